# Optimizing an MI355X kernel written in HIP

```python
import jax, jax.numpy as jnp
from jax import lax
import numpy as np

D_MODEL = 1024
BATCH = 4
SEQ = 4096
DEPTH = 2

GRID_W = 64
CTX_LEN = 256
D_LRU = 1024
LRU_HEADS = 16
LRU_HEAD_DIM = D_LRU // LRU_HEADS
CONV_WIDTH = 4
CONV_PAD = (2, 1)
LRU_C = 8.0
D_POOL = 512
POOL_WINDOWS = (2, 4, 8, 16)
POOL_GROUP = D_POOL // len(POOL_WINDOWS)
D_FF = 4 * D_MODEL
N_BRANCH = 2
D_IN = 2 * D_LRU + D_POOL + N_BRANCH * D_MODEL
IN_SPLITS = (D_LRU, 2 * D_LRU, 2 * D_LRU + D_POOL)
N_MOD = 6
EPS = 1e-6

kernel_name = "hybrid_rglru_pool_dit_block"


def rms_norm(x, g):
    xf = x.astype(jnp.float32)
    y = xf * lax.rsqrt(jnp.mean(xf * xf, axis=-1, keepdims=True) + EPS)
    return (y * g.astype(jnp.float32)).astype(x.dtype)


def modulate(x, g, shift, scale):
    return rms_norm(x, g) * (1.0 + scale[:, None, :]) + shift[:, None, :]


def depthwise_conv(u, w, b):
    y = lax.conv_general_dilated(
        u, w[:, None, :].astype(u.dtype), window_strides=(1,), padding=[CONV_PAD],
        dimension_numbers=('NWC', 'WIO', 'NWC'), feature_group_count=u.shape[-1])
    return y + b


def rglru_coeffs(uc, w_r, b_r, w_i, b_i, lam):
    bsz, L, _ = uc.shape
    uh = uc.reshape(bsz, L, LRU_HEADS, LRU_HEAD_DIM)
    r = jax.nn.sigmoid(jnp.einsum('blhd,hde->blhe', uh, w_r).reshape(bsz, L, D_LRU) + b_r)
    i = jax.nn.sigmoid(jnp.einsum('blhd,hde->blhe', uh, w_i).reshape(bsz, L, D_LRU) + b_i)
    log_a = -LRU_C * r.astype(jnp.float32) * jax.nn.softplus(-lam.astype(jnp.float32))
    a = jnp.exp(log_a)
    b = jnp.sqrt(-jnp.expm1(2.0 * log_a)) * (i * uc).astype(jnp.float32)
    return a, b


def linear_scan(a, b, h0, reverse):
    if reverse:
        a, b = jnp.flip(a, axis=1), jnp.flip(b, axis=1)
    b = b.at[:, 0].add(a[:, 0] * h0)

    def combine(e1, e2):
        a1, b1 = e1
        a2, b2 = e2
        return a1 * a2, a2 * b1 + b2

    _, h = lax.associative_scan(combine, (a, b), axis=1)
    if reverse:
        h = jnp.flip(h, axis=1)
    return h


def rglru_bidirectional(u_lat, u_ctx, conv_w, conv_b, w_r, b_r, w_i, b_i, lam):
    uc_l = depthwise_conv(u_lat, conv_w, conv_b)
    uc_c = depthwise_conv(u_ctx, conv_w, conv_b)
    h0 = jnp.zeros((u_ctx.shape[0], D_LRU), jnp.float32)
    out_l = jnp.zeros(uc_l.shape, jnp.float32)
    out_c = jnp.zeros(uc_c.shape, jnp.float32)
    for d, rev in enumerate((False, True)):
        a_c, b_c = rglru_coeffs(uc_c, w_r[d], b_r[d], w_i[d], b_i[d], lam[d])
        h_c = linear_scan(a_c, b_c, h0, rev)
        h_final = h_c[:, 0] if rev else h_c[:, -1]
        a_l, b_l = rglru_coeffs(uc_l, w_r[d], b_r[d], w_i[d], b_i[d], lam[d])
        out_l = out_l + linear_scan(a_l, b_l, h_final, rev)
        out_c = out_c + h_c
    return out_l.astype(u_lat.dtype), out_c.astype(u_ctx.dtype)


def pool_mixer(p, pool_w, pool_scale):
    L = p.shape[-2]
    pf = p.astype(jnp.float32)
    cs = jnp.concatenate([jnp.zeros_like(pf[..., :1, :]), jnp.cumsum(pf, axis=-2)], axis=-2)
    t = jnp.arange(L)
    groups = []
    for gi, w in enumerate(POOL_WINDOWS):
        sl = slice(gi * POOL_GROUP, (gi + 1) * POOL_GROUP)
        lo = jnp.clip(t - w // 2, 0, L)
        hi = jnp.clip(t + w - w // 2, 0, L)
        csg = cs[..., sl]
        mean = (jnp.take(csg, hi, axis=-2) - jnp.take(csg, lo, axis=-2)) / (hi - lo).astype(jnp.float32)[:, None]
        groups.append(mean - pf[..., sl])
    m = jnp.stack(groups, axis=-2)
    y = jnp.einsum('bnlgc,gce->bnlge', m.astype(p.dtype), pool_w)
    return y.reshape(p.shape) * pool_scale


def branch_merge(h_lru, g, p_mixed, gt, w_lru_out, w_pool_out, w_o):
    lru_out = (h_lru * jax.nn.gelu(g)) @ w_lru_out
    pool_out = p_mixed @ w_pool_out
    g_lru, g_pool = jnp.split(jax.nn.sigmoid(gt), N_BRANCH, axis=-1)
    return (g_lru * lru_out + g_pool * pool_out) @ w_o


def sq_relu_mlp(h, w1, w2):
    return jnp.square(jax.nn.relu(h @ w1)) @ w2


def setup_inputs(seed: int = 0) -> dict:
    key = jax.random.key(seed)
    ks = jax.random.split(key, 24)
    f32 = jnp.float32
    D, L_ = D_MODEL, DEPTH

    def nrm(k, shape, scale):
        return jax.random.normal(k, shape, f32) * scale

    u = jax.random.uniform(ks[15], (L_, 2, D_LRU), f32, minval=0.9, maxval=0.999)
    return {
        "x": nrm(ks[0], (BATCH, SEQ, D), 1.0),
        "c": nrm(ks[1], (BATCH, D), 1.0),
        "ctx": nrm(ks[2], (BATCH, CTX_LEN, D), 1.0),
        "c_ctx": nrm(ks[3], (D,), 1.0),
        "w_ada": nrm(ks[4], (L_, D, N_MOD * D), 0.5 * D ** -0.5),
        "b_ada": nrm(ks[5], (L_, N_MOD * D), 0.02),
        "norm1_g": 1.0 + nrm(ks[6], (L_, D), 0.05),
        "norm2_g": 1.0 + nrm(ks[7], (L_, D), 0.05),
        "w_in": nrm(ks[8], (L_, D, D_IN), D ** -0.5),
        "conv_w": nrm(ks[9], (L_, CONV_WIDTH, D_LRU), CONV_WIDTH ** -0.5),
        "conv_b": nrm(ks[10], (L_, D_LRU), 0.02),
        "lru_w_r": nrm(ks[11], (L_, 2, LRU_HEADS, LRU_HEAD_DIM, LRU_HEAD_DIM), LRU_HEAD_DIM ** -0.5),
        "lru_b_r": nrm(ks[12], (L_, 2, D_LRU), 0.02),
        "lru_w_i": nrm(ks[13], (L_, 2, LRU_HEADS, LRU_HEAD_DIM, LRU_HEAD_DIM), LRU_HEAD_DIM ** -0.5),
        "lru_b_i": nrm(ks[14], (L_, 2, D_LRU), 0.02),
        "lru_lambda": jnp.log(u) - jnp.log1p(-u),
        "w_lru_out": nrm(ks[16], (L_, D_LRU, D), D_LRU ** -0.5),
        "pool_w": nrm(ks[17], (L_, len(POOL_WINDOWS), POOL_GROUP, POOL_GROUP), POOL_GROUP ** -0.5),
        "pool_scale": 1.0 + nrm(ks[18], (L_, D_POOL), 0.1),
        "w_pool_out": nrm(ks[19], (L_, D_POOL, D), D_POOL ** -0.5),
        "w_o": nrm(ks[20], (L_, D, D), D ** -0.5),
        "mlp_w1": nrm(ks[21], (L_, D, D_FF), D ** -0.5),
        "mlp_w2": nrm(ks[22], (L_, D_FF, D), D_FF ** -0.5),
        "final_g": 1.0 + nrm(ks[23], (D,), 0.05),
    }


def reference(x, c, ctx, c_ctx, w_ada, b_ada, norm1_g, norm2_g, w_in, conv_w, conv_b,
              lru_w_r, lru_b_r, lru_w_i, lru_b_i, lru_lambda, w_lru_out, pool_w, pool_scale,
              w_pool_out, w_o, mlp_w1, mlp_w2, final_g):
    bsz, seq, _ = x.shape
    rows = seq // GRID_W
    silu_c = jax.nn.silu(c)
    silu_cc = jax.nn.silu(c_ctx)[None]
    for l in range(DEPTH):
        last = l == DEPTH - 1
        shift1, scale1, gate1, shift2, scale2, gate2 = jnp.split(silu_c @ w_ada[l] + b_ada[l], N_MOD, axis=-1)
        cshift1, cscale1, cgate1, cshift2, cscale2, cgate2 = jnp.split(silu_cc @ w_ada[l] + b_ada[l], N_MOD, axis=-1)

        h_l = modulate(x, norm1_g[l], shift1, scale1)
        h_c = modulate(ctx, norm1_g[l], cshift1, cscale1)
        u_l, g_l, p_l, gt_l = jnp.split(h_l @ w_in[l], IN_SPLITS, axis=-1)
        if last:
            u_c = h_c @ w_in[l][:, :D_LRU]
        else:
            u_c, g_c, p_c, gt_c = jnp.split(h_c @ w_in[l], IN_SPLITS, axis=-1)
        hl_lru, hc_lru = rglru_bidirectional(u_l, u_c, conv_w[l], conv_b[l], lru_w_r[l], lru_b_r[l],
                                             lru_w_i[l], lru_b_i[l], lru_lambda[l])
        pm_l = pool_mixer(p_l.reshape(bsz, rows, GRID_W, D_POOL), pool_w[l], pool_scale[l]).reshape(bsz, seq, D_POOL)
        y_l = branch_merge(hl_lru, g_l, pm_l, gt_l, w_lru_out[l], w_pool_out[l], w_o[l])
        x = x + gate1[:, None, :] * y_l
        x = x + gate2[:, None, :] * sq_relu_mlp(modulate(x, norm2_g[l], shift2, scale2), mlp_w1[l], mlp_w2[l])

        if not last:
            pm_c = pool_mixer(p_c[:, None], pool_w[l], pool_scale[l])[:, 0]
            y_c = branch_merge(hc_lru, g_c, pm_c, gt_c, w_lru_out[l], w_pool_out[l], w_o[l])
            ctx = ctx + cgate1[:, None, :] * y_c
            ctx = ctx + cgate2[:, None, :] * sq_relu_mlp(modulate(ctx, norm2_g[l], cshift2, cscale2), mlp_w1[l], mlp_w2[l])
    return rms_norm(x, final_g)
```

```cpp
#include <hip/hip_runtime.h>
#include <hip/hip_cooperative_groups.h>
#include <cstdio>
#include <cstdint>
namespace cg = cooperative_groups;
#ifndef MK_PER_PHASE
#define MK_PER_PHASE 1
#endif
__device__ __forceinline__ int opaque_tid() { int t = threadIdx.x; asm volatile("" : "+v"(t)); return t; }
namespace pg8 {
#define PG8_LAS __attribute__((address_space(3)))
typedef unsigned short bf16_t;
typedef short bf16x8 __attribute__((ext_vector_type(8)));
typedef float f32x4 __attribute__((ext_vector_type(4)));
typedef unsigned u32x4 __attribute__((ext_vector_type(4)));
constexpr int BM = 256, BK = 64, HALF = 128, HTB = HALF * BK * 2  , STAGE_BYTES = 8 * HTB, NXCD = 8, WGM = 8;

__host__ __device__ __forceinline__ int lds_byte(int r, int c) { const int st = (r >> 4) * 2 + (c >> 5), rr = r & 15, cc = c & 31, ob = rr * 64 + cc * 2; return st * 1024 + (ob ^ (((ob >> 9) & 1) << 5)); }
__host__ __device__ __forceinline__ void stage_rc(int b, int& R, int& C) { const int st = b / 1024, sb = b % 1024, swz = sb ^ (((sb >> 9) & 1) << 5); R = (st >> 1) * 16 + swz / 64; C = (st & 1) * 32 + (swz % 64) / 2; }
__host__ __device__ __forceinline__ int perm32(int rho) { const int n = rho >> 4, i = rho & 15; return 8 * (i >> 2) + 4 * n + (i & 3); }

struct Unit { int pm, pn; };
struct Gemm { const bf16_t* A; const bf16_t* Bt; int M, N, K; };

struct StaticOrder {
    int nM, nN, nwg, G, c;
    __host__ __device__ void init(int M, int N, int G_, int c_) { nM = M / BM; nN = N / BM; nwg = nM * nN; G = G_; c = c_; }
    __host__ __device__ bool next(int i, Unit& u) const {
        const long L = (long)i * G + c; if (L >= nwg) return false;
        int wgid = (int)L; { const int q = nwg / NXCD, r = nwg % NXCD, xcd = wgid % NXCD, off = wgid / NXCD; wgid = (xcd < r ? xcd * (q + 1) : r * (q + 1) + (xcd - r) * q) + off; }
        const int nig = WGM * nN, gid = wgid / nig, fm = gid * WGM, gsz = (nM - fm) < WGM ? (nM - fm) : WGM;
        u.pm = fm + ((wgid % nig) % gsz); u.pn = (wgid % nig) / gsz; return true;
    }
    __device__ __forceinline__ void a_ready(const Unit&) const {}
    __device__ __forceinline__ void done(const Unit&) const {}
};
__device__ __forceinline__ unsigned cvt_pk_bf16(float lo, float hi) { unsigned r; asm volatile("v_cvt_pk_bf16_f32 %0, %1, %2" : "=v"(r) : "v"(lo), "v"(hi)); return r; }
__device__ __forceinline__ float bf_lo(unsigned w) { return __uint_as_float(w << 16); }
__device__ __forceinline__ float bf_hi(unsigned w) { return __uint_as_float(w & 0xffff0000u); }
__device__ __forceinline__ float sigm(float x) { return __builtin_amdgcn_rcpf(1.0f + __expf(-x)); }

struct EpiSplit {
    static constexpr bool PERM = true, AFTER_DRAIN = false;
    bf16_t *U, *G, *P, *GT;
    __device__ __forceinline__ void operator()(const f32x4 (&acc)[2][2][4][2], const Unit& u, int wr, int wc, int fr, int fq) const {
        bf16_t* base; int ldc, colt;
        if (u.pn < 4) { base = U; ldc = 1024; colt = u.pn * 256; }
        else if (u.pn < 8) { base = G; ldc = 1024; colt = (u.pn - 4) * 256; }
        else if (u.pn < 10) { base = P; ldc = 512; colt = (u.pn - 8) * 256; }
        else { base = GT; ldc = 2048; colt = (u.pn - 10) * 256; }
        const int row0 = u.pm * BM + wr * 64 + fr, col0 = colt + wc * 32 + 8 * fq;
#pragma unroll
        for (int ai = 0; ai < 2; ++ai)
#pragma unroll
            for (int m = 0; m < 4; ++m) { bf16_t* rowp = base + (size_t)(row0 + ai * HALF + m * 16) * ldc + col0;
#pragma unroll
                for (int bj = 0; bj < 2; ++bj) { const f32x4 v0 = acc[ai][bj][m][0], v1 = acc[ai][bj][m][1];
                    u32x4 w; w.x = cvt_pk_bf16(v0[0], v0[1]); w.y = cvt_pk_bf16(v0[2], v0[3]); w.z = cvt_pk_bf16(v1[0], v1[1]); w.w = cvt_pk_bf16(v1[2], v1[3]);
                    *(u32x4*)(rowp + bj * HALF) = w; } }
    }
};
template <int MODE> struct EpiGate {
    static constexpr bool PERM = true, AFTER_DRAIN = false;
    bf16_t* Z; const bf16_t* GT;
    __device__ __forceinline__ void operator()(const f32x4 (&acc)[2][2][4][2], const Unit& u, int wr, int wc, int fr, int fq) const {
        const int row0 = u.pm * BM + wr * 64 + fr, col0 = u.pn * BM + wc * 32 + 8 * fq;
#pragma unroll
        for (int ai = 0; ai < 2; ++ai)
#pragma unroll
            for (int m = 0; m < 4; ++m) { const size_t row = (size_t)(row0 + ai * HALF + m * 16);
#pragma unroll
                for (int bj = 0; bj < 2; ++bj) { const int col = col0 + bj * HALF;
                    const u32x4 gt = *(const u32x4*)(GT + row * 2048 + (MODE == 0 ? 1024 : 0) + col);
                    f32x4 v0 = acc[ai][bj][m][0], v1 = acc[ai][bj][m][1];
                    v0[0] *= sigm(bf_lo(gt.x)); v0[1] *= sigm(bf_hi(gt.x)); v0[2] *= sigm(bf_lo(gt.y)); v0[3] *= sigm(bf_hi(gt.y));
                    v1[0] *= sigm(bf_lo(gt.z)); v1[1] *= sigm(bf_hi(gt.z)); v1[2] *= sigm(bf_lo(gt.w)); v1[3] *= sigm(bf_hi(gt.w));
                    u32x4* zp = (u32x4*)(Z + row * 1024 + col);
                    if (MODE == 1) { const u32x4 z = *zp;
                        v0[0] += bf_lo(z.x); v0[1] += bf_hi(z.x); v0[2] += bf_lo(z.y); v0[3] += bf_hi(z.y);
                        v1[0] += bf_lo(z.z); v1[1] += bf_hi(z.z); v1[2] += bf_lo(z.w); v1[3] += bf_hi(z.w); }
                    u32x4 w; w.x = cvt_pk_bf16(v0[0], v0[1]); w.y = cvt_pk_bf16(v0[2], v0[3]); w.z = cvt_pk_bf16(v1[0], v1[1]); w.w = cvt_pk_bf16(v1[2], v1[3]);
                    *zp = w; }
                asm volatile("" ::: "memory"); }
    }
};
struct EpiRes {
    static constexpr bool PERM = false, AFTER_DRAIN = false;
    const float* srcL; const float* srcC; float* dstL; float* dstC; const float* gate;
    __device__ __forceinline__ void operator()(const f32x4 (&acc)[2][2][4][2], const Unit& u, int wr, int wc, int fr, int fq) const {
        const bool lat = u.pm < 64;
        const size_t tb = (size_t)(lat ? u.pm : u.pm - 64) * 256 * 1024;
        const float* src = (lat ? srcL : srcC) + tb; float* dst = (lat ? dstL : dstC) + tb;
        const float* gv = gate + (lat ? (u.pm >> 4) : 4) * 6144;
        const int rl0 = wr * 64 + fr, col0 = u.pn * BM + wc * 32 + 4 * fq;
        f32x4 g[2][2];
#pragma unroll
        for (int bj = 0; bj < 2; ++bj)
#pragma unroll
            for (int n = 0; n < 2; ++n) g[bj][n] = *(const f32x4*)(gv + col0 + bj * HALF + n * 16);
#pragma unroll
        for (int ai = 0; ai < 2; ++ai)
#pragma unroll
            for (int m = 0; m < 4; ++m) { const size_t off = (size_t)(rl0 + ai * HALF + m * 16) * 1024 + col0;
#pragma unroll
                for (int bj = 0; bj < 2; ++bj)
#pragma unroll
                    for (int n = 0; n < 2; ++n) { const f32x4 s = *(const f32x4*)(src + off + bj * HALF + n * 16);
                        *(f32x4*)(dst + off + bj * HALF + n * 16) = s + g[bj][n] * acc[ai][bj][m][n]; }
                asm volatile("" ::: "memory"); }
    }
};
struct EpiSqRelu {
    static constexpr bool PERM = true, AFTER_DRAIN = false;
    bf16_t* F; int ldc;
    __device__ __forceinline__ void operator()(const f32x4 (&acc)[2][2][4][2], const Unit& u, int wr, int wc, int fr, int fq) const {
        const int row0 = u.pm * BM + wr * 64 + fr, col0 = u.pn * BM + wc * 32 + 8 * fq;
#pragma unroll
        for (int ai = 0; ai < 2; ++ai)
#pragma unroll
            for (int m = 0; m < 4; ++m) { bf16_t* rowp = F + (size_t)(row0 + ai * HALF + m * 16) * ldc + col0;
#pragma unroll
                for (int bj = 0; bj < 2; ++bj) { f32x4 v0 = acc[ai][bj][m][0], v1 = acc[ai][bj][m][1];
#pragma unroll
                    for (int j = 0; j < 4; ++j) { const float a0 = fmaxf(v0[j], 0.f), a1 = fmaxf(v1[j], 0.f); v0[j] = a0 * a0; v1[j] = a1 * a1; }
                    u32x4 w; w.x = cvt_pk_bf16(v0[0], v0[1]); w.y = cvt_pk_bf16(v0[2], v0[3]); w.z = cvt_pk_bf16(v1[0], v1[1]); w.w = cvt_pk_bf16(v1[2], v1[3]);
                    *(u32x4*)(rowp + bj * HALF) = w; } }
    }
};

template <class Epi, class Sched, bool ALIGN_EPI = false, bool SP2 = false>
__device__ __forceinline__ void gemm_phase(PG8_LAS unsigned char* lds, const Gemm g, const Sched& S, const Epi& E) {
    const int tid = opaque_tid(), wid = __builtin_amdgcn_readfirstlane(tid >> 6), lane = tid & 63, wr = wid >> 2, wc = wid & 3, fr = lane & 15, fq = lane >> 4;
    const int K = g.K, nt = K / BK;
    unsigned voffA[2], voffB[2];
#pragma unroll
    for (int i = 0; i < 2; ++i) { int R, C; stage_rc(tid * 16 + i * 8192, R, C); const int Rb = Epi::PERM ? ((R & ~31) + perm32(R & 31)) : R;
        voffA[i] = (unsigned)(R * K + C) * 2u; voffB[i] = (unsigned)(Rb * K + C) * 2u; }
    const size_t kstep = (size_t)(BK * 2);
    const size_t hstep = (size_t)HALF * K * 2;
    const size_t tstep = 2 * hstep;
    const unsigned ldsw = (unsigned)wid * 1024u;
    const int aoff = lds_byte(wr * 64 + fr, fq * 8), boff = lds_byte(wc * 32 + fr, fq * 8);
#define PG8_SA(b, h) (((b) * 2 + (h)) * HTB)
#define PG8_SB(b, h) ((4 + (b) * 2 + (h)) * HTB)
#define PG8_STAGE(bufoff, gbase, voff) do { _Pragma("unroll") for (int _i = 0; _i < 2; ++_i) \
        __builtin_amdgcn_global_load_lds((const unsigned*)((const char*)(gbase) + (voff)[_i]), (PG8_LAS unsigned*)(lds + (bufoff) + ldsw + _i * 8192), 16, 0, 0); } while (0)
#define PG8_LDA(dst, b, h) do { _Pragma("unroll") for (int m = 0; m < 4; ++m) _Pragma("unroll") for (int k = 0; k < 2; ++k) dst[m][k] = *(const PG8_LAS bf16x8*)(lds + PG8_SA(b, h) + aoff + m * 2048 + k * 1024); } while (0)
#define PG8_LDB(dst, b, h) do { _Pragma("unroll") for (int n = 0; n < 2; ++n) _Pragma("unroll") for (int k = 0; k < 2; ++k) dst[n][k] = *(const PG8_LAS bf16x8*)(lds + PG8_SB(b, h) + boff + n * 2048 + k * 1024); } while (0)
#define PG8_MMA(ai, bj, At, Bt) do { __builtin_amdgcn_s_setprio(1); _Pragma("unroll") for (int m = 0; m < 4; ++m) _Pragma("unroll") for (int n = 0; n < 2; ++n) _Pragma("unroll") for (int k = 0; k < 2; ++k) \
        acc[ai][bj][m][n] = __builtin_amdgcn_mfma_f32_16x16x32_bf16(Bt[n][k], At[m][k], acc[ai][bj][m][n], 0, 0, 0); __builtin_amdgcn_s_setprio(0); } while (0)
#define PG8_WAIT_V(n) asm volatile("s_waitcnt vmcnt(" #n ")" ::: "memory")
#define PG8_WAIT_L(n) asm volatile("s_waitcnt lgkmcnt(" #n ")" ::: "memory")
#define PG8_BAR __builtin_amdgcn_s_barrier()
#define PG8_SCHED __builtin_amdgcn_sched_barrier(0)
    Unit cur, nxt; int ui = 0;
    if (!S.next(0, cur)) return;
    f32x4 acc[2][2][4][2];
#pragma unroll
    for (int a = 0; a < 2; ++a)
#pragma unroll
        for (int b = 0; b < 2; ++b)
#pragma unroll
            for (int m = 0; m < 4; ++m)
#pragma unroll
                for (int n = 0; n < 2; ++n) acc[a][b][m][n] = (f32x4){0.f, 0.f, 0.f, 0.f};
    bf16x8 At[4][2], B0[2][2], B1[2][2];
    const char* cA = (const char*)g.A + (size_t)cur.pm * tstep; const char* cB = (const char*)g.Bt + (size_t)cur.pn * tstep;
    S.a_ready(cur);
    if constexpr (SP2) {
        PG8_STAGE(PG8_SB(0, 0), cB, voffB); PG8_STAGE(PG8_SB(0, 1), cB + hstep, voffB); PG8_STAGE(PG8_SA(0, 0), cA, voffA); PG8_STAGE(PG8_SA(0, 1), cA + hstep, voffA);
        if (wr == 1) PG8_BAR;
        PG8_WAIT_V(2); PG8_BAR;
        PG8_STAGE(PG8_SB(1, 0), cB + kstep, voffB); PG8_STAGE(PG8_SA(1, 0), cA + kstep, voffA); PG8_STAGE(PG8_SB(1, 1), cB + hstep + kstep, voffB);
        PG8_WAIT_V(6); PG8_BAR;
    } else {
        PG8_STAGE(PG8_SB(0, 0), cB, voffB); PG8_STAGE(PG8_SA(0, 0), cA, voffA); PG8_STAGE(PG8_SB(0, 1), cB + hstep, voffB); PG8_STAGE(PG8_SA(0, 1), cA + hstep, voffA);
        if (wr == 1) PG8_BAR;
        PG8_WAIT_V(4); PG8_BAR;
        PG8_STAGE(PG8_SB(1, 0), cB + kstep, voffB); PG8_STAGE(PG8_SA(1, 0), cA + kstep, voffA); PG8_STAGE(PG8_SB(1, 1), cB + hstep + kstep, voffB);
        PG8_WAIT_V(6); PG8_BAR;
    }
    for (;;) {
        const bool has_next = S.next(ui + 1, nxt);
        const char* nA = has_next ? (const char*)g.A + (size_t)nxt.pm * tstep : cA; const char* nB = has_next ? (const char*)g.Bt + (size_t)nxt.pn * tstep : cB;
        for (int t = 0; t < nt; t += 2) {
            const bool last = (t == nt - 2);
            const char* a1 = cA + (size_t)(t + 1) * kstep;
            const char* a2 = last ? nA : cA + (size_t)(t + 2) * kstep; const char* b2 = last ? nB : cB + (size_t)(t + 2) * kstep;
            const char* a3 = a2 + kstep; const char* b3 = b2 + kstep;
            if (last && has_next) S.a_ready(nxt);
            if constexpr (SP2) {
            PG8_LDB(B0, 0, 0); PG8_LDB(B1, 0, 1); PG8_SCHED; PG8_LDA(At, 0, 0); PG8_STAGE(PG8_SA(1, 1), a1 + hstep, voffA);
            PG8_WAIT_V(8); PG8_WAIT_L(0); PG8_BAR; PG8_MMA(0, 0, At, B0); PG8_MMA(0, 1, At, B1); PG8_BAR; PG8_SCHED;
            PG8_LDA(At, 0, 1); PG8_STAGE(PG8_SB(0, 0), b2, voffB); PG8_STAGE(PG8_SB(0, 1), b2 + hstep, voffB); PG8_STAGE(PG8_SA(0, 0), a2, voffA);
            PG8_WAIT_V(8); PG8_WAIT_L(0); PG8_BAR; PG8_MMA(1, 0, At, B0); PG8_MMA(1, 1, At, B1); PG8_BAR; PG8_SCHED;
            PG8_LDB(B0, 1, 0); PG8_LDB(B1, 1, 1); PG8_SCHED; PG8_LDA(At, 1, 0); PG8_STAGE(PG8_SA(0, 1), a2 + hstep, voffA);
            PG8_WAIT_V(8); PG8_WAIT_L(0); PG8_BAR; PG8_MMA(0, 0, At, B0); PG8_MMA(0, 1, At, B1); PG8_BAR; PG8_SCHED;
            PG8_LDA(At, 1, 1); PG8_STAGE(PG8_SB(1, 0), b3, voffB); PG8_STAGE(PG8_SB(1, 1), b3 + hstep, voffB); PG8_STAGE(PG8_SA(1, 0), a3, voffA);
            PG8_WAIT_V(8); PG8_WAIT_L(0); PG8_BAR; PG8_MMA(1, 0, At, B0); PG8_MMA(1, 1, At, B1); PG8_BAR; PG8_SCHED;
            } else {
            PG8_LDB(B0, 0, 0); PG8_SCHED; PG8_LDA(At, 0, 0); PG8_STAGE(PG8_SA(1, 1), a1 + hstep, voffA);
            PG8_WAIT_L(8); PG8_BAR; PG8_WAIT_L(0); PG8_MMA(0, 0, At, B0); PG8_BAR; PG8_SCHED;
            PG8_LDB(B1, 0, 1); PG8_STAGE(PG8_SB(0, 0), b2, voffB);
            PG8_BAR; PG8_WAIT_L(0); PG8_MMA(0, 1, At, B1); PG8_BAR;
            PG8_LDA(At, 0, 1); PG8_STAGE(PG8_SA(0, 0), a2, voffA);
            PG8_BAR; PG8_WAIT_L(0); PG8_MMA(1, 0, At, B0); PG8_BAR; PG8_SCHED;
            PG8_STAGE(PG8_SB(0, 1), b2 + hstep, voffB);
            PG8_WAIT_V(6); PG8_BAR; PG8_MMA(1, 1, At, B1); PG8_BAR;
            PG8_LDB(B0, 1, 0); PG8_SCHED; PG8_LDA(At, 1, 0); PG8_STAGE(PG8_SA(0, 1), a2 + hstep, voffA);
            PG8_WAIT_L(8); PG8_BAR; PG8_WAIT_L(0); PG8_MMA(0, 0, At, B0); PG8_BAR; PG8_SCHED;
            PG8_LDB(B1, 1, 1); PG8_STAGE(PG8_SB(1, 0), b3, voffB);
            PG8_BAR; PG8_WAIT_L(0); PG8_MMA(0, 1, At, B1); PG8_BAR;
            PG8_LDA(At, 1, 1); PG8_STAGE(PG8_SA(1, 0), a3, voffA);
            PG8_BAR; PG8_WAIT_L(0); PG8_MMA(1, 0, At, B0); PG8_BAR; PG8_SCHED;
            PG8_STAGE(PG8_SB(1, 1), b3 + hstep, voffB);
            PG8_WAIT_V(6); PG8_BAR; PG8_MMA(1, 1, At, B1); PG8_BAR;
            }
        }
        if constexpr (ALIGN_EPI) { if (wr == 0) PG8_BAR; }
        if constexpr (!Epi::AFTER_DRAIN) { E(acc, cur, wr, wc, fr, fq); S.done(cur); }
        if (!has_next) break;
#pragma unroll
        for (int a = 0; a < 2; ++a)
#pragma unroll
            for (int b = 0; b < 2; ++b)
#pragma unroll
                for (int m = 0; m < 4; ++m)
#pragma unroll
                    for (int n = 0; n < 2; ++n) acc[a][b][m][n] = (f32x4){0.f, 0.f, 0.f, 0.f};
        cur = nxt; cA = nA; cB = nB; ++ui;
        if constexpr (ALIGN_EPI) { if (wr == 1) PG8_BAR; }
    }
    PG8_WAIT_V(0);
    if constexpr (!ALIGN_EPI) { if (wr == 0) PG8_BAR; }
    PG8_BAR;
    if constexpr (Epi::AFTER_DRAIN) { E.fused(acc, cur, wr, wc, fr, fq, lds, wid, lane); S.done(cur); }
#undef PG8_SA
#undef PG8_SB
#undef PG8_STAGE
#undef PG8_LDA
#undef PG8_LDB
#undef PG8_MMA
#undef PG8_WAIT_V
#undef PG8_WAIT_L
#undef PG8_BAR
#undef PG8_SCHED
}
}
constexpr int D = 1024, NB = 4, SEQ = 4096, CTX = 256, DEPTH = 2;
constexpr int ML = NB * SEQ, MC = NB * CTX, MT = ML + MC;
constexpr int D_IN = 4608, D_POOL = 512, D_FF = 4096, MODW = 6 * D;
constexpr int TCH = 128;
constexpr int NQ = CTX / TCH + SEQ / TCH;
constexpr float EPS = 1e-6f;
constexpr size_t MiB = 1u << 20;
constexpr size_t WS_MOD = 0;
constexpr size_t WS_SUMM = 512 * 1024;
constexpr size_t WS_CARRY = 2816 * 1024;
constexpr size_t WS_XC = 4 * MiB;
constexpr size_t WS_WIN = 8 * MiB, WS_WLO = 17 * MiB, WS_WPO = 19 * MiB, WS_WO = 20 * MiB, WS_W1 = 22 * MiB, WS_W2 = 30 * MiB;
constexpr size_t WS_GW = 38 * MiB;
constexpr size_t WS_PW = 39 * MiB;
constexpr size_t WS_H = 40 * MiB;
constexpr size_t WS_U = 74 * MiB;
constexpr size_t WS_G = 108 * MiB;
constexpr size_t WS_P = 142 * MiB;
constexpr size_t WS_GT = 159 * MiB;
constexpr size_t WS_PM = 227 * MiB;
constexpr size_t WS_F = WS_U;
constexpr size_t WS_END = 244 * MiB;
static_assert(WS_SUMM + (size_t)NB * 2 * NQ * 2 * 1024 * 4 <= WS_CARRY && WS_CARRY + (size_t)NB * 2 * NQ * 1024 * 4 <= WS_XC, "ws map (small)");
static_assert(WS_F + (size_t)MT * D_FF * 2 <= WS_PM && WS_H + (size_t)MT * D * 2 <= WS_U && WS_GT + (size_t)MT * 2048 * 2 <= WS_PM, "ws map");
constexpr int LDS_BYTES = 136 * 1024;

#define LAS __attribute__((address_space(3)))
typedef unsigned short bf16;
typedef unsigned u32x4 __attribute__((ext_vector_type(4)));
typedef unsigned u32x2 __attribute__((ext_vector_type(2)));
typedef float f32x4 __attribute__((ext_vector_type(4)));
typedef float f32x16 __attribute__((ext_vector_type(16)));
typedef short bf16x8 __attribute__((ext_vector_type(8)));
using pg8::cvt_pk_bf16; using pg8::bf_lo; using pg8::bf_hi; using pg8::sigm;

struct Args { const float* in[24]; float* out; unsigned char* ws; int lo, hi; };
enum { I_X = 0, I_C, I_CTX, I_CCTX, I_WADA, I_BADA, I_N1G, I_N2G, I_WIN, I_CONVW, I_CONVB, I_WR, I_BR, I_WI, I_BI, I_LAM, I_WLO, I_POOLW, I_POOLS, I_WPO, I_WO, I_W1, I_W2, I_FG };

__device__ __forceinline__ float wave_sum(float v) {
#pragma unroll
    for (int o = 1; o < 64; o <<= 1) v += __shfl_xor(v, o);
    return v;
}
__device__ __forceinline__ float gelu_tanh(float x) { const float z = 0.7978845608f * (x + 0.044715f * x * x * x); const float e = __expf(2.f * z); return 0.5f * x * (2.f - 2.f * __builtin_amdgcn_rcpf(e + 1.f)); }

__device__ __forceinline__ void mod_item(const Args& a, LAS unsigned char* lds, int item) {
    const int tid = opaque_tid(), l = item / 96, cb = item % 96, cq = tid & 15, kg = tid >> 4;
    LAS float* s = (LAS float*)lds;
    LAS float* part = (LAS float*)(lds + 20480);
    const float* c = a.in[I_C]; const float* cc = a.in[I_CCTX];
    for (int i = tid; i < 5120; i += 512) { const int r = i >> 10, k = i & 1023; const float v = r < 4 ? c[r * 1024 + k] : cc[k]; s[i] = v * sigm(v); }
    __syncthreads();
    const float* W = a.in[I_WADA] + (size_t)l * D * MODW + cb * 64 + cq * 4;
    float acc[5][4];
#pragma unroll
    for (int r = 0; r < 5; ++r)
#pragma unroll
        for (int j = 0; j < 4; ++j) acc[r][j] = 0.f;
#pragma unroll 8
    for (int kk = 0; kk < 32; ++kk) { const int k = kg * 32 + kk; const f32x4 w = *(const f32x4*)(W + (size_t)k * MODW);
#pragma unroll
        for (int r = 0; r < 5; ++r) { const float sv = s[r * 1024 + k];
#pragma unroll
            for (int j = 0; j < 4; ++j) acc[r][j] += sv * w[j]; } }
#pragma unroll
    for (int r = 0; r < 5; ++r)
#pragma unroll
        for (int j = 0; j < 4; ++j) part[(kg * 5 + r) * 64 + cq * 4 + j] = acc[r][j];
    __syncthreads();
    if (tid < 320) { const int r = tid >> 6, col = tid & 63; float t = 0.f;
#pragma unroll 8
        for (int g = 0; g < 32; ++g) t += part[(g * 5 + r) * 64 + col];
        ((float*)(a.ws + WS_MOD))[(size_t)(l * 5 + r) * MODW + cb * 64 + col] = t + a.in[I_BADA][l * MODW + cb * 64 + col]; }
    __syncthreads();
}
__device__ __forceinline__ void transpose_item(const float* W, int K, int N, bf16* WT, LAS float* scr, int item, int lane) {
    const int nblk = N / 32, kb = item / nblk, nb = item % nblk, k0 = 64 * kb, n0 = 32 * nb;
#pragma unroll 8
    for (int i = 0; i < 32; ++i) { const int kk = 2 * i + (lane >> 5); scr[kk * 33 + (lane & 31)] = W[(size_t)(k0 + kk) * N + n0 + (lane & 31)]; }
    asm volatile("s_waitcnt lgkmcnt(0)" ::: "memory");
    const int c = lane & 7;
#pragma unroll
    for (int j = 0; j < 4; ++j) { const int n = (lane >> 3) + 8 * j; const LAS float* s = scr + (8 * c) * 33 + n;
        u32x4 o; o.x = cvt_pk_bf16(s[0 * 33], s[1 * 33]); o.y = cvt_pk_bf16(s[2 * 33], s[3 * 33]); o.z = cvt_pk_bf16(s[4 * 33], s[5 * 33]); o.w = cvt_pk_bf16(s[6 * 33], s[7 * 33]);
        *(u32x4*)(WT + (size_t)(n0 + n) * K + k0 + 8 * c) = o; }
    asm volatile("s_waitcnt lgkmcnt(0)" ::: "memory");
}
__device__ __forceinline__ void convert_big(const Args& a, LAS unsigned char* lds, int l, int gw, int NGW, int wave, int lane) {
    LAS float* scr = (LAS float*)(lds + wave * 16384);
    constexpr int I_IN = (D / 64) * (D_IN / 32), I_LO = (D / 64) * (D / 32), I_PO = (D_POOL / 64) * (D / 32), I_O = I_LO, I_1 = (D / 64) * (D_FF / 32), I_2 = (D_FF / 64) * (D / 32);
    constexpr int NIT = I_IN + I_LO + I_PO + I_O + I_1 + I_2;
    unsigned char* ws = a.ws;
    for (int it = gw; it < NIT; it += NGW) { int r = it;
        if (r < I_IN) { transpose_item(a.in[I_WIN] + (size_t)l * D * D_IN, D, D_IN, (bf16*)(ws + WS_WIN), scr, r, lane); continue; } r -= I_IN;
        if (r < I_LO) { transpose_item(a.in[I_WLO] + (size_t)l * D * D, D, D, (bf16*)(ws + WS_WLO), scr, r, lane); continue; } r -= I_LO;
        if (r < I_PO) { transpose_item(a.in[I_WPO] + (size_t)l * D_POOL * D, D_POOL, D, (bf16*)(ws + WS_WPO), scr, r, lane); continue; } r -= I_PO;
        if (r < I_O) { transpose_item(a.in[I_WO] + (size_t)l * D * D, D, D, (bf16*)(ws + WS_WO), scr, r, lane); continue; } r -= I_O;
        if (r < I_1) { transpose_item(a.in[I_W1] + (size_t)l * D * D_FF, D, D_FF, (bf16*)(ws + WS_W1), scr, r, lane); continue; } r -= I_1;
        transpose_item(a.in[I_W2] + (size_t)l * D_FF * D, D_FF, D, (bf16*)(ws + WS_W2), scr, r, lane); }
}
__device__ __forceinline__ void convert_small(const Args& a, LAS unsigned char* lds, int gw, int NGW, int wave, int lane) {
    LAS float* scr = (LAS float*)(lds + wave * 16384);
    for (int it = gw; it < 256 + 64; it += NGW) {
        if (it < 256) { const int mi = it >> 1, sub = it & 1, h = mi & 15, ri = (mi >> 4) & 1, ld = mi >> 5;
            const float* src = a.in[ri ? I_WI : I_WR] + ((size_t)ld * 16 + h) * 4096;
            transpose_item(src, 64, 64, (bf16*)(a.ws + WS_GW) + ((size_t)(ld * 2 + ri) * 16 + h) * 4096, scr, sub, lane); }
        else { const int r = it - 256, mi = r >> 3, sub = r & 7;
            transpose_item(a.in[I_POOLW] + (size_t)mi * 16384, 128, 128, (bf16*)(a.ws + WS_PW) + (size_t)mi * 16384, scr, sub, lane); }
    }
}
__device__ __forceinline__ void norm_rows(const float* xl, const float* xc, bf16* H, const float* gvec, const float* mod  , int shift_i, int scale_i, int nrows, int gw, int NGW, int lane) {
    for (int m = gw; m < nrows; m += NGW) {
        const float* xr = m < ML ? xl + (size_t)m * D : xc + (size_t)(m - ML) * D; const int r = m < ML ? (m >> 12) : 4;
        const f32x4* x4 = (const f32x4*)xr + lane; f32x4 v[4]; float ss = 0.f;
#pragma unroll
        for (int j = 0; j < 4; ++j) { v[j] = x4[64 * j]; ss += (v[j].x * v[j].x + v[j].y * v[j].y) + (v[j].z * v[j].z + v[j].w * v[j].w); }
        const float rstd = 1.0f / sqrtf(wave_sum(ss) * (1.f / D) + EPS);
        const f32x4* g4 = (const f32x4*)gvec + lane; const f32x4* sc4 = (const f32x4*)(mod + (size_t)r * MODW + scale_i * D) + lane; const f32x4* sh4 = (const f32x4*)(mod + (size_t)r * MODW + shift_i * D) + lane;
        u32x2* o = (u32x2*)(H + (size_t)m * D) + lane;
#pragma unroll
        for (int j = 0; j < 4; ++j) { const f32x4 h = v[j] * rstd * g4[64 * j] * (1.0f + sc4[64 * j]) + sh4[64 * j]; u32x2 w; w.x = cvt_pk_bf16(h.x, h.y); w.y = cvt_pk_bf16(h.z, h.w); o[64 * j] = w; }
    }
}
__device__ __forceinline__ void final_rows(float* x, const float* gvec, int gw, int NGW, int lane) {
    for (int m = gw; m < ML; m += NGW) {
        f32x4* x4 = (f32x4*)(x + (size_t)m * D) + lane; f32x4 v[4]; float ss = 0.f;
#pragma unroll
        for (int j = 0; j < 4; ++j) { v[j] = x4[64 * j]; ss += (v[j].x * v[j].x + v[j].y * v[j].y) + (v[j].z * v[j].z + v[j].w * v[j].w); }
        const float rstd = 1.0f / sqrtf(wave_sum(ss) * (1.f / D) + EPS);
        const f32x4* g4 = (const f32x4*)gvec + lane;
#pragma unroll
        for (int j = 0; j < 4; ++j) x4[64 * j] = v[j] * rstd * g4[64 * j];
    }
}
constexpr int SC_A = 0, SC_B = 32768, SC_HF = 65536, SC_UCB = 98304, SC_UROW = 144  , SC_SEG = SC_UCB + TCH * SC_UROW;
static_assert(SC_SEG + 4096 <= 131072, "scan LDS");
template <bool PASSB>
__device__ __forceinline__ void scan_item(const Args& a, LAS unsigned char* lds, int l, int item) {
    const int tid = opaque_tid(), lane = tid & 63, wave = __builtin_amdgcn_readfirstlane(tid >> 6);
    int b, chunk, h, seqbase, L, q;
    if (item < 2048) { b = item >> 9; const int rem = item & 511; chunk = rem >> 4; h = rem & 15; seqbase = b * SEQ; L = SEQ; q = 2 + chunk; }
    else { const int it = item - 2048; b = it >> 5; const int rem = it & 31; chunk = rem >> 4; h = rem & 15; seqbase = ML + b * CTX; L = CTX; q = chunk; }
    const int t0 = chunk * TCH;
    const bf16* U = (const bf16*)(a.ws + WS_U);
    LAS float* Al = (LAS float*)(lds + SC_A); LAS float* Bl = (LAS float*)(lds + SC_B); LAS float* Hf = (LAS float*)(lds + SC_HF);
    LAS float* segA = (LAS float*)(lds + SC_SEG); LAS float* segB = segA + 512;
    {
        const int t = tid >> 2, cgp = tid & 3, ch0 = h * 64 + cgp * 16;
        const float* cw = a.in[I_CONVW] + (size_t)l * 4 * D + ch0; const float* cb = a.in[I_CONVB] + (size_t)l * D + ch0;
#pragma unroll
        for (int hh = 0; hh < 2; ++hh) {
            float uc[8];
            { const f32x4 b0 = *(const f32x4*)(cb + hh * 8), b1 = *(const f32x4*)(cb + hh * 8 + 4);
              uc[0] = b0.x; uc[1] = b0.y; uc[2] = b0.z; uc[3] = b0.w; uc[4] = b1.x; uc[5] = b1.y; uc[6] = b1.z; uc[7] = b1.w; }
#pragma unroll
            for (int j = 0; j < 4; ++j) { const int tt = t0 + t - 2 + j;
                u32x4 uv = (u32x4){0u, 0u, 0u, 0u};
                if (tt >= 0 && tt < L) uv = *(const u32x4*)(U + (size_t)(seqbase + tt) * D + ch0 + hh * 8);
                const f32x4 w0 = *(const f32x4*)(cw + j * D + hh * 8), w1 = *(const f32x4*)(cw + j * D + hh * 8 + 4);
                uc[0] += w0.x * bf_lo(uv.x); uc[1] += w0.y * bf_hi(uv.x); uc[2] += w0.z * bf_lo(uv.y); uc[3] += w0.w * bf_hi(uv.y);
                uc[4] += w1.x * bf_lo(uv.z); uc[5] += w1.y * bf_hi(uv.z); uc[6] += w1.z * bf_lo(uv.w); uc[7] += w1.w * bf_hi(uv.w); }
            u32x4 o; o.x = cvt_pk_bf16(uc[0], uc[1]); o.y = cvt_pk_bf16(uc[2], uc[3]); o.z = cvt_pk_bf16(uc[4], uc[5]); o.w = cvt_pk_bf16(uc[6], uc[7]);
            *(LAS u32x4*)(lds + SC_UCB + t * SC_UROW + (cgp * 16 + hh * 8) * 2) = o;
        }
    }
    __syncthreads();
    const int tb = wave >> 1, nb = wave & 1, l31 = lane & 31, lh = lane >> 5, e = nb * 32 + l31, ch = h * 64 + e;
    bf16x8 af[4];
#pragma unroll
    for (int ks = 0; ks < 4; ++ks) af[ks] = *(const LAS bf16x8*)(lds + SC_UCB + (tb * 32 + l31) * SC_UROW + (ks * 16 + lh * 8) * 2);
    const int sseg = tid >> 6, sc = tid & 63;
#pragma unroll 1
    for (int dir = 0; dir < 2; ++dir) {
        const int ld = l * 2 + dir;
        const bf16* gwr = (const bf16*)(a.ws + WS_GW) + ((size_t)((ld * 2 + 0) * 16 + h) * 64 + e) * 64 + lh * 8;
        const bf16* gwi = (const bf16*)(a.ws + WS_GW) + ((size_t)((ld * 2 + 1) * 16 + h) * 64 + e) * 64 + lh * 8;
        f32x16 ar, ai;
#pragma unroll
        for (int i = 0; i < 16; ++i) { ar[i] = 0.f; ai[i] = 0.f; }
#pragma unroll
        for (int ks = 0; ks < 4; ++ks) { const bf16x8 br = *(const bf16x8*)(gwr + ks * 16), bi = *(const bf16x8*)(gwi + ks * 16);
            ar = __builtin_amdgcn_mfma_f32_32x32x16_bf16(af[ks], br, ar, 0, 0, 0); ai = __builtin_amdgcn_mfma_f32_32x32x16_bf16(af[ks], bi, ai, 0, 0, 0); }
        const float brr = a.in[I_BR][ld * D + ch], bii = a.in[I_BI][ld * D + ch], lam = a.in[I_LAM][ld * D + ch];
        const float sp = fmaxf(-lam, 0.f) + log1pf(__expf(-fabsf(lam)));
#pragma unroll
        for (int reg = 0; reg < 16; ++reg) { const int t = tb * 32 + (reg & 3) + 8 * (reg >> 2) + 4 * lh;
            const float r = sigm(ar[reg] + brr), ig = sigm(ai[reg] + bii);
            const float la = -8.0f * r * sp, av = __expf(la), mult = sqrtf(fmaxf(-expm1f(2.0f * la), 0.f));
            const float ucv = __uint_as_float((unsigned)(*(const LAS unsigned short*)(lds + SC_UCB + t * SC_UROW + e * 2)) << 16);
            Al[t * 64 + e] = av; Bl[t * 64 + e] = mult * ig * ucv; }
        __syncthreads();
        float pA = 1.f, pB = 0.f;
#pragma unroll
        for (int k = 0; k < 16; ++k) { const int t = dir ? (sseg * 16 + 15 - k) : (sseg * 16 + k); const float av = Al[t * 64 + sc], bv = Bl[t * 64 + sc]; pB = av * pB + bv; pA *= av; }
        segA[sseg * 64 + sc] = pA; segB[sseg * 64 + sc] = pB;
        __syncthreads();
        const int gch = h * 64 + sc;
        if (!PASSB) {
            if (tid < 64) { float tA = 1.f, tB = 0.f;
#pragma unroll
                for (int k = 0; k < 8; ++k) { const int s2 = dir ? 7 - k : k; const float sa = segA[s2 * 64 + sc], sb = segB[s2 * 64 + sc]; tB = sa * tB + sb; tA *= sa; }
                float* sm = (float*)(a.ws + WS_SUMM) + ((size_t)((b * 2 + dir) * NQ + q) * 2) * 1024 + gch;
                sm[0] = tA; sm[1024] = tB; }
        } else {
            float hs = ((const float*)(a.ws + WS_CARRY))[(size_t)((b * 2 + dir) * NQ + q) * 1024 + gch];
            const int npre = dir ? 7 - sseg : sseg;
            for (int k = 0; k < npre; ++k) { const int s2 = dir ? 7 - k : k; hs = segA[s2 * 64 + sc] * hs + segB[s2 * 64 + sc]; }
#pragma unroll
            for (int k = 0; k < 16; ++k) { const int t = dir ? (sseg * 16 + 15 - k) : (sseg * 16 + k); hs = Al[t * 64 + sc] * hs + Bl[t * 64 + sc];
                if (dir == 0) Hf[t * 64 + sc] = hs; else Hf[t * 64 + sc] += hs; }
        }
        __syncthreads();
    }
    if (PASSB) {
        const int t = tid >> 2, cgp = tid & 3; const size_t row = (size_t)(seqbase + t0 + t);
        const bf16* G = (const bf16*)(a.ws + WS_G) + row * D + h * 64 + cgp * 16; bf16* HL = (bf16*)(a.ws + WS_H) + row * D + h * 64 + cgp * 16;
#pragma unroll
        for (int hh = 0; hh < 2; ++hh) { const u32x4 gv = *(const u32x4*)(G + hh * 8);
            const f32x4 h0 = *(const LAS f32x4*)(Hf + t * 64 + cgp * 16 + hh * 8), h1 = *(const LAS f32x4*)(Hf + t * 64 + cgp * 16 + hh * 8 + 4);
            u32x4 o; o.x = cvt_pk_bf16(h0.x * gelu_tanh(bf_lo(gv.x)), h0.y * gelu_tanh(bf_hi(gv.x))); o.y = cvt_pk_bf16(h0.z * gelu_tanh(bf_lo(gv.y)), h0.w * gelu_tanh(bf_hi(gv.y)));
            o.z = cvt_pk_bf16(h1.x * gelu_tanh(bf_lo(gv.z)), h1.y * gelu_tanh(bf_hi(gv.z))); o.w = cvt_pk_bf16(h1.z * gelu_tanh(bf_lo(gv.w)), h1.w * gelu_tanh(bf_hi(gv.w)));
            *(u32x4*)(HL + hh * 8) = o; }
        __syncthreads();
    }
}
__device__ __forceinline__ void carry_phase(const Args& a) {
    const float* sm = (const float*)(a.ws + WS_SUMM); float* cr = (float*)(a.ws + WS_CARRY);
    const int tid = opaque_tid();
    for (int idx = blockIdx.x * 64 + tid; tid < 64 && idx < NB * 2 * 1024; idx += gridDim.x * 64) {
        const int chn = idx & 1023, bd = idx >> 10, dir = bd & 1;
        const float* s0 = sm + (size_t)bd * NQ * 2048 + chn; float* c0 = cr + (size_t)bd * NQ * 1024 + chn;
        float hs = 0.f;
#pragma unroll 2
        for (int k = 0; k < NQ; ++k) { int q;
            if (dir == 0) q = k; else q = (k < 2) ? 1 - k : (NQ + 1 - k);
            c0[(size_t)q * 1024] = hs; hs = s0[(size_t)q * 2048] * hs + s0[(size_t)q * 2048 + 1024]; }
    }
}
constexpr int PL_PF = 0  , PL_MB = 40960  , PL_MROW = 272;
__device__ __forceinline__ void pool_item(const Args& a, LAS unsigned char* lds, int l, int item) {
    const int tid = opaque_tid(), lane = tid & 63, wave = __builtin_amdgcn_readfirstlane(tid >> 6);
    int g, R0, L, t0;
    if (item < 1024) { g = item & 3; R0 = (item >> 2) * 64; L = 64; t0 = 0; }
    else { const int it = item - 1024; g = it & 3; const int blk = (it >> 2) & 3, b = it >> 4; R0 = ML + b * CTX; L = CTX; t0 = blk * 64; }
    const bf16* P = (const bf16*)(a.ws + WS_P); LAS float* pf = (LAS float*)(lds + PL_PF);
    for (int idx = tid; idx < 1280; idx += 512) { const int row = idx >> 4, c8 = (idx & 15) * 8, tt = t0 - 8 + row;
        if (tt >= 0 && tt < L) { const u32x4 v = *(const u32x4*)(P + (size_t)(R0 + tt) * D_POOL + g * 128 + c8);
            *(LAS f32x4*)(pf + row * 128 + c8) = (f32x4){bf_lo(v.x), bf_hi(v.x), bf_lo(v.y), bf_hi(v.y)}; *(LAS f32x4*)(pf + row * 128 + c8 + 4) = (f32x4){bf_lo(v.z), bf_hi(v.z), bf_lo(v.w), bf_hi(v.w)}; } }
    __syncthreads();
    { const int c = tid & 127, tq = tid >> 7, hw = 1 << g;
      for (int k = 0; k < 16; ++k) { const int t = tq * 16 + k, tt = t0 + t; const int lo = max(tt - hw, 0), hi = min(tt + hw, L); float s = 0.f;
          for (int u = lo; u < hi; ++u) s += pf[(u - t0 + 8) * 128 + c];
          const float mval = s / (float)(hi - lo) - pf[(t + 8) * 128 + c];
          *(LAS unsigned short*)(lds + PL_MB + t * PL_MROW + c * 2) = (unsigned short)(cvt_pk_bf16(mval, 0.f) & 0xffffu); } }
    __syncthreads();
    { const int mblk = wave & 1, nblk = wave >> 1, l31 = lane & 31, lh = lane >> 5, e = nblk * 32 + l31;
      const bf16* pw = (const bf16*)(a.ws + WS_PW) + ((size_t)(l * 4 + g) * 128 + e) * 128 + lh * 8;
      f32x16 acc;
#pragma unroll
      for (int i = 0; i < 16; ++i) acc[i] = 0.f;
#pragma unroll
      for (int ks = 0; ks < 8; ++ks) { const bf16x8 af = *(const LAS bf16x8*)(lds + PL_MB + (mblk * 32 + l31) * PL_MROW + (ks * 16 + lh * 8) * 2); const bf16x8 bw = *(const bf16x8*)(pw + ks * 16);
          acc = __builtin_amdgcn_mfma_f32_32x32x16_bf16(af, bw, acc, 0, 0, 0); }
      const float scl = a.in[I_POOLS][l * D_POOL + g * 128 + e];
      bf16* PM = (bf16*)(a.ws + WS_PM) + (size_t)(R0 + t0) * D_POOL + g * 128 + e;
#pragma unroll
      for (int reg = 0; reg < 16; ++reg) { const int t = mblk * 32 + (reg & 3) + 8 * (reg >> 2) + 4 * lh; PM[(size_t)t * D_POOL] = (bf16)(cvt_pk_bf16(acc[reg] * scl, 0.f) & 0xffffu); } }
    __syncthreads();
}
constexpr int NPHASE = 22;
__global__ void __launch_bounds__(512, 2) mk_fwd(Args a) {
    extern __shared__ __attribute__((aligned(16))) unsigned char lds_raw[];
    LAS unsigned char* lds = (LAS unsigned char*)lds_raw;
    cg::grid_group grid = cg::this_grid();
    const int G = gridDim.x, bx = blockIdx.x, NGW = G * 8;
#define WL() const int tid_ = opaque_tid(), lane = tid_ & 63, wave = __builtin_amdgcn_readfirstlane(tid_ >> 6), gw = bx * 8 + wave
    const int lo = a.lo, hi = a.hi;
    unsigned char* ws = a.ws;
    float* MOD = (float*)(ws + WS_MOD); float* XC = (float*)(ws + WS_XC);
    bf16* Hb = (bf16*)(ws + WS_H); bf16* Ub = (bf16*)(ws + WS_U); bf16* Gb = (bf16*)(ws + WS_G); bf16* Pb = (bf16*)(ws + WS_P); bf16* GTb = (bf16*)(ws + WS_GT); bf16* PMb = (bf16*)(ws + WS_PM); bf16* Fb = (bf16*)(ws + WS_F);
#ifndef PH_MASK
#define PH_MASK 0xfff
#endif
#define IN(k) (lo <= (k) && (k) < hi)
#define ON(b) ((PH_MASK >> (b)) & 1)
#define SEAM(k) do { if (IN(k) && IN((k) + 1)) grid.sync(); } while (0)
    if (ON(0) && IN(0)) {
        for (int it = bx; it < 192; it += G) mod_item(a, lds, it);
        WL();
        convert_small(a, lds, gw, NGW, wave, lane);
        convert_big(a, lds, 0, gw, NGW, wave, lane);
    }
    SEAM(0);
#pragma unroll 1
    for (int l = 0; l < DEPTH; ++l) {
        const int pb = 1 + 10 * l; const bool last = (l == DEPTH - 1);
        const float* modl = MOD + (size_t)l * 5 * MODW;
        const float* xsrcL = l == 0 ? a.in[I_X] : a.out; const float* xsrcC = l == 0 ? a.in[I_CTX] : XC;
        const int Mrest = last ? ML : MT;
        if (ON(1) && IN(pb + 0)) {
            WL();
            if (l > 0) convert_big(a, lds, l, gw, NGW, wave, lane);
            norm_rows(xsrcL, xsrcC, Hb, a.in[I_N1G] + l * D, modl, 0, 1, MT, gw, NGW, lane);
        }
        SEAM(pb + 0);
        if (ON(2) && IN(pb + 1)) {
            pg8::Gemm g{Hb, (const bf16*)(ws + WS_WIN), MT, D_IN, D}; pg8::StaticOrder S; S.init(MT, D_IN, G, bx);
            pg8::EpiSplit E{Ub, Gb, Pb, GTb};
            pg8::gemm_phase<pg8::EpiSplit, pg8::StaticOrder, true, true>(lds, g, S, E);
        }
        SEAM(pb + 1);
        if (ON(3) && IN(pb + 2)) {
            const int npool = last ? 1024 : 1088;
            for (int it = bx; it < 2176 + npool; it += G) { if (it < 2176) scan_item<false>(a, lds, l, it); else pool_item(a, lds, l, it - 2176); }
        }
        SEAM(pb + 2);
        if (ON(4) && IN(pb + 3)) carry_phase(a);
        SEAM(pb + 3);
        if (ON(5) && IN(pb + 4)) { const int nit = last ? 2048 : 2176; for (int it = bx; it < nit; it += G) scan_item<true>(a, lds, l, it); }
        SEAM(pb + 4);
        if (ON(6) && IN(pb + 5)) {
            { pg8::Gemm g{PMb, (const bf16*)(ws + WS_WPO), Mrest, D, D_POOL}; pg8::StaticOrder S; S.init(Mrest, D, G, bx);
              pg8::EpiGate<0> E{Ub, GTb}; pg8::gemm_phase<pg8::EpiGate<0>, pg8::StaticOrder, true, true>(lds, g, S, E); }
            { pg8::Gemm g{Hb, (const bf16*)(ws + WS_WLO), Mrest, D, D}; pg8::StaticOrder S; S.init(Mrest, D, G, bx);
              pg8::EpiGate<1> E{Ub, GTb}; pg8::gemm_phase<pg8::EpiGate<1>, pg8::StaticOrder, true, true>(lds, g, S, E); }
        }
        SEAM(pb + 5);
        if (ON(7) && IN(pb + 6)) {
            pg8::Gemm g{Ub, (const bf16*)(ws + WS_WO), Mrest, D, D}; pg8::StaticOrder S; S.init(Mrest, D, G, bx);
            pg8::EpiRes E{xsrcL, xsrcC, a.out, XC, modl + 2 * D};
            pg8::gemm_phase<pg8::EpiRes, pg8::StaticOrder, true, true>(lds, g, S, E);
        }
        SEAM(pb + 6);
        if (ON(8) && IN(pb + 7)) { WL(); norm_rows(a.out, XC, Hb, a.in[I_N2G] + l * D, modl, 3, 4, Mrest, gw, NGW, lane); }
        SEAM(pb + 7);
        if (ON(9) && IN(pb + 8)) {
            pg8::Gemm g{Hb, (const bf16*)(ws + WS_W1), Mrest, D_FF, D}; pg8::StaticOrder S; S.init(Mrest, D_FF, G, bx);
            pg8::EpiSqRelu E{Fb, D_FF};
            pg8::gemm_phase<pg8::EpiSqRelu, pg8::StaticOrder, true, true>(lds, g, S, E);
        }
        SEAM(pb + 8);
        if (ON(10) && IN(pb + 9)) {
            pg8::Gemm g{Fb, (const bf16*)(ws + WS_W2), Mrest, D, D_FF}; pg8::StaticOrder S; S.init(Mrest, D, G, bx);
            pg8::EpiRes E{a.out, XC, a.out, XC, modl + 5 * D};
            pg8::gemm_phase<pg8::EpiRes, pg8::StaticOrder, true, true>(lds, g, S, E);
        }
        SEAM(pb + 9);
    }
    if (ON(11) && IN(21)) { WL(); final_rows(a.out, a.in[I_FG], gw, NGW, lane); }
#undef IN
#undef SEAM
}

extern "C" void kernel_launch(void* const* d_in, const int* in_sizes, int n_in, void* d_out, int out_size, void* d_ws, size_t ws_size, hipStream_t stream) {
    static int grid = 0;
    if (grid == 0) {
        if (n_in != 24 || out_size != ML * D || ws_size < WS_END) { fprintf(stderr, "kernel_launch: unexpected shapes (n_in %d, out %d, ws %zu)\n", n_in, out_size, ws_size); grid = -1; return; }
        int dev = 0, cus = 0, per_cu = 0;
        if (hipGetDevice(&dev) != hipSuccess || hipDeviceGetAttribute(&cus, hipDeviceAttributeMultiprocessorCount, dev) != hipSuccess) { grid = -1; return; }
        if (hipFuncSetAttribute((const void*)mk_fwd, hipFuncAttributeMaxDynamicSharedMemorySize, LDS_BYTES) != hipSuccess) { fprintf(stderr, "kernel_launch: hipFuncSetAttribute failed\n"); grid = -1; return; }
        if (hipOccupancyMaxActiveBlocksPerMultiprocessor(&per_cu, (const void*)mk_fwd, 512, LDS_BYTES) != hipSuccess || per_cu < 1) { fprintf(stderr, "kernel_launch: occupancy query says %d\n", per_cu); per_cu = 1; }
        (void)hipGetLastError();
        grid = cus;
    }
    if (grid < 0) return;
    Args a{};
    for (int i = 0; i < 24; ++i) a.in[i] = (const float*)d_in[i];
    a.out = (float*)d_out; a.ws = (unsigned char*)d_ws;
#if MK_PER_PHASE
    for (int p = 0; p < NPHASE; ++p) { a.lo = p; a.hi = p + 1; hipLaunchKernelGGL(mk_fwd, dim3(grid), dim3(512), LDS_BYTES, stream, a); }
#else
    a.lo = 0; a.hi = NPHASE;
    void* args[] = {&a};
    hipError_t e = hipLaunchCooperativeKernel((const void*)mk_fwd, dim3(grid), dim3(512), args, LDS_BYTES, stream);
    if (e != hipSuccess) fprintf(stderr, "kernel_launch: cooperative launch failed: %s (grid %d)\n", hipGetErrorString(e), grid);
#endif
}
```

```cpp
#include <hip/hip_runtime.h>
#include <hip/hip_cooperative_groups.h>
#include <cstdio>
#include <cstdint>
namespace cg = cooperative_groups;
#ifndef MK_PER_PHASE
#define MK_PER_PHASE 0
#endif
__device__ __forceinline__ int opaque_tid() { int t = threadIdx.x; asm volatile("" : "+v"(t)); return t; }
namespace pg8 {
#define PG8_LAS __attribute__((address_space(3)))
typedef unsigned short bf16_t;
typedef short bf16x8 __attribute__((ext_vector_type(8)));
typedef float f32x4 __attribute__((ext_vector_type(4)));
typedef unsigned u32x4 __attribute__((ext_vector_type(4)));
constexpr int BM = 256, BK = 64, HALF = 128, HTB = HALF * BK * 2  , STAGE_BYTES = 8 * HTB, NXCD = 8, WGM = 8;

__host__ __device__ __forceinline__ int lds_byte(int r, int c) { const int st = (r >> 4) * 2 + (c >> 5), rr = r & 15, cc = c & 31, ob = rr * 64 + cc * 2; return st * 1024 + (ob ^ (((ob >> 9) & 1) << 5)); }
__host__ __device__ __forceinline__ void stage_rc(int b, int& R, int& C) { const int st = b / 1024, sb = b % 1024, swz = sb ^ (((sb >> 9) & 1) << 5); R = (st >> 1) * 16 + swz / 64; C = (st & 1) * 32 + (swz % 64) / 2; }
__host__ __device__ __forceinline__ int perm32(int rho) { const int n = rho >> 4, i = rho & 15; return 8 * (i >> 2) + 4 * n + (i & 3); }

struct Unit { int pm, pn; };
struct Gemm { const bf16_t* A; const bf16_t* Bt; int M, N, K; };

struct StaticOrder {
    int nM, nN, nwg, G, c;
    __host__ __device__ void init(int M, int N, int G_, int c_) { nM = M / BM; nN = N / BM; nwg = nM * nN; G = G_; c = c_; }
    __host__ __device__ bool next(int i, Unit& u) const {
        const long L = (long)i * G + c; if (L >= nwg) return false;
        int wgid = (int)L; { const int q = nwg / NXCD, r = nwg % NXCD, xcd = wgid % NXCD, off = wgid / NXCD; wgid = (xcd < r ? xcd * (q + 1) : r * (q + 1) + (xcd - r) * q) + off; }
        const int nig = WGM * nN, gid = wgid / nig, fm = gid * WGM, gsz = (nM - fm) < WGM ? (nM - fm) : WGM;
        u.pm = fm + ((wgid % nig) % gsz); u.pn = (wgid % nig) / gsz; return true;
    }
    __device__ __forceinline__ void a_ready(const Unit&) const {}
    __device__ __forceinline__ void done(const Unit&) const {}
};
__device__ __forceinline__ unsigned cvt_pk_bf16(float lo, float hi) { unsigned r; asm volatile("v_cvt_pk_bf16_f32 %0, %1, %2" : "=v"(r) : "v"(lo), "v"(hi)); return r; }
__device__ __forceinline__ float bf_lo(unsigned w) { return __uint_as_float(w << 16); }
__device__ __forceinline__ float bf_hi(unsigned w) { return __uint_as_float(w & 0xffff0000u); }
__device__ __forceinline__ float sigm(float x) { return __builtin_amdgcn_rcpf(1.0f + __expf(-x)); }

struct EpiSplit {
    static constexpr bool PERM = true, AFTER_DRAIN = false;
    bf16_t *U, *G, *P, *GT;
    __device__ __forceinline__ void operator()(const f32x4 (&acc)[2][2][4][2], const Unit& u, int wr, int wc, int fr, int fq) const {
        bf16_t* base; int ldc, colt;
        if (u.pn < 4) { base = U; ldc = 1024; colt = u.pn * 256; }
        else if (u.pn < 8) { base = G; ldc = 1024; colt = (u.pn - 4) * 256; }
        else if (u.pn < 10) { base = P; ldc = 512; colt = (u.pn - 8) * 256; }
        else { base = GT; ldc = 2048; colt = (u.pn - 10) * 256; }
        const int row0 = u.pm * BM + wr * 64 + fr, col0 = colt + wc * 32 + 8 * fq;
#pragma unroll
        for (int ai = 0; ai < 2; ++ai)
#pragma unroll
            for (int m = 0; m < 4; ++m) { bf16_t* rowp = base + (size_t)(row0 + ai * HALF + m * 16) * ldc + col0;
#pragma unroll
                for (int bj = 0; bj < 2; ++bj) { const f32x4 v0 = acc[ai][bj][m][0], v1 = acc[ai][bj][m][1];
                    u32x4 w; w.x = cvt_pk_bf16(v0[0], v0[1]); w.y = cvt_pk_bf16(v0[2], v0[3]); w.z = cvt_pk_bf16(v1[0], v1[1]); w.w = cvt_pk_bf16(v1[2], v1[3]);
                    *(u32x4*)(rowp + bj * HALF) = w; } }
    }
};
template <int MODE> struct EpiGate {
    static constexpr bool PERM = true, AFTER_DRAIN = false;
    bf16_t* Z; const bf16_t* GT;
    __device__ __forceinline__ void operator()(const f32x4 (&acc)[2][2][4][2], const Unit& u, int wr, int wc, int fr, int fq) const {
        const int row0 = u.pm * BM + wr * 64 + fr, col0 = u.pn * BM + wc * 32 + 8 * fq;
#pragma unroll
        for (int ai = 0; ai < 2; ++ai)
#pragma unroll
            for (int m = 0; m < 4; ++m) { const size_t row = (size_t)(row0 + ai * HALF + m * 16);
#pragma unroll
                for (int bj = 0; bj < 2; ++bj) { const int col = col0 + bj * HALF;
                    const u32x4 gt = *(const u32x4*)(GT + row * 2048 + (MODE == 0 ? 1024 : 0) + col);
                    f32x4 v0 = acc[ai][bj][m][0], v1 = acc[ai][bj][m][1];
                    v0[0] *= sigm(bf_lo(gt.x)); v0[1] *= sigm(bf_hi(gt.x)); v0[2] *= sigm(bf_lo(gt.y)); v0[3] *= sigm(bf_hi(gt.y));
                    v1[0] *= sigm(bf_lo(gt.z)); v1[1] *= sigm(bf_hi(gt.z)); v1[2] *= sigm(bf_lo(gt.w)); v1[3] *= sigm(bf_hi(gt.w));
                    u32x4* zp = (u32x4*)(Z + row * 1024 + col);
                    if (MODE == 1) { const u32x4 z = *zp;
                        v0[0] += bf_lo(z.x); v0[1] += bf_hi(z.x); v0[2] += bf_lo(z.y); v0[3] += bf_hi(z.y);
                        v1[0] += bf_lo(z.z); v1[1] += bf_hi(z.z); v1[2] += bf_lo(z.w); v1[3] += bf_hi(z.w); }
                    u32x4 w; w.x = cvt_pk_bf16(v0[0], v0[1]); w.y = cvt_pk_bf16(v0[2], v0[3]); w.z = cvt_pk_bf16(v1[0], v1[1]); w.w = cvt_pk_bf16(v1[2], v1[3]);
                    *zp = w; }
                asm volatile("" ::: "memory"); }
    }
};
struct EpiRes {
    static constexpr bool PERM = false, AFTER_DRAIN = false;
    const float* srcL; const float* srcC; float* dstL; float* dstC; const float* gate;
    __device__ __forceinline__ void operator()(const f32x4 (&acc)[2][2][4][2], const Unit& u, int wr, int wc, int fr, int fq) const {
        const bool lat = u.pm < 64;
        const size_t tb = (size_t)(lat ? u.pm : u.pm - 64) * 256 * 1024;
        const float* src = (lat ? srcL : srcC) + tb; float* dst = (lat ? dstL : dstC) + tb;
        const float* gv = gate + (lat ? (u.pm >> 4) : 4) * 6144;
        const int rl0 = wr * 64 + fr, col0 = u.pn * BM + wc * 32 + 4 * fq;
        f32x4 g[2][2];
#pragma unroll
        for (int bj = 0; bj < 2; ++bj)
#pragma unroll
            for (int n = 0; n < 2; ++n) g[bj][n] = *(const f32x4*)(gv + col0 + bj * HALF + n * 16);
#pragma unroll
        for (int ai = 0; ai < 2; ++ai)
#pragma unroll
            for (int m = 0; m < 4; ++m) { const size_t off = (size_t)(rl0 + ai * HALF + m * 16) * 1024 + col0;
#pragma unroll
                for (int bj = 0; bj < 2; ++bj)
#pragma unroll
                    for (int n = 0; n < 2; ++n) { const f32x4 s = *(const f32x4*)(src + off + bj * HALF + n * 16);
                        *(f32x4*)(dst + off + bj * HALF + n * 16) = s + g[bj][n] * acc[ai][bj][m][n]; }
                asm volatile("" ::: "memory"); }
    }
};
struct EpiSqRelu {
    static constexpr bool PERM = true, AFTER_DRAIN = false;
    bf16_t* F; int ldc;
    __device__ __forceinline__ void operator()(const f32x4 (&acc)[2][2][4][2], const Unit& u, int wr, int wc, int fr, int fq) const {
        const int row0 = u.pm * BM + wr * 64 + fr, col0 = u.pn * BM + wc * 32 + 8 * fq;
#pragma unroll
        for (int ai = 0; ai < 2; ++ai)
#pragma unroll
            for (int m = 0; m < 4; ++m) { bf16_t* rowp = F + (size_t)(row0 + ai * HALF + m * 16) * ldc + col0;
#pragma unroll
                for (int bj = 0; bj < 2; ++bj) { f32x4 v0 = acc[ai][bj][m][0], v1 = acc[ai][bj][m][1];
#pragma unroll
                    for (int j = 0; j < 4; ++j) { const float a0 = fmaxf(v0[j], 0.f), a1 = fmaxf(v1[j], 0.f); v0[j] = a0 * a0; v1[j] = a1 * a1; }
                    u32x4 w; w.x = cvt_pk_bf16(v0[0], v0[1]); w.y = cvt_pk_bf16(v0[2], v0[3]); w.z = cvt_pk_bf16(v1[0], v1[1]); w.w = cvt_pk_bf16(v1[2], v1[3]);
                    *(u32x4*)(rowp + bj * HALF) = w; } }
    }
};

template <class Epi, class Sched, bool ALIGN_EPI = false, bool SP2 = false>
__device__ __forceinline__ void gemm_phase(PG8_LAS unsigned char* lds, const Gemm g, const Sched& S, const Epi& E) {
    const int tid = opaque_tid(), wid = __builtin_amdgcn_readfirstlane(tid >> 6), lane = tid & 63, wr = wid >> 2, wc = wid & 3, fr = lane & 15, fq = lane >> 4;
    const int K = g.K, nt = K / BK;
    unsigned voffA[2], voffB[2];
#pragma unroll
    for (int i = 0; i < 2; ++i) { int R, C; stage_rc(tid * 16 + i * 8192, R, C); const int Rb = Epi::PERM ? ((R & ~31) + perm32(R & 31)) : R;
        voffA[i] = (unsigned)(R * K + C) * 2u; voffB[i] = (unsigned)(Rb * K + C) * 2u; }
    const size_t kstep = (size_t)(BK * 2);
    const size_t hstep = (size_t)HALF * K * 2;
    const size_t tstep = 2 * hstep;
    const unsigned ldsw = (unsigned)wid * 1024u;
    const int aoff = lds_byte(wr * 64 + fr, fq * 8), boff = lds_byte(wc * 32 + fr, fq * 8);
#define PG8_SA(b, h) (((b) * 2 + (h)) * HTB)
#define PG8_SB(b, h) ((4 + (b) * 2 + (h)) * HTB)
#define PG8_STAGE(bufoff, gbase, voff) do { _Pragma("unroll") for (int _i = 0; _i < 2; ++_i) \
        __builtin_amdgcn_global_load_lds((const unsigned*)((const char*)(gbase) + (voff)[_i]), (PG8_LAS unsigned*)(lds + (bufoff) + ldsw + _i * 8192), 16, 0, 0); } while (0)
#define PG8_LDA(dst, b, h) do { _Pragma("unroll") for (int m = 0; m < 4; ++m) _Pragma("unroll") for (int k = 0; k < 2; ++k) dst[m][k] = *(const PG8_LAS bf16x8*)(lds + PG8_SA(b, h) + aoff + m * 2048 + k * 1024); } while (0)
#define PG8_LDB(dst, b, h) do { _Pragma("unroll") for (int n = 0; n < 2; ++n) _Pragma("unroll") for (int k = 0; k < 2; ++k) dst[n][k] = *(const PG8_LAS bf16x8*)(lds + PG8_SB(b, h) + boff + n * 2048 + k * 1024); } while (0)
#define PG8_MMA(ai, bj, At, Bt) do { __builtin_amdgcn_s_setprio(1); _Pragma("unroll") for (int m = 0; m < 4; ++m) _Pragma("unroll") for (int n = 0; n < 2; ++n) _Pragma("unroll") for (int k = 0; k < 2; ++k) \
        acc[ai][bj][m][n] = __builtin_amdgcn_mfma_f32_16x16x32_bf16(Bt[n][k], At[m][k], acc[ai][bj][m][n], 0, 0, 0); __builtin_amdgcn_s_setprio(0); } while (0)
#define PG8_WAIT_V(n) asm volatile("s_waitcnt vmcnt(" #n ")" ::: "memory")
#define PG8_WAIT_L(n) asm volatile("s_waitcnt lgkmcnt(" #n ")" ::: "memory")
#define PG8_BAR __builtin_amdgcn_s_barrier()
#define PG8_SCHED __builtin_amdgcn_sched_barrier(0)
    Unit cur, nxt; int ui = 0;
    if (!S.next(0, cur)) return;
    f32x4 acc[2][2][4][2];
#pragma unroll
    for (int a = 0; a < 2; ++a)
#pragma unroll
        for (int b = 0; b < 2; ++b)
#pragma unroll
            for (int m = 0; m < 4; ++m)
#pragma unroll
                for (int n = 0; n < 2; ++n) acc[a][b][m][n] = (f32x4){0.f, 0.f, 0.f, 0.f};
    bf16x8 At[4][2], B0[2][2], B1[2][2];
    const char* cA = (const char*)g.A + (size_t)cur.pm * tstep; const char* cB = (const char*)g.Bt + (size_t)cur.pn * tstep;
    S.a_ready(cur);
    if constexpr (SP2) {
        PG8_STAGE(PG8_SB(0, 0), cB, voffB); PG8_STAGE(PG8_SB(0, 1), cB + hstep, voffB); PG8_STAGE(PG8_SA(0, 0), cA, voffA); PG8_STAGE(PG8_SA(0, 1), cA + hstep, voffA);
        if (wr == 1) PG8_BAR;
        PG8_WAIT_V(2); PG8_BAR;
        PG8_STAGE(PG8_SB(1, 0), cB + kstep, voffB); PG8_STAGE(PG8_SA(1, 0), cA + kstep, voffA); PG8_STAGE(PG8_SB(1, 1), cB + hstep + kstep, voffB);
        PG8_WAIT_V(6); PG8_BAR;
    } else {
        PG8_STAGE(PG8_SB(0, 0), cB, voffB); PG8_STAGE(PG8_SA(0, 0), cA, voffA); PG8_STAGE(PG8_SB(0, 1), cB + hstep, voffB); PG8_STAGE(PG8_SA(0, 1), cA + hstep, voffA);
        if (wr == 1) PG8_BAR;
        PG8_WAIT_V(4); PG8_BAR;
        PG8_STAGE(PG8_SB(1, 0), cB + kstep, voffB); PG8_STAGE(PG8_SA(1, 0), cA + kstep, voffA); PG8_STAGE(PG8_SB(1, 1), cB + hstep + kstep, voffB);
        PG8_WAIT_V(6); PG8_BAR;
    }
    for (;;) {
        const bool has_next = S.next(ui + 1, nxt);
        const char* nA = has_next ? (const char*)g.A + (size_t)nxt.pm * tstep : cA; const char* nB = has_next ? (const char*)g.Bt + (size_t)nxt.pn * tstep : cB;
        for (int t = 0; t < nt; t += 2) {
            const bool last = (t == nt - 2);
            const char* a1 = cA + (size_t)(t + 1) * kstep;
            const char* a2 = last ? nA : cA + (size_t)(t + 2) * kstep; const char* b2 = last ? nB : cB + (size_t)(t + 2) * kstep;
            const char* a3 = a2 + kstep; const char* b3 = b2 + kstep;
            if (last && has_next) S.a_ready(nxt);
            if constexpr (SP2) {
            PG8_LDB(B0, 0, 0); PG8_LDB(B1, 0, 1); PG8_SCHED; PG8_LDA(At, 0, 0); PG8_STAGE(PG8_SA(1, 1), a1 + hstep, voffA);
            PG8_WAIT_V(8); PG8_WAIT_L(0); PG8_BAR; PG8_MMA(0, 0, At, B0); PG8_MMA(0, 1, At, B1); PG8_BAR; PG8_SCHED;
            PG8_LDA(At, 0, 1); PG8_STAGE(PG8_SB(0, 0), b2, voffB); PG8_STAGE(PG8_SB(0, 1), b2 + hstep, voffB); PG8_STAGE(PG8_SA(0, 0), a2, voffA);
            PG8_WAIT_V(8); PG8_WAIT_L(0); PG8_BAR; PG8_MMA(1, 0, At, B0); PG8_MMA(1, 1, At, B1); PG8_BAR; PG8_SCHED;
            PG8_LDB(B0, 1, 0); PG8_LDB(B1, 1, 1); PG8_SCHED; PG8_LDA(At, 1, 0); PG8_STAGE(PG8_SA(0, 1), a2 + hstep, voffA);
            PG8_WAIT_V(8); PG8_WAIT_L(0); PG8_BAR; PG8_MMA(0, 0, At, B0); PG8_MMA(0, 1, At, B1); PG8_BAR; PG8_SCHED;
            PG8_LDA(At, 1, 1); PG8_STAGE(PG8_SB(1, 0), b3, voffB); PG8_STAGE(PG8_SB(1, 1), b3 + hstep, voffB); PG8_STAGE(PG8_SA(1, 0), a3, voffA);
            PG8_WAIT_V(8); PG8_WAIT_L(0); PG8_BAR; PG8_MMA(1, 0, At, B0); PG8_MMA(1, 1, At, B1); PG8_BAR; PG8_SCHED;
            } else {
            PG8_LDB(B0, 0, 0); PG8_SCHED; PG8_LDA(At, 0, 0); PG8_STAGE(PG8_SA(1, 1), a1 + hstep, voffA);
            PG8_WAIT_L(8); PG8_BAR; PG8_WAIT_L(0); PG8_MMA(0, 0, At, B0); PG8_BAR; PG8_SCHED;
            PG8_LDB(B1, 0, 1); PG8_STAGE(PG8_SB(0, 0), b2, voffB);
            PG8_BAR; PG8_WAIT_L(0); PG8_MMA(0, 1, At, B1); PG8_BAR;
            PG8_LDA(At, 0, 1); PG8_STAGE(PG8_SA(0, 0), a2, voffA);
            PG8_BAR; PG8_WAIT_L(0); PG8_MMA(1, 0, At, B0); PG8_BAR; PG8_SCHED;
            PG8_STAGE(PG8_SB(0, 1), b2 + hstep, voffB);
            PG8_WAIT_V(6); PG8_BAR; PG8_MMA(1, 1, At, B1); PG8_BAR;
            PG8_LDB(B0, 1, 0); PG8_SCHED; PG8_LDA(At, 1, 0); PG8_STAGE(PG8_SA(0, 1), a2 + hstep, voffA);
            PG8_WAIT_L(8); PG8_BAR; PG8_WAIT_L(0); PG8_MMA(0, 0, At, B0); PG8_BAR; PG8_SCHED;
            PG8_LDB(B1, 1, 1); PG8_STAGE(PG8_SB(1, 0), b3, voffB);
            PG8_BAR; PG8_WAIT_L(0); PG8_MMA(0, 1, At, B1); PG8_BAR;
            PG8_LDA(At, 1, 1); PG8_STAGE(PG8_SA(1, 0), a3, voffA);
            PG8_BAR; PG8_WAIT_L(0); PG8_MMA(1, 0, At, B0); PG8_BAR; PG8_SCHED;
            PG8_STAGE(PG8_SB(1, 1), b3 + hstep, voffB);
            PG8_WAIT_V(6); PG8_BAR; PG8_MMA(1, 1, At, B1); PG8_BAR;
            }
        }
        if constexpr (ALIGN_EPI) { if (wr == 0) PG8_BAR; }
        if constexpr (!Epi::AFTER_DRAIN) { E(acc, cur, wr, wc, fr, fq); S.done(cur); }
        if (!has_next) break;
#pragma unroll
        for (int a = 0; a < 2; ++a)
#pragma unroll
            for (int b = 0; b < 2; ++b)
#pragma unroll
                for (int m = 0; m < 4; ++m)
#pragma unroll
                    for (int n = 0; n < 2; ++n) acc[a][b][m][n] = (f32x4){0.f, 0.f, 0.f, 0.f};
        cur = nxt; cA = nA; cB = nB; ++ui;
        if constexpr (ALIGN_EPI) { if (wr == 1) PG8_BAR; }
    }
    PG8_WAIT_V(0);
    if constexpr (!ALIGN_EPI) { if (wr == 0) PG8_BAR; }
    PG8_BAR;
    if constexpr (Epi::AFTER_DRAIN) { E.fused(acc, cur, wr, wc, fr, fq, lds, wid, lane); S.done(cur); }
#undef PG8_SA
#undef PG8_SB
#undef PG8_STAGE
#undef PG8_LDA
#undef PG8_LDB
#undef PG8_MMA
#undef PG8_WAIT_V
#undef PG8_WAIT_L
#undef PG8_BAR
#undef PG8_SCHED
}
}
constexpr int D = 1024, NB = 4, SEQ = 4096, CTX = 256, DEPTH = 2;
constexpr int ML = NB * SEQ, MC = NB * CTX, MT = ML + MC;
constexpr int D_IN = 4608, D_POOL = 512, D_FF = 4096, MODW = 6 * D;
constexpr int TCH = 128;
constexpr int NQ = CTX / TCH + SEQ / TCH;
constexpr float EPS = 1e-6f;
constexpr size_t MiB = 1u << 20;
constexpr size_t WS_MOD = 0;
constexpr size_t WS_BAR = 256 * 1024;
constexpr size_t WS_SUMM = 512 * 1024;
constexpr size_t WS_CARRY = 2816 * 1024;
constexpr size_t WS_XC = 4 * MiB;
constexpr size_t WS_WIN = 8 * MiB, WS_WLO = 17 * MiB, WS_WPO = 19 * MiB, WS_WO = 20 * MiB, WS_W1 = 22 * MiB, WS_W2 = 30 * MiB;
constexpr size_t WS_GW = 38 * MiB;
constexpr size_t WS_PW = 39 * MiB;
constexpr size_t WS_H = 40 * MiB;
constexpr size_t WS_U = 74 * MiB;
constexpr size_t WS_G = 108 * MiB;
constexpr size_t WS_P = 142 * MiB;
constexpr size_t WS_GT = 159 * MiB;
constexpr size_t WS_PM = 227 * MiB;
constexpr size_t WS_F = WS_U;
constexpr size_t WS_END = 244 * MiB;
static_assert(WS_SUMM + (size_t)NB * 2 * NQ * 2 * 1024 * 4 <= WS_CARRY && WS_CARRY + (size_t)NB * 2 * NQ * 1024 * 4 <= WS_XC, "ws map (small)");
static_assert(WS_F + (size_t)MT * D_FF * 2 <= WS_PM && WS_H + (size_t)MT * D * 2 <= WS_U && WS_GT + (size_t)MT * 2048 * 2 <= WS_PM, "ws map");
constexpr int LDS_BYTES = 136 * 1024;

#define LAS __attribute__((address_space(3)))
typedef unsigned short bf16;
typedef unsigned u32x4 __attribute__((ext_vector_type(4)));
typedef unsigned u32x2 __attribute__((ext_vector_type(2)));
typedef float f32x4 __attribute__((ext_vector_type(4)));
typedef float f32x16 __attribute__((ext_vector_type(16)));
typedef short bf16x8 __attribute__((ext_vector_type(8)));
using pg8::cvt_pk_bf16; using pg8::bf_lo; using pg8::bf_hi; using pg8::sigm;

struct Args { const float* in[24]; float* out; unsigned char* ws; int lo, hi; };
enum { I_X = 0, I_C, I_CTX, I_CCTX, I_WADA, I_BADA, I_N1G, I_N2G, I_WIN, I_CONVW, I_CONVB, I_WR, I_BR, I_WI, I_BI, I_LAM, I_WLO, I_POOLW, I_POOLS, I_WPO, I_WO, I_W1, I_W2, I_FG };

__device__ __forceinline__ float wave_sum(float v) {
#pragma unroll
    for (int o = 1; o < 64; o <<= 1) v += __shfl_xor(v, o);
    return v;
}
__device__ __forceinline__ float gelu_tanh(float x) { const float z = 0.7978845608f * (x + 0.044715f * x * x * x); const float e = __expf(2.f * z); return 0.5f * x * (2.f - 2.f * __builtin_amdgcn_rcpf(e + 1.f)); }

__device__ __forceinline__ void mod_item(const Args& a, LAS unsigned char* lds, int item) {
    const int tid = opaque_tid(), l = item / 96, cb = item % 96, cq = tid & 15, kg = tid >> 4;
    LAS float* s = (LAS float*)lds;
    LAS float* part = (LAS float*)(lds + 20480);
    const float* c = a.in[I_C]; const float* cc = a.in[I_CCTX];
    for (int i = tid; i < 5120; i += 512) { const int r = i >> 10, k = i & 1023; const float v = r < 4 ? c[r * 1024 + k] : cc[k]; s[i] = v * sigm(v); }
    __syncthreads();
    const float* W = a.in[I_WADA] + (size_t)l * D * MODW + cb * 64 + cq * 4;
    float acc[5][4];
#pragma unroll
    for (int r = 0; r < 5; ++r)
#pragma unroll
        for (int j = 0; j < 4; ++j) acc[r][j] = 0.f;
#pragma unroll 8
    for (int kk = 0; kk < 32; ++kk) { const int k = kg * 32 + kk; const f32x4 w = *(const f32x4*)(W + (size_t)k * MODW);
#pragma unroll
        for (int r = 0; r < 5; ++r) { const float sv = s[r * 1024 + k];
#pragma unroll
            for (int j = 0; j < 4; ++j) acc[r][j] += sv * w[j]; } }
#pragma unroll
    for (int r = 0; r < 5; ++r)
#pragma unroll
        for (int j = 0; j < 4; ++j) part[(kg * 5 + r) * 64 + cq * 4 + j] = acc[r][j];
    __syncthreads();
    if (tid < 320) { const int r = tid >> 6, col = tid & 63; float t = 0.f;
#pragma unroll 8
        for (int g = 0; g < 32; ++g) t += part[(g * 5 + r) * 64 + col];
        ((float*)(a.ws + WS_MOD))[(size_t)(l * 5 + r) * MODW + cb * 64 + col] = t + a.in[I_BADA][l * MODW + cb * 64 + col]; }
    __syncthreads();
}
__device__ __forceinline__ void transpose_item(const float* W, int K, int N, bf16* WT, LAS float* scr, int item, int lane) {
    const int nblk = N / 32, kb = item / nblk, nb = item % nblk, k0 = 64 * kb, n0 = 32 * nb;
#pragma unroll 8
    for (int i = 0; i < 32; ++i) { const int kk = 2 * i + (lane >> 5); scr[kk * 33 + (lane & 31)] = W[(size_t)(k0 + kk) * N + n0 + (lane & 31)]; }
    asm volatile("s_waitcnt lgkmcnt(0)" ::: "memory");
    const int c = lane & 7;
#pragma unroll
    for (int j = 0; j < 4; ++j) { const int n = (lane >> 3) + 8 * j; const LAS float* s = scr + (8 * c) * 33 + n;
        u32x4 o; o.x = cvt_pk_bf16(s[0 * 33], s[1 * 33]); o.y = cvt_pk_bf16(s[2 * 33], s[3 * 33]); o.z = cvt_pk_bf16(s[4 * 33], s[5 * 33]); o.w = cvt_pk_bf16(s[6 * 33], s[7 * 33]);
        *(u32x4*)(WT + (size_t)(n0 + n) * K + k0 + 8 * c) = o; }
    asm volatile("s_waitcnt lgkmcnt(0)" ::: "memory");
}
__device__ __forceinline__ void convert_big(const Args& a, LAS unsigned char* lds, int l, int gw, int NGW, int wave, int lane) {
    LAS float* scr = (LAS float*)(lds + wave * 16384);
    constexpr int I_IN = (D / 64) * (D_IN / 32), I_LO = (D / 64) * (D / 32), I_PO = (D_POOL / 64) * (D / 32), I_O = I_LO, I_1 = (D / 64) * (D_FF / 32), I_2 = (D_FF / 64) * (D / 32);
    constexpr int NIT = I_IN + I_LO + I_PO + I_O + I_1 + I_2;
    unsigned char* ws = a.ws;
    for (int it = gw; it < NIT; it += NGW) { int r = it;
        if (r < I_IN) { transpose_item(a.in[I_WIN] + (size_t)l * D * D_IN, D, D_IN, (bf16*)(ws + WS_WIN), scr, r, lane); continue; } r -= I_IN;
        if (r < I_LO) { transpose_item(a.in[I_WLO] + (size_t)l * D * D, D, D, (bf16*)(ws + WS_WLO), scr, r, lane); continue; } r -= I_LO;
        if (r < I_PO) { transpose_item(a.in[I_WPO] + (size_t)l * D_POOL * D, D_POOL, D, (bf16*)(ws + WS_WPO), scr, r, lane); continue; } r -= I_PO;
        if (r < I_O) { transpose_item(a.in[I_WO] + (size_t)l * D * D, D, D, (bf16*)(ws + WS_WO), scr, r, lane); continue; } r -= I_O;
        if (r < I_1) { transpose_item(a.in[I_W1] + (size_t)l * D * D_FF, D, D_FF, (bf16*)(ws + WS_W1), scr, r, lane); continue; } r -= I_1;
        transpose_item(a.in[I_W2] + (size_t)l * D_FF * D, D_FF, D, (bf16*)(ws + WS_W2), scr, r, lane); }
}
__device__ __forceinline__ void convert_small(const Args& a, LAS unsigned char* lds, int gw, int NGW, int wave, int lane) {
    LAS float* scr = (LAS float*)(lds + wave * 16384);
    for (int it = gw; it < 256 + 64; it += NGW) {
        if (it < 256) { const int mi = it >> 1, sub = it & 1, h = mi & 15, ri = (mi >> 4) & 1, ld = mi >> 5;
            const float* src = a.in[ri ? I_WI : I_WR] + ((size_t)ld * 16 + h) * 4096;
            transpose_item(src, 64, 64, (bf16*)(a.ws + WS_GW) + ((size_t)(ld * 2 + ri) * 16 + h) * 4096, scr, sub, lane); }
        else { const int r = it - 256, mi = r >> 3, sub = r & 7;
            transpose_item(a.in[I_POOLW] + (size_t)mi * 16384, 128, 128, (bf16*)(a.ws + WS_PW) + (size_t)mi * 16384, scr, sub, lane); }
    }
}
__device__ __forceinline__ void norm_rows(const float* xl, const float* xc, bf16* H, const float* gvec, const float* mod  , int shift_i, int scale_i, int nrows, int gw, int NGW, int lane) {
    for (int m = gw; m < nrows; m += NGW) {
        const float* xr = m < ML ? xl + (size_t)m * D : xc + (size_t)(m - ML) * D; const int r = m < ML ? (m >> 12) : 4;
        const f32x4* x4 = (const f32x4*)xr + lane; f32x4 v[4]; float ss = 0.f;
#pragma unroll
        for (int j = 0; j < 4; ++j) { v[j] = x4[64 * j]; ss += (v[j].x * v[j].x + v[j].y * v[j].y) + (v[j].z * v[j].z + v[j].w * v[j].w); }
        const float rstd = 1.0f / sqrtf(wave_sum(ss) * (1.f / D) + EPS);
        const f32x4* g4 = (const f32x4*)gvec + lane; const f32x4* sc4 = (const f32x4*)(mod + (size_t)r * MODW + scale_i * D) + lane; const f32x4* sh4 = (const f32x4*)(mod + (size_t)r * MODW + shift_i * D) + lane;
        u32x2* o = (u32x2*)(H + (size_t)m * D) + lane;
#pragma unroll
        for (int j = 0; j < 4; ++j) { const f32x4 h = v[j] * rstd * g4[64 * j] * (1.0f + sc4[64 * j]) + sh4[64 * j]; u32x2 w; w.x = cvt_pk_bf16(h.x, h.y); w.y = cvt_pk_bf16(h.z, h.w); o[64 * j] = w; }
    }
}
__device__ __forceinline__ void final_rows(float* x, const float* gvec, int gw, int NGW, int lane) {
    for (int m = gw; m < ML; m += NGW) {
        f32x4* x4 = (f32x4*)(x + (size_t)m * D) + lane; f32x4 v[4]; float ss = 0.f;
#pragma unroll
        for (int j = 0; j < 4; ++j) { v[j] = x4[64 * j]; ss += (v[j].x * v[j].x + v[j].y * v[j].y) + (v[j].z * v[j].z + v[j].w * v[j].w); }
        const float rstd = 1.0f / sqrtf(wave_sum(ss) * (1.f / D) + EPS);
        const f32x4* g4 = (const f32x4*)gvec + lane;
#pragma unroll
        for (int j = 0; j < 4; ++j) x4[64 * j] = v[j] * rstd * g4[64 * j];
    }
}
constexpr int SC_A = 0, SC_B = 32768, SC_HF = 65536, SC_UCB = 98304, SC_UROW = 144  , SC_SEG = SC_UCB + TCH * SC_UROW;
static_assert(SC_SEG + 4096 <= 131072, "scan LDS");
template <bool PASSB>
__device__ __forceinline__ void scan_item(const Args& a, LAS unsigned char* lds, int l, int item) {
    const int tid = opaque_tid(), lane = tid & 63, wave = __builtin_amdgcn_readfirstlane(tid >> 6);
    int b, chunk, h, seqbase, L, q;
    if (item < 2048) { b = item >> 9; const int rem = item & 511; chunk = rem >> 4; h = rem & 15; seqbase = b * SEQ; L = SEQ; q = 2 + chunk; }
    else { const int it = item - 2048; b = it >> 5; const int rem = it & 31; chunk = rem >> 4; h = rem & 15; seqbase = ML + b * CTX; L = CTX; q = chunk; }
    const int t0 = chunk * TCH;
    const bf16* U = (const bf16*)(a.ws + WS_U);
    LAS float* Al = (LAS float*)(lds + SC_A); LAS float* Bl = (LAS float*)(lds + SC_B); LAS float* Hf = (LAS float*)(lds + SC_HF);
    LAS float* segA = (LAS float*)(lds + SC_SEG); LAS float* segB = segA + 512;
    {
        const int t = tid >> 2, cgp = tid & 3, ch0 = h * 64 + cgp * 16;
        const float* cw = a.in[I_CONVW] + (size_t)l * 4 * D + ch0; const float* cb = a.in[I_CONVB] + (size_t)l * D + ch0;
#pragma unroll
        for (int hh = 0; hh < 2; ++hh) {
            float uc[8];
            { const f32x4 b0 = *(const f32x4*)(cb + hh * 8), b1 = *(const f32x4*)(cb + hh * 8 + 4);
              uc[0] = b0.x; uc[1] = b0.y; uc[2] = b0.z; uc[3] = b0.w; uc[4] = b1.x; uc[5] = b1.y; uc[6] = b1.z; uc[7] = b1.w; }
#pragma unroll
            for (int j = 0; j < 4; ++j) { const int tt = t0 + t - 2 + j;
                u32x4 uv = (u32x4){0u, 0u, 0u, 0u};
                if (tt >= 0 && tt < L) uv = *(const u32x4*)(U + (size_t)(seqbase + tt) * D + ch0 + hh * 8);
                const f32x4 w0 = *(const f32x4*)(cw + j * D + hh * 8), w1 = *(const f32x4*)(cw + j * D + hh * 8 + 4);
                uc[0] += w0.x * bf_lo(uv.x); uc[1] += w0.y * bf_hi(uv.x); uc[2] += w0.z * bf_lo(uv.y); uc[3] += w0.w * bf_hi(uv.y);
                uc[4] += w1.x * bf_lo(uv.z); uc[5] += w1.y * bf_hi(uv.z); uc[6] += w1.z * bf_lo(uv.w); uc[7] += w1.w * bf_hi(uv.w); }
            u32x4 o; o.x = cvt_pk_bf16(uc[0], uc[1]); o.y = cvt_pk_bf16(uc[2], uc[3]); o.z = cvt_pk_bf16(uc[4], uc[5]); o.w = cvt_pk_bf16(uc[6], uc[7]);
            *(LAS u32x4*)(lds + SC_UCB + t * SC_UROW + (cgp * 16 + hh * 8) * 2) = o;
        }
    }
    __syncthreads();
    const int tb = wave >> 1, nb = wave & 1, l31 = lane & 31, lh = lane >> 5, e = nb * 32 + l31, ch = h * 64 + e;
    bf16x8 af[4];
#pragma unroll
    for (int ks = 0; ks < 4; ++ks) af[ks] = *(const LAS bf16x8*)(lds + SC_UCB + (tb * 32 + l31) * SC_UROW + (ks * 16 + lh * 8) * 2);
    const int sseg = tid >> 6, sc = tid & 63;
#pragma unroll 1
    for (int dir = 0; dir < 2; ++dir) {
        const int ld = l * 2 + dir;
        const bf16* gwr = (const bf16*)(a.ws + WS_GW) + ((size_t)((ld * 2 + 0) * 16 + h) * 64 + e) * 64 + lh * 8;
        const bf16* gwi = (const bf16*)(a.ws + WS_GW) + ((size_t)((ld * 2 + 1) * 16 + h) * 64 + e) * 64 + lh * 8;
        f32x16 ar, ai;
#pragma unroll
        for (int i = 0; i < 16; ++i) { ar[i] = 0.f; ai[i] = 0.f; }
#pragma unroll
        for (int ks = 0; ks < 4; ++ks) { const bf16x8 br = *(const bf16x8*)(gwr + ks * 16), bi = *(const bf16x8*)(gwi + ks * 16);
            ar = __builtin_amdgcn_mfma_f32_32x32x16_bf16(af[ks], br, ar, 0, 0, 0); ai = __builtin_amdgcn_mfma_f32_32x32x16_bf16(af[ks], bi, ai, 0, 0, 0); }
        const float brr = a.in[I_BR][ld * D + ch], bii = a.in[I_BI][ld * D + ch], lam = a.in[I_LAM][ld * D + ch];
        const float sp = fmaxf(-lam, 0.f) + log1pf(__expf(-fabsf(lam)));
#pragma unroll
        for (int reg = 0; reg < 16; ++reg) { const int t = tb * 32 + (reg & 3) + 8 * (reg >> 2) + 4 * lh;
            const float r = sigm(ar[reg] + brr), ig = sigm(ai[reg] + bii);
            const float la = -8.0f * r * sp, av = __expf(la), mult = sqrtf(fmaxf(-expm1f(2.0f * la), 0.f));
            const float ucv = __uint_as_float((unsigned)(*(const LAS unsigned short*)(lds + SC_UCB + t * SC_UROW + e * 2)) << 16);
            Al[t * 64 + e] = av; Bl[t * 64 + e] = mult * ig * ucv; }
        __syncthreads();
        float pA = 1.f, pB = 0.f;
#pragma unroll
        for (int k = 0; k < 16; ++k) { const int t = dir ? (sseg * 16 + 15 - k) : (sseg * 16 + k); const float av = Al[t * 64 + sc], bv = Bl[t * 64 + sc]; pB = av * pB + bv; pA *= av; }
        segA[sseg * 64 + sc] = pA; segB[sseg * 64 + sc] = pB;
        __syncthreads();
        const int gch = h * 64 + sc;
        if (!PASSB) {
            if (tid < 64) { float tA = 1.f, tB = 0.f;
#pragma unroll
                for (int k = 0; k < 8; ++k) { const int s2 = dir ? 7 - k : k; const float sa = segA[s2 * 64 + sc], sb = segB[s2 * 64 + sc]; tB = sa * tB + sb; tA *= sa; }
                float* sm = (float*)(a.ws + WS_SUMM) + ((size_t)((b * 2 + dir) * NQ + q) * 2) * 1024 + gch;
                sm[0] = tA; sm[1024] = tB; }
        } else {
            float hs = ((const float*)(a.ws + WS_CARRY))[(size_t)((b * 2 + dir) * NQ + q) * 1024 + gch];
            const int npre = dir ? 7 - sseg : sseg;
            for (int k = 0; k < npre; ++k) { const int s2 = dir ? 7 - k : k; hs = segA[s2 * 64 + sc] * hs + segB[s2 * 64 + sc]; }
#pragma unroll
            for (int k = 0; k < 16; ++k) { const int t = dir ? (sseg * 16 + 15 - k) : (sseg * 16 + k); hs = Al[t * 64 + sc] * hs + Bl[t * 64 + sc];
                if (dir == 0) Hf[t * 64 + sc] = hs; else Hf[t * 64 + sc] += hs; }
        }
        __syncthreads();
    }
    if (PASSB) {
        const int t = tid >> 2, cgp = tid & 3; const size_t row = (size_t)(seqbase + t0 + t);
        const bf16* G = (const bf16*)(a.ws + WS_G) + row * D + h * 64 + cgp * 16; bf16* HL = (bf16*)(a.ws + WS_H) + row * D + h * 64 + cgp * 16;
#pragma unroll
        for (int hh = 0; hh < 2; ++hh) { const u32x4 gv = *(const u32x4*)(G + hh * 8);
            const f32x4 h0 = *(const LAS f32x4*)(Hf + t * 64 + cgp * 16 + hh * 8), h1 = *(const LAS f32x4*)(Hf + t * 64 + cgp * 16 + hh * 8 + 4);
            u32x4 o; o.x = cvt_pk_bf16(h0.x * gelu_tanh(bf_lo(gv.x)), h0.y * gelu_tanh(bf_hi(gv.x))); o.y = cvt_pk_bf16(h0.z * gelu_tanh(bf_lo(gv.y)), h0.w * gelu_tanh(bf_hi(gv.y)));
            o.z = cvt_pk_bf16(h1.x * gelu_tanh(bf_lo(gv.z)), h1.y * gelu_tanh(bf_hi(gv.z))); o.w = cvt_pk_bf16(h1.z * gelu_tanh(bf_lo(gv.w)), h1.w * gelu_tanh(bf_hi(gv.w)));
            *(u32x4*)(HL + hh * 8) = o; }
        __syncthreads();
    }
}
__device__ __forceinline__ void carry_phase(const Args& a) {
    const float* sm = (const float*)(a.ws + WS_SUMM); float* cr = (float*)(a.ws + WS_CARRY);
    const int tid = opaque_tid();
    for (int idx = blockIdx.x * 64 + tid; tid < 64 && idx < NB * 2 * 1024; idx += gridDim.x * 64) {
        const int chn = idx & 1023, bd = idx >> 10, dir = bd & 1;
        const float* s0 = sm + (size_t)bd * NQ * 2048 + chn; float* c0 = cr + (size_t)bd * NQ * 1024 + chn;
        float hs = 0.f;
#pragma unroll 2
        for (int k = 0; k < NQ; ++k) { int q;
            if (dir == 0) q = k; else q = (k < 2) ? 1 - k : (NQ + 1 - k);
            c0[(size_t)q * 1024] = hs; hs = s0[(size_t)q * 2048] * hs + s0[(size_t)q * 2048 + 1024]; }
    }
}
constexpr int PL_PF = 0  , PL_MB = 40960  , PL_MROW = 272;
__device__ __forceinline__ void pool_item(const Args& a, LAS unsigned char* lds, int l, int item) {
    const int tid = opaque_tid(), lane = tid & 63, wave = __builtin_amdgcn_readfirstlane(tid >> 6);
    int g, R0, L, t0;
    if (item < 1024) { g = item & 3; R0 = (item >> 2) * 64; L = 64; t0 = 0; }
    else { const int it = item - 1024; g = it & 3; const int blk = (it >> 2) & 3, b = it >> 4; R0 = ML + b * CTX; L = CTX; t0 = blk * 64; }
    const bf16* P = (const bf16*)(a.ws + WS_P); LAS float* pf = (LAS float*)(lds + PL_PF);
    for (int idx = tid; idx < 1280; idx += 512) { const int row = idx >> 4, c8 = (idx & 15) * 8, tt = t0 - 8 + row;
        if (tt >= 0 && tt < L) { const u32x4 v = *(const u32x4*)(P + (size_t)(R0 + tt) * D_POOL + g * 128 + c8);
            *(LAS f32x4*)(pf + row * 128 + c8) = (f32x4){bf_lo(v.x), bf_hi(v.x), bf_lo(v.y), bf_hi(v.y)}; *(LAS f32x4*)(pf + row * 128 + c8 + 4) = (f32x4){bf_lo(v.z), bf_hi(v.z), bf_lo(v.w), bf_hi(v.w)}; } }
    __syncthreads();
    { const int c = tid & 127, tq = tid >> 7, hw = 1 << g;
      for (int k = 0; k < 16; ++k) { const int t = tq * 16 + k, tt = t0 + t; const int lo = max(tt - hw, 0), hi = min(tt + hw, L); float s = 0.f;
          for (int u = lo; u < hi; ++u) s += pf[(u - t0 + 8) * 128 + c];
          const float mval = s / (float)(hi - lo) - pf[(t + 8) * 128 + c];
          *(LAS unsigned short*)(lds + PL_MB + t * PL_MROW + c * 2) = (unsigned short)(cvt_pk_bf16(mval, 0.f) & 0xffffu); } }
    __syncthreads();
    { const int mblk = wave & 1, nblk = wave >> 1, l31 = lane & 31, lh = lane >> 5, e = nblk * 32 + l31;
      const bf16* pw = (const bf16*)(a.ws + WS_PW) + ((size_t)(l * 4 + g) * 128 + e) * 128 + lh * 8;
      f32x16 acc;
#pragma unroll
      for (int i = 0; i < 16; ++i) acc[i] = 0.f;
#pragma unroll
      for (int ks = 0; ks < 8; ++ks) { const bf16x8 af = *(const LAS bf16x8*)(lds + PL_MB + (mblk * 32 + l31) * PL_MROW + (ks * 16 + lh * 8) * 2); const bf16x8 bw = *(const bf16x8*)(pw + ks * 16);
          acc = __builtin_amdgcn_mfma_f32_32x32x16_bf16(af, bw, acc, 0, 0, 0); }
      const float scl = a.in[I_POOLS][l * D_POOL + g * 128 + e];
      bf16* PM = (bf16*)(a.ws + WS_PM) + (size_t)(R0 + t0) * D_POOL + g * 128 + e;
#pragma unroll
      for (int reg = 0; reg < 16; ++reg) { const int t = mblk * 32 + (reg & 3) + 8 * (reg >> 2) + 4 * lh; PM[(size_t)t * D_POOL] = (bf16)(cvt_pk_bf16(acc[reg] * scl, 0.f) & 0xffffu); } }
    __syncthreads();
}
#define XB_TMO      128
#define XB_XCNT(j)  (256  + 64 * (j))
#define XB_XSUB(j)  (1280 + 64 * (j))
#define XB_XGEN(j)  (2304 + 64 * (j))
#define XB_TOP      3328
#define XB_TOPGEN   3392
#define XCD_BAR_WORDS 3456
#define XB_SPIN_CAP (1u << 18)

__device__ __forceinline__ unsigned xb_ld(unsigned* p)              { return __hip_atomic_load(p, __ATOMIC_RELAXED, __HIP_MEMORY_SCOPE_AGENT); }
__device__ __forceinline__ unsigned xb_add(unsigned* p, unsigned v) { return __hip_atomic_fetch_add(p, v, __ATOMIC_RELAXED, __HIP_MEMORY_SCOPE_AGENT); }
__device__ __forceinline__ unsigned xb_xcc_id() { return (unsigned)__builtin_amdgcn_s_getreg((3 << 11) | 20) & 0xFu; }
#define XB_SPIN(cond, bar) do { unsigned _sp = 0; while (cond) { __builtin_amdgcn_s_sleep(1); \
    if ((++_sp & 255u) == 0u) { if (xb_ld(&(bar)[XB_TMO])) break; if (_sp > XB_SPIN_CAP) { atomicAdd(&(bar)[XB_TMO], 1u); break; } } } } while (0)

struct XcdBarrier {
    unsigned* bar; unsigned x;
    volatile LAS unsigned* st;
};

__device__ __forceinline__ XcdBarrier xcd_barrier_post(unsigned* bar, volatile LAS unsigned* st) {
    XcdBarrier b; b.bar = bar; b.x = xb_xcc_id(); b.st = st;
    if (threadIdx.x == 0) (void)xb_add(&bar[XB_XCNT(b.x)], 1u);
    return b;
}
__device__ __forceinline__ void xcd_barrier_complete(unsigned* bar, unsigned x, unsigned& nloc, unsigned& nx) {
    const unsigned G = gridDim.x * gridDim.y * gridDim.z;
    unsigned sum, cnt, mine, sp = 0u;
    for (;;) {
        sum = 0u; cnt = 0u; mine = 0u;
#pragma unroll
        for (unsigned j = 0; j < 16; ++j) { const unsigned c = xb_ld(&bar[XB_XCNT(j)]); sum += c; cnt += (c > 0u) ? 1u : 0u; mine = (j == x) ? c : mine; }
        if (sum == G) break;
        __builtin_amdgcn_s_sleep(1);
        if ((++sp & 255u) == 0u) { if (xb_ld(&bar[XB_TMO])) break; if (sp > XB_SPIN_CAP) { atomicAdd(&bar[XB_TMO], 1u); break; } }
    }
    nloc = mine > 0u ? mine : 1u; nx = cnt > 0u ? cnt : 1u;
}

__device__ __forceinline__ void xcd_barrier(const XcdBarrier& b) {
    asm volatile("s_waitcnt vmcnt(0)" ::: "memory");
    __syncthreads();
    if (threadIdx.x == 0) {
        unsigned* bar = b.bar;
        __builtin_amdgcn_s_waitcnt(0);
        unsigned nloc = b.st[0], nx = b.st[1];
        if (nloc == 0u) { xcd_barrier_complete(bar, b.x, nloc, nx); b.st[0] = nloc; b.st[1] = nx; }
        const unsigned old = xb_add(&bar[XB_XSUB(b.x)], 1u);
        const unsigned gen = old / nloc;
        if (old + 1u == (gen + 1u) * nloc) {
            __builtin_amdgcn_fence(__ATOMIC_RELEASE, "agent");
            asm volatile("s_waitcnt vmcnt(0)" ::: "memory");
            const unsigned og = xb_add(&bar[XB_TOP], 1u);
            const unsigned tg = og / nx;
            if (og + 1u == (tg + 1u) * nx) xb_add(&bar[XB_TOPGEN], 1u);
            else XB_SPIN(xb_ld(&bar[XB_TOPGEN]) == tg, bar);
            __builtin_amdgcn_fence(__ATOMIC_ACQUIRE, "agent");
            xb_add(&bar[XB_XGEN(b.x)], 1u);
            asm volatile("s_waitcnt vmcnt(0)" ::: "memory");
        } else {
            XB_SPIN(xb_ld(&bar[XB_XGEN(b.x)]) == gen, bar);
            __builtin_amdgcn_fence(__ATOMIC_ACQUIRE, "agent");
            asm volatile("s_waitcnt vmcnt(0)" ::: "memory");
        }
    }
    __syncthreads();
}

constexpr int NPHASE = 22;
__global__ void __launch_bounds__(512, 2) mk_fwd(Args a) {
    extern __shared__ __attribute__((aligned(16))) unsigned char lds_raw[];
    LAS unsigned char* lds = (LAS unsigned char*)lds_raw;
    cg::grid_group grid = cg::this_grid();
    volatile LAS unsigned* MISC = (volatile LAS unsigned*)(lds + 131072);
    if (threadIdx.x < 64) MISC[threadIdx.x] = 0u;
    __syncthreads();
    XcdBarrier xbar; xbar.bar = (unsigned*)(a.ws + WS_BAR); xbar.x = 0; xbar.st = MISC + 8;
    if (a.hi - a.lo > 1) xbar = xcd_barrier_post((unsigned*)(a.ws + WS_BAR), MISC + 8);
    const int G = gridDim.x, bx = blockIdx.x, NGW = G * 8;
#define WL() const int tid_ = opaque_tid(), lane = tid_ & 63, wave = __builtin_amdgcn_readfirstlane(tid_ >> 6), gw = bx * 8 + wave
    const int lo = a.lo, hi = a.hi;
    unsigned char* ws = a.ws;
    float* MOD = (float*)(ws + WS_MOD); float* XC = (float*)(ws + WS_XC);
    bf16* Hb = (bf16*)(ws + WS_H); bf16* Ub = (bf16*)(ws + WS_U); bf16* Gb = (bf16*)(ws + WS_G); bf16* Pb = (bf16*)(ws + WS_P); bf16* GTb = (bf16*)(ws + WS_GT); bf16* PMb = (bf16*)(ws + WS_PM); bf16* Fb = (bf16*)(ws + WS_F);
#ifndef PH_MASK
#define PH_MASK 0xfff
#endif
#define IN(k) (lo <= (k) && (k) < hi)
#define ON(b) ((PH_MASK >> (b)) & 1)
#ifndef REP_MASK
#define REP_MASK 0
#endif
#define REPS(b) for (int rep_ = 0; rep_ < 1 + ((REP_MASK >> (b)) & 1); ++rep_)
#ifndef SYNC_REP
#define SYNC_REP 1
#endif
#define SEAM(k) do { if (IN(k) && IN((k) + 1)) for (int sr_ = 0; sr_ < SYNC_REP; ++sr_) { if ((k) == 0) grid.sync(); else xcd_barrier(xbar); } } while (0)
    if (ON(0) && IN(0)) REPS(0) {
        for (int it = bx; it < 192; it += G) mod_item(a, lds, it);
        WL();
        convert_small(a, lds, gw, NGW, wave, lane);
        convert_big(a, lds, 0, gw, NGW, wave, lane);
    }
    SEAM(0);
#pragma unroll 1
    for (int l = 0; l < DEPTH; ++l) {
        const int pb = 1 + 10 * l; const bool last = (l == DEPTH - 1);
        const float* modl = MOD + (size_t)l * 5 * MODW;
        const float* xsrcL = l == 0 ? a.in[I_X] : a.out; const float* xsrcC = l == 0 ? a.in[I_CTX] : XC;
        const int Mrest = last ? ML : MT;
        if (ON(1) && IN(pb + 0)) REPS(1) {
            WL();
            if (l > 0) convert_big(a, lds, l, gw, NGW, wave, lane);
            norm_rows(xsrcL, xsrcC, Hb, a.in[I_N1G] + l * D, modl, 0, 1, MT, gw, NGW, lane);
        }
        SEAM(pb + 0);
        if (ON(2) && IN(pb + 1)) REPS(2) {
            pg8::Gemm g{Hb, (const bf16*)(ws + WS_WIN), MT, D_IN, D}; pg8::StaticOrder S; S.init(MT, D_IN, G, bx);
            pg8::EpiSplit E{Ub, Gb, Pb, GTb};
            pg8::gemm_phase<pg8::EpiSplit, pg8::StaticOrder, true, true>(lds, g, S, E);
        }
        SEAM(pb + 1);
        if (ON(3) && IN(pb + 2)) REPS(3) {
            const int npool = last ? 1024 : 1088;
            for (int it = bx; it < 2176 + npool; it += G) { if (it < 2176) scan_item<false>(a, lds, l, it); else pool_item(a, lds, l, it - 2176); }
        }
        SEAM(pb + 2);
        if (ON(4) && IN(pb + 3)) REPS(4) carry_phase(a);
        SEAM(pb + 3);
        if (ON(5) && IN(pb + 4)) REPS(5) { const int nit = last ? 2048 : 2176; for (int it = bx; it < nit; it += G) scan_item<true>(a, lds, l, it); }
        SEAM(pb + 4);
        if (ON(6) && IN(pb + 5)) REPS(6) {
            { pg8::Gemm g{PMb, (const bf16*)(ws + WS_WPO), Mrest, D, D_POOL}; pg8::StaticOrder S; S.init(Mrest, D, G, bx);
              pg8::EpiGate<0> E{Ub, GTb}; pg8::gemm_phase<pg8::EpiGate<0>, pg8::StaticOrder, true, true>(lds, g, S, E); }
            { pg8::Gemm g{Hb, (const bf16*)(ws + WS_WLO), Mrest, D, D}; pg8::StaticOrder S; S.init(Mrest, D, G, bx);
              pg8::EpiGate<1> E{Ub, GTb}; pg8::gemm_phase<pg8::EpiGate<1>, pg8::StaticOrder, true, true>(lds, g, S, E); }
        }
        SEAM(pb + 5);
        if (ON(7) && IN(pb + 6)) {
            pg8::Gemm g{Ub, (const bf16*)(ws + WS_WO), Mrest, D, D}; pg8::StaticOrder S; S.init(Mrest, D, G, bx);
            pg8::EpiRes E{xsrcL, xsrcC, a.out, XC, modl + 2 * D};
            pg8::gemm_phase<pg8::EpiRes, pg8::StaticOrder, true, true>(lds, g, S, E);
        }
        SEAM(pb + 6);
        if (ON(8) && IN(pb + 7)) REPS(8) { WL(); norm_rows(a.out, XC, Hb, a.in[I_N2G] + l * D, modl, 3, 4, Mrest, gw, NGW, lane); }
        SEAM(pb + 7);
        if (ON(9) && IN(pb + 8)) REPS(9) {
            pg8::Gemm g{Hb, (const bf16*)(ws + WS_W1), Mrest, D_FF, D}; pg8::StaticOrder S; S.init(Mrest, D_FF, G, bx);
            pg8::EpiSqRelu E{Fb, D_FF};
            pg8::gemm_phase<pg8::EpiSqRelu, pg8::StaticOrder, true, true>(lds, g, S, E);
        }
        SEAM(pb + 8);
        if (ON(10) && IN(pb + 9)) {
            pg8::Gemm g{Fb, (const bf16*)(ws + WS_W2), Mrest, D, D_FF}; pg8::StaticOrder S; S.init(Mrest, D, G, bx);
            pg8::EpiRes E{a.out, XC, a.out, XC, modl + 5 * D};
            pg8::gemm_phase<pg8::EpiRes, pg8::StaticOrder, true, true>(lds, g, S, E);
        }
        SEAM(pb + 9);
    }
    if (ON(11) && IN(21)) { WL(); final_rows(a.out, a.in[I_FG], gw, NGW, lane); }
#undef IN
#undef SEAM
}

extern "C" void kernel_launch(void* const* d_in, const int* in_sizes, int n_in, void* d_out, int out_size, void* d_ws, size_t ws_size, hipStream_t stream) {
    static int grid = 0;
    if (grid == 0) {
        if (n_in != 24 || out_size != ML * D || ws_size < WS_END) { fprintf(stderr, "kernel_launch: unexpected shapes (n_in %d, out %d, ws %zu)\n", n_in, out_size, ws_size); grid = -1; return; }
        int dev = 0, cus = 0, per_cu = 0;
        if (hipGetDevice(&dev) != hipSuccess || hipDeviceGetAttribute(&cus, hipDeviceAttributeMultiprocessorCount, dev) != hipSuccess) { grid = -1; return; }
        if (hipFuncSetAttribute((const void*)mk_fwd, hipFuncAttributeMaxDynamicSharedMemorySize, LDS_BYTES) != hipSuccess) { fprintf(stderr, "kernel_launch: hipFuncSetAttribute failed\n"); grid = -1; return; }
        if (hipOccupancyMaxActiveBlocksPerMultiprocessor(&per_cu, (const void*)mk_fwd, 512, LDS_BYTES) != hipSuccess || per_cu < 1) { fprintf(stderr, "kernel_launch: occupancy query says %d\n", per_cu); per_cu = 1; }
        (void)hipGetLastError();
        grid = cus;
    }
    if (grid < 0) return;
    Args a{};
    for (int i = 0; i < 24; ++i) a.in[i] = (const float*)d_in[i];
    a.out = (float*)d_out; a.ws = (unsigned char*)d_ws;
#if MK_PER_PHASE
    for (int p = 0; p < NPHASE; ++p) { a.lo = p; a.hi = p + 1; hipLaunchKernelGGL(mk_fwd, dim3(grid), dim3(512), LDS_BYTES, stream, a); }
#else
    a.lo = 0; a.hi = NPHASE;
    if (hipMemsetAsync((char*)d_ws + WS_BAR, 0, 16384, stream) != hipSuccess) { fprintf(stderr, "kernel_launch: memset of the barrier words failed\n"); return; }
    void* args[] = {&a};
    hipError_t e = hipLaunchCooperativeKernel((const void*)mk_fwd, dim3(grid), dim3(512), args, LDS_BYTES, stream);
    if (e != hipSuccess) fprintf(stderr, "kernel_launch: cooperative launch failed: %s (grid %d)\n", hipGetErrorString(e), grid);
#endif
}
```

```cpp
#include <hip/hip_runtime.h>
#include <hip/hip_cooperative_groups.h>
#include <cstdio>
#include <cstdint>
namespace cg = cooperative_groups;
#ifndef MK_PER_PHASE
#define MK_PER_PHASE 0
#endif
__device__ __forceinline__ int opaque_tid() { int t = threadIdx.x; asm volatile("" : "+v"(t) : : "memory"); return t; }
namespace pg8 {
#define PG8_LAS __attribute__((address_space(3)))
typedef unsigned short bf16_t;
typedef short bf16x8 __attribute__((ext_vector_type(8)));
typedef float f32x4 __attribute__((ext_vector_type(4)));
typedef unsigned u32x4 __attribute__((ext_vector_type(4)));
constexpr int BM = 256, BK = 64, HALF = 128, HTB = HALF * BK * 2  , STAGE_BYTES = 8 * HTB, NXCD = 8, WGM = 8;

__host__ __device__ __forceinline__ int lds_byte(int r, int c) { const int st = (r >> 4) * 2 + (c >> 5), rr = r & 15, cc = c & 31, ob = rr * 64 + cc * 2; return st * 1024 + (ob ^ (((ob >> 9) & 1) << 5)); }
__host__ __device__ __forceinline__ void stage_rc(int b, int& R, int& C) { const int st = b / 1024, sb = b % 1024, swz = sb ^ (((sb >> 9) & 1) << 5); R = (st >> 1) * 16 + swz / 64; C = (st & 1) * 32 + (swz % 64) / 2; }
__host__ __device__ __forceinline__ int perm32(int rho) { const int n = rho >> 4, i = rho & 15; return 8 * (i >> 2) + 4 * n + (i & 3); }

struct Unit { int pm, pn, kb, ks; };
struct Gemm { const bf16_t* A; const bf16_t* Bt; int M, N, K, ld; };

struct StaticOrder {
    int nM, nN, nwg, G, c;
    __host__ __device__ void init(int M, int N, int G_, int c_) { nM = M / BM; nN = N / BM; nwg = nM * nN; G = G_; c = c_; }
    __host__ __device__ bool next(int i, Unit& u) const {
        const long L = (long)i * G + c; if (L >= nwg) return false;
        int wgid = (int)L; { const int q = nwg / NXCD, r = nwg % NXCD, xcd = wgid % NXCD, off = wgid / NXCD; wgid = (xcd < r ? xcd * (q + 1) : r * (q + 1) + (xcd - r) * q) + off; }
        const int nig = WGM * nN, gid = wgid / nig, fm = gid * WGM, gsz = (nM - fm) < WGM ? (nM - fm) : WGM;
        u.pm = fm + ((wgid % nig) % gsz); u.pn = (wgid % nig) / gsz; u.kb = 0; u.ks = 0; return true;
    }
    __device__ __forceinline__ void a_ready(const Unit&) const {}
    __device__ __forceinline__ void done(const Unit&) const {}
};
struct SplitOrder {
    int nN, nS, ksl, ntot, G, c;
    __host__ __device__ void init(int M, int N, int Kfull, int ksl_, int G_, int c_) { nN = N / BM; nS = Kfull / ksl_; ksl = ksl_; ntot = (M / BM) * nN * nS; G = G_; c = c_; }
    __host__ __device__ bool next(int i, Unit& u) const { const int j = i * G + c; if (j >= ntot) return false; const int ks = j % nS, t = j / nS; u.pn = t % nN; u.pm = t / nN; u.kb = ks * ksl; u.ks = ks; return true; }
    __device__ __forceinline__ void a_ready(const Unit&) const {}
    __device__ __forceinline__ void done(const Unit&) const {}
};
__device__ __forceinline__ unsigned cvt_pk_bf16(float lo, float hi) { unsigned r; asm volatile("v_cvt_pk_bf16_f32 %0, %1, %2" : "=v"(r) : "v"(lo), "v"(hi)); return r; }
__device__ __forceinline__ float bf_lo(unsigned w) { return __uint_as_float(w << 16); }
__device__ __forceinline__ float bf_hi(unsigned w) { return __uint_as_float(w & 0xffff0000u); }
__device__ __forceinline__ float sigm(float x) { return __builtin_amdgcn_rcpf(1.0f + __expf(-x)); }

struct EpiSplit {
    static constexpr bool PERM = true, AFTER_DRAIN = false;
    bf16_t *U, *G, *P, *GT;
    __device__ __forceinline__ void operator()(const f32x4 (&acc)[2][2][4][2], const Unit& u, int wr, int wc, int fr, int fq) const {
        bf16_t* base; int ldc, colt;
        if (u.pn < 4) { base = U; ldc = 1024; colt = u.pn * 256; }
        else if (u.pn < 8) { base = G; ldc = 1024; colt = (u.pn - 4) * 256; }
        else if (u.pn < 10) { base = P; ldc = 512; colt = (u.pn - 8) * 256; }
        else { base = GT; ldc = 2048; colt = (u.pn - 10) * 256; }
        const int row0 = u.pm * BM + wr * 64 + fr, col0 = colt + wc * 32 + 8 * fq;
#pragma unroll
        for (int ai = 0; ai < 2; ++ai)
#pragma unroll
            for (int m = 0; m < 4; ++m) { bf16_t* rowp = base + (size_t)(row0 + ai * HALF + m * 16) * ldc + col0;
#pragma unroll
                for (int bj = 0; bj < 2; ++bj) { const f32x4 v0 = acc[ai][bj][m][0], v1 = acc[ai][bj][m][1];
                    u32x4 w; w.x = cvt_pk_bf16(v0[0], v0[1]); w.y = cvt_pk_bf16(v0[2], v0[3]); w.z = cvt_pk_bf16(v1[0], v1[1]); w.w = cvt_pk_bf16(v1[2], v1[3]);
                    *(u32x4*)(rowp + bj * HALF) = w; } }
    }
};
template <int MODE> struct EpiGate {
    static constexpr bool PERM = true, AFTER_DRAIN = false;
    bf16_t* Z; const bf16_t* GT;
    __device__ __forceinline__ void operator()(const f32x4 (&acc)[2][2][4][2], const Unit& u, int wr, int wc, int fr, int fq) const {
        const int row0 = u.pm * BM + wr * 64 + fr, col0 = u.pn * BM + wc * 32 + 8 * fq;
#pragma unroll
        for (int ai = 0; ai < 2; ++ai)
#pragma unroll
            for (int m = 0; m < 4; ++m) { const size_t row = (size_t)(row0 + ai * HALF + m * 16);
#pragma unroll
                for (int bj = 0; bj < 2; ++bj) { const int col = col0 + bj * HALF;
                    const u32x4 gt = *(const u32x4*)(GT + row * 2048 + (MODE == 0 ? 1024 : 0) + col);
                    f32x4 v0 = acc[ai][bj][m][0], v1 = acc[ai][bj][m][1];
                    v0[0] *= sigm(bf_lo(gt.x)); v0[1] *= sigm(bf_hi(gt.x)); v0[2] *= sigm(bf_lo(gt.y)); v0[3] *= sigm(bf_hi(gt.y));
                    v1[0] *= sigm(bf_lo(gt.z)); v1[1] *= sigm(bf_hi(gt.z)); v1[2] *= sigm(bf_lo(gt.w)); v1[3] *= sigm(bf_hi(gt.w));
                    u32x4* zp = (u32x4*)(Z + row * 1024 + col);
                    if (MODE == 1) { const u32x4 z = *zp;
                        v0[0] += bf_lo(z.x); v0[1] += bf_hi(z.x); v0[2] += bf_lo(z.y); v0[3] += bf_hi(z.y);
                        v1[0] += bf_lo(z.z); v1[1] += bf_hi(z.z); v1[2] += bf_lo(z.w); v1[3] += bf_hi(z.w); }
                    u32x4 w; w.x = cvt_pk_bf16(v0[0], v0[1]); w.y = cvt_pk_bf16(v0[2], v0[3]); w.z = cvt_pk_bf16(v1[0], v1[1]); w.w = cvt_pk_bf16(v1[2], v1[3]);
                    *zp = w; }
                asm volatile("" ::: "memory"); }
    }
};
struct EpiRes {
    static constexpr bool PERM = false, AFTER_DRAIN = false;
    const float* srcL; const float* srcC; float* dstL; float* dstC; const float* gate;
    __device__ __forceinline__ void operator()(const f32x4 (&acc)[2][2][4][2], const Unit& u, int wr, int wc, int fr, int fq) const {
        const bool lat = u.pm < 64;
        const size_t tb = (size_t)(lat ? u.pm : u.pm - 64) * 256 * 1024;
        const float* src = (lat ? srcL : srcC) + tb; float* dst = (lat ? dstL : dstC) + tb;
        const float* gv = gate + (lat ? (u.pm >> 4) : 4) * 6144;
        const int rl0 = wr * 64 + fr, col0 = u.pn * BM + wc * 32 + 4 * fq;
        f32x4 g[2][2];
#pragma unroll
        for (int bj = 0; bj < 2; ++bj)
#pragma unroll
            for (int n = 0; n < 2; ++n) g[bj][n] = *(const f32x4*)(gv + col0 + bj * HALF + n * 16);
#pragma unroll
        for (int ai = 0; ai < 2; ++ai)
#pragma unroll
            for (int m = 0; m < 4; ++m) { const size_t off = (size_t)(rl0 + ai * HALF + m * 16) * 1024 + col0;
#pragma unroll
                for (int bj = 0; bj < 2; ++bj)
#pragma unroll
                    for (int n = 0; n < 2; ++n) { const f32x4 s = *(const f32x4*)(src + off + bj * HALF + n * 16);
                        *(f32x4*)(dst + off + bj * HALF + n * 16) = s + g[bj][n] * acc[ai][bj][m][n]; }
                asm volatile("" ::: "memory"); }
    }
};
struct EpiSqRelu {
    static constexpr bool PERM = true, AFTER_DRAIN = false;
    bf16_t* F; int ldc;
    __device__ __forceinline__ void operator()(const f32x4 (&acc)[2][2][4][2], const Unit& u, int wr, int wc, int fr, int fq) const {
        const int row0 = u.pm * BM + wr * 64 + fr, col0 = u.pn * BM + wc * 32 + 8 * fq;
#pragma unroll
        for (int ai = 0; ai < 2; ++ai)
#pragma unroll
            for (int m = 0; m < 4; ++m) { bf16_t* rowp = F + (size_t)(row0 + ai * HALF + m * 16) * ldc + col0;
#pragma unroll
                for (int bj = 0; bj < 2; ++bj) { f32x4 v0 = acc[ai][bj][m][0], v1 = acc[ai][bj][m][1];
#pragma unroll
                    for (int j = 0; j < 4; ++j) { const float a0 = fmaxf(v0[j], 0.f), a1 = fmaxf(v1[j], 0.f); v0[j] = a0 * a0; v1[j] = a1 * a1; }
                    u32x4 w; w.x = cvt_pk_bf16(v0[0], v0[1]); w.y = cvt_pk_bf16(v0[2], v0[3]); w.z = cvt_pk_bf16(v1[0], v1[1]); w.w = cvt_pk_bf16(v1[2], v1[3]);
                    *(u32x4*)(rowp + bj * HALF) = w; } }
    }
};

struct EpiSlab {
    static constexpr bool PERM = false, AFTER_DRAIN = false;
    float* slab;
    __device__ __forceinline__ void operator()(const f32x4 (&acc)[2][2][4][2], const Unit& u, int wr, int wc, int fr, int fq) const {
        float* p0 = slab + ((size_t)u.ks * 1024 + u.pm * BM + wr * 64 + fr) * 1024 + u.pn * BM + wc * 32 + 4 * fq;
#pragma unroll
        for (int ai = 0; ai < 2; ++ai)
#pragma unroll
            for (int m = 0; m < 4; ++m) { float* rowp = p0 + (size_t)(ai * HALF + m * 16) * 1024;
#pragma unroll
                for (int bj = 0; bj < 2; ++bj)
#pragma unroll
                    for (int n = 0; n < 2; ++n) *(f32x4*)(rowp + bj * HALF + n * 16) = acc[ai][bj][m][n]; }
    }
};

template <class Epi, class Sched, bool ALIGN_EPI = false, bool SP2 = false>
__device__ __forceinline__ void gemm_phase(PG8_LAS unsigned char* lds, const Gemm g, const Sched& S, const Epi& E) {
    const int tid = opaque_tid(), wid = __builtin_amdgcn_readfirstlane(tid >> 6), lane = tid & 63, wr = wid >> 2, wc = wid & 3, fr = lane & 15, fq = lane >> 4;
    const int K = g.ld, nt = g.K / BK;
    unsigned voffA[2], voffB[2];
#pragma unroll
    for (int i = 0; i < 2; ++i) { int R, C; stage_rc(tid * 16 + i * 8192, R, C); const int Rb = Epi::PERM ? ((R & ~31) + perm32(R & 31)) : R;
        voffA[i] = (unsigned)(R * K + C) * 2u; voffB[i] = (unsigned)(Rb * K + C) * 2u; }
    const size_t kstep = (size_t)(BK * 2);
    const size_t hstep = (size_t)HALF * K * 2;
    const size_t tstep = 2 * hstep;
    const unsigned ldsw = (unsigned)wid * 1024u;
    const int aoff = lds_byte(wr * 64 + fr, fq * 8), boff = lds_byte(wc * 32 + fr, fq * 8);
#define PG8_SA(b, h) (((b) * 2 + (h)) * HTB)
#define PG8_SB(b, h) ((4 + (b) * 2 + (h)) * HTB)
#define PG8_STAGE(bufoff, gbase, voff) do { _Pragma("unroll") for (int _i = 0; _i < 2; ++_i) \
        __builtin_amdgcn_global_load_lds((const unsigned*)((const char*)(gbase) + (voff)[_i]), (PG8_LAS unsigned*)(lds + (bufoff) + ldsw + _i * 8192), 16, 0, 0); } while (0)
#define PG8_LDA(dst, b, h) do { _Pragma("unroll") for (int m = 0; m < 4; ++m) _Pragma("unroll") for (int k = 0; k < 2; ++k) dst[m][k] = *(const PG8_LAS bf16x8*)(lds + PG8_SA(b, h) + aoff + m * 2048 + k * 1024); } while (0)
#define PG8_LDB(dst, b, h) do { _Pragma("unroll") for (int n = 0; n < 2; ++n) _Pragma("unroll") for (int k = 0; k < 2; ++k) dst[n][k] = *(const PG8_LAS bf16x8*)(lds + PG8_SB(b, h) + boff + n * 2048 + k * 1024); } while (0)
#define PG8_MMA(ai, bj, At, Bt) do { __builtin_amdgcn_s_setprio(1); _Pragma("unroll") for (int m = 0; m < 4; ++m) _Pragma("unroll") for (int n = 0; n < 2; ++n) _Pragma("unroll") for (int k = 0; k < 2; ++k) \
        acc[ai][bj][m][n] = __builtin_amdgcn_mfma_f32_16x16x32_bf16(Bt[n][k], At[m][k], acc[ai][bj][m][n], 0, 0, 0); __builtin_amdgcn_s_setprio(0); } while (0)
#define PG8_WAIT_V(n) asm volatile("s_waitcnt vmcnt(" #n ")" ::: "memory")
#define PG8_WAIT_L(n) asm volatile("s_waitcnt lgkmcnt(" #n ")" ::: "memory")
#define PG8_BAR __builtin_amdgcn_s_barrier()
#define PG8_SCHED __builtin_amdgcn_sched_barrier(0)
    Unit cur, nxt; int ui = 0;
    if (!S.next(0, cur)) return;
    f32x4 acc[2][2][4][2];
#pragma unroll
    for (int a = 0; a < 2; ++a)
#pragma unroll
        for (int b = 0; b < 2; ++b)
#pragma unroll
            for (int m = 0; m < 4; ++m)
#pragma unroll
                for (int n = 0; n < 2; ++n) acc[a][b][m][n] = (f32x4){0.f, 0.f, 0.f, 0.f};
    bf16x8 At[4][2], B0[2][2], B1[2][2];
    const char* cA = (const char*)g.A + (size_t)cur.pm * tstep + (size_t)cur.kb * 2; const char* cB = (const char*)g.Bt + (size_t)cur.pn * tstep + (size_t)cur.kb * 2;
    S.a_ready(cur);
    if constexpr (SP2) {
        PG8_STAGE(PG8_SB(0, 0), cB, voffB); PG8_STAGE(PG8_SB(0, 1), cB + hstep, voffB); PG8_STAGE(PG8_SA(0, 0), cA, voffA); PG8_STAGE(PG8_SA(0, 1), cA + hstep, voffA);
        if (wr == 1) PG8_BAR;
        PG8_WAIT_V(2); PG8_BAR;
        PG8_STAGE(PG8_SB(1, 0), cB + kstep, voffB); PG8_STAGE(PG8_SA(1, 0), cA + kstep, voffA); PG8_STAGE(PG8_SB(1, 1), cB + hstep + kstep, voffB);
        PG8_WAIT_V(6); PG8_BAR;
    } else {
        PG8_STAGE(PG8_SB(0, 0), cB, voffB); PG8_STAGE(PG8_SA(0, 0), cA, voffA); PG8_STAGE(PG8_SB(0, 1), cB + hstep, voffB); PG8_STAGE(PG8_SA(0, 1), cA + hstep, voffA);
        if (wr == 1) PG8_BAR;
        PG8_WAIT_V(4); PG8_BAR;
        PG8_STAGE(PG8_SB(1, 0), cB + kstep, voffB); PG8_STAGE(PG8_SA(1, 0), cA + kstep, voffA); PG8_STAGE(PG8_SB(1, 1), cB + hstep + kstep, voffB);
        PG8_WAIT_V(6); PG8_BAR;
    }
    for (;;) {
        const bool has_next = S.next(ui + 1, nxt);
        const char* nA = has_next ? (const char*)g.A + (size_t)nxt.pm * tstep + (size_t)nxt.kb * 2 : cA; const char* nB = has_next ? (const char*)g.Bt + (size_t)nxt.pn * tstep + (size_t)nxt.kb * 2 : cB;
        for (int t = 0; t < nt; t += 2) {
            const bool last = (t == nt - 2);
            const char* a1 = cA + (size_t)(t + 1) * kstep;
            const char* a2 = last ? nA : cA + (size_t)(t + 2) * kstep; const char* b2 = last ? nB : cB + (size_t)(t + 2) * kstep;
            const char* a3 = a2 + kstep; const char* b3 = b2 + kstep;
            if (last && has_next) S.a_ready(nxt);
            if constexpr (SP2) {
            PG8_LDB(B0, 0, 0); PG8_LDB(B1, 0, 1); PG8_SCHED; PG8_LDA(At, 0, 0); PG8_STAGE(PG8_SA(1, 1), a1 + hstep, voffA);
            PG8_WAIT_V(8); PG8_WAIT_L(0); PG8_BAR; PG8_MMA(0, 0, At, B0); PG8_MMA(0, 1, At, B1); PG8_BAR; PG8_SCHED;
            PG8_LDA(At, 0, 1); PG8_STAGE(PG8_SB(0, 0), b2, voffB); PG8_STAGE(PG8_SB(0, 1), b2 + hstep, voffB); PG8_STAGE(PG8_SA(0, 0), a2, voffA);
            PG8_WAIT_V(8); PG8_WAIT_L(0); PG8_BAR; PG8_MMA(1, 0, At, B0); PG8_MMA(1, 1, At, B1); PG8_BAR; PG8_SCHED;
            PG8_LDB(B0, 1, 0); PG8_LDB(B1, 1, 1); PG8_SCHED; PG8_LDA(At, 1, 0); PG8_STAGE(PG8_SA(0, 1), a2 + hstep, voffA);
            PG8_WAIT_V(8); PG8_WAIT_L(0); PG8_BAR; PG8_MMA(0, 0, At, B0); PG8_MMA(0, 1, At, B1); PG8_BAR; PG8_SCHED;
            PG8_LDA(At, 1, 1); PG8_STAGE(PG8_SB(1, 0), b3, voffB); PG8_STAGE(PG8_SB(1, 1), b3 + hstep, voffB); PG8_STAGE(PG8_SA(1, 0), a3, voffA);
            PG8_WAIT_V(8); PG8_WAIT_L(0); PG8_BAR; PG8_MMA(1, 0, At, B0); PG8_MMA(1, 1, At, B1); PG8_BAR; PG8_SCHED;
            } else {
            PG8_LDB(B0, 0, 0); PG8_SCHED; PG8_LDA(At, 0, 0); PG8_STAGE(PG8_SA(1, 1), a1 + hstep, voffA);
            PG8_WAIT_L(8); PG8_BAR; PG8_WAIT_L(0); PG8_MMA(0, 0, At, B0); PG8_BAR; PG8_SCHED;
            PG8_LDB(B1, 0, 1); PG8_STAGE(PG8_SB(0, 0), b2, voffB);
            PG8_BAR; PG8_WAIT_L(0); PG8_MMA(0, 1, At, B1); PG8_BAR;
            PG8_LDA(At, 0, 1); PG8_STAGE(PG8_SA(0, 0), a2, voffA);
            PG8_BAR; PG8_WAIT_L(0); PG8_MMA(1, 0, At, B0); PG8_BAR; PG8_SCHED;
            PG8_STAGE(PG8_SB(0, 1), b2 + hstep, voffB);
            PG8_WAIT_V(6); PG8_BAR; PG8_MMA(1, 1, At, B1); PG8_BAR;
            PG8_LDB(B0, 1, 0); PG8_SCHED; PG8_LDA(At, 1, 0); PG8_STAGE(PG8_SA(0, 1), a2 + hstep, voffA);
            PG8_WAIT_L(8); PG8_BAR; PG8_WAIT_L(0); PG8_MMA(0, 0, At, B0); PG8_BAR; PG8_SCHED;
            PG8_LDB(B1, 1, 1); PG8_STAGE(PG8_SB(1, 0), b3, voffB);
            PG8_BAR; PG8_WAIT_L(0); PG8_MMA(0, 1, At, B1); PG8_BAR;
            PG8_LDA(At, 1, 1); PG8_STAGE(PG8_SA(1, 0), a3, voffA);
            PG8_BAR; PG8_WAIT_L(0); PG8_MMA(1, 0, At, B0); PG8_BAR; PG8_SCHED;
            PG8_STAGE(PG8_SB(1, 1), b3 + hstep, voffB);
            PG8_WAIT_V(6); PG8_BAR; PG8_MMA(1, 1, At, B1); PG8_BAR;
            }
        }
        if constexpr (ALIGN_EPI) { if (wr == 0) PG8_BAR; }
        if constexpr (!Epi::AFTER_DRAIN) { E(acc, cur, wr, wc, fr, fq); S.done(cur); }
        if (!has_next) break;
#pragma unroll
        for (int a = 0; a < 2; ++a)
#pragma unroll
            for (int b = 0; b < 2; ++b)
#pragma unroll
                for (int m = 0; m < 4; ++m)
#pragma unroll
                    for (int n = 0; n < 2; ++n) acc[a][b][m][n] = (f32x4){0.f, 0.f, 0.f, 0.f};
        cur = nxt; cA = nA; cB = nB; ++ui;
        if constexpr (ALIGN_EPI) { if (wr == 1) PG8_BAR; }
    }
    PG8_WAIT_V(0);
    if constexpr (!ALIGN_EPI) { if (wr == 0) PG8_BAR; }
    PG8_BAR;
    if constexpr (Epi::AFTER_DRAIN) { E.fused(acc, cur, wr, wc, fr, fq, lds, wid, lane); S.done(cur); }
#undef PG8_SA
#undef PG8_SB
#undef PG8_STAGE
#undef PG8_LDA
#undef PG8_LDB
#undef PG8_MMA
#undef PG8_WAIT_V
#undef PG8_WAIT_L
#undef PG8_BAR
#undef PG8_SCHED
}
}
constexpr int D = 1024, NB = 4, SEQ = 4096, CTX = 256, DEPTH = 2;
constexpr int ML = NB * SEQ, MC = NB * CTX, MT = ML + MC;
constexpr int D_IN = 4608, D_POOL = 512, D_FF = 4096, MODW = 6 * D;
constexpr int TCH = 64;
constexpr int NSUB = TCH / 32, NCL = SEQ / TCH, NCC = CTX / TCH, NLAT = NB * NCL * 16, NCTX = NB * NCC * 16;
constexpr int NQ = NCC + NCL;
constexpr float EPS = 1e-6f;
constexpr size_t MiB = 1u << 20;
constexpr size_t WS_MOD = 0;
constexpr size_t WS_BAR = 256 * 1024;
constexpr size_t WS_SUMM = 244 * MiB;
constexpr size_t WS_CARRY = WS_SUMM + (size_t)NB * 2 * NQ * 2 * 1024 * 4;
constexpr size_t WS_XC = 4 * MiB;
constexpr size_t WS_WIN = 8 * MiB, WS_WLO = 17 * MiB, WS_WPO = 19 * MiB, WS_WO = 20 * MiB, WS_W1 = 22 * MiB, WS_W2 = 30 * MiB;
constexpr size_t WS_GW = 38 * MiB;
constexpr size_t WS_PW = 39 * MiB;
constexpr size_t WS_H = 40 * MiB;
constexpr size_t WS_U = 74 * MiB;
constexpr size_t WS_G = 108 * MiB;
constexpr size_t WS_P = 142 * MiB;
constexpr size_t WS_GT = 159 * MiB;
constexpr size_t WS_PM = 227 * MiB;
constexpr size_t WS_SLAB3 = WS_G;
constexpr size_t WS_SLAB5 = 210 * MiB;
constexpr size_t WS_F = WS_U;
constexpr size_t WS_END = 256 * MiB;
static_assert(WS_CARRY + (size_t)NB * 2 * NQ * 1024 * 4 <= 256 * MiB, "ws map (tail)");
static_assert(WS_F + (size_t)MT * D_FF * 2 <= WS_PM && WS_H + (size_t)MT * D * 2 <= WS_U && WS_GT + (size_t)MT * 2048 * 2 <= WS_PM, "ws map");
constexpr int LDS_BYTES = 148 * 1024, MISC_OFF = 147456;

#define LAS __attribute__((address_space(3)))
typedef unsigned short bf16;
typedef unsigned u32x4 __attribute__((ext_vector_type(4)));
typedef unsigned u32x2 __attribute__((ext_vector_type(2)));
typedef float f32x4 __attribute__((ext_vector_type(4)));
typedef float f32x16 __attribute__((ext_vector_type(16)));
typedef short bf16x8 __attribute__((ext_vector_type(8)));
using pg8::cvt_pk_bf16; using pg8::bf_lo; using pg8::bf_hi; using pg8::sigm;

struct Args { const float* in[24]; float* out; unsigned char* ws; int lo, hi; };
enum { I_X = 0, I_C, I_CTX, I_CCTX, I_WADA, I_BADA, I_N1G, I_N2G, I_WIN, I_CONVW, I_CONVB, I_WR, I_BR, I_WI, I_BI, I_LAM, I_WLO, I_POOLW, I_POOLS, I_WPO, I_WO, I_W1, I_W2, I_FG };

__device__ __forceinline__ float wave_sum(float v) {
#pragma unroll
    for (int o = 1; o < 64; o <<= 1) v += __shfl_xor(v, o);
    return v;
}
__device__ __forceinline__ float gelu_tanh(float x) { const float z = 0.7978845608f * (x + 0.044715f * x * x * x); const float e = __expf(2.f * z); return 0.5f * x * (2.f - 2.f * __builtin_amdgcn_rcpf(e + 1.f)); }

__device__ __forceinline__ void mod_item(const Args& a, LAS unsigned char* lds, int item) {
    const int tid = opaque_tid(), l = item / 96, cb = item % 96, cq = tid & 15, kg = tid >> 4;
    LAS float* s = (LAS float*)lds;
    LAS float* part = (LAS float*)(lds + 20480);
    const float* c = a.in[I_C]; const float* cc = a.in[I_CCTX];
    for (int i = tid; i < 5120; i += 512) { const int r = i >> 10, k = i & 1023; const float v = r < 4 ? c[r * 1024 + k] : cc[k]; s[i] = v * sigm(v); }
    __syncthreads();
    const float* W = a.in[I_WADA] + (size_t)l * D * MODW + cb * 64 + cq * 4;
    float acc[5][4];
#pragma unroll
    for (int r = 0; r < 5; ++r)
#pragma unroll
        for (int j = 0; j < 4; ++j) acc[r][j] = 0.f;
#pragma unroll 8
    for (int kk = 0; kk < 32; ++kk) { const int k = kg * 32 + kk; const f32x4 w = *(const f32x4*)(W + (size_t)k * MODW);
#pragma unroll
        for (int r = 0; r < 5; ++r) { const float sv = s[r * 1024 + k];
#pragma unroll
            for (int j = 0; j < 4; ++j) acc[r][j] += sv * w[j]; } }
#pragma unroll
    for (int r = 0; r < 5; ++r)
#pragma unroll
        for (int j = 0; j < 4; ++j) part[(kg * 5 + r) * 64 + cq * 4 + j] = acc[r][j];
    __syncthreads();
    if (tid < 320) { const int r = tid >> 6, col = tid & 63; float t = 0.f;
#pragma unroll 8
        for (int g = 0; g < 32; ++g) t += part[(g * 5 + r) * 64 + col];
        ((float*)(a.ws + WS_MOD))[(size_t)(l * 5 + r) * MODW + cb * 64 + col] = t + a.in[I_BADA][l * MODW + cb * 64 + col]; }
    __syncthreads();
}
__device__ __forceinline__ void transpose_item(const float* W, int K, int N, bf16* WT, LAS float* scr, int item, int lane) {
    const int nblk = N / 32, kb = item / nblk, nb = item % nblk, k0 = 64 * kb, n0 = 32 * nb;
#pragma unroll 8
    for (int i = 0; i < 32; ++i) { const int kk = 2 * i + (lane >> 5); scr[kk * 33 + (lane & 31)] = W[(size_t)(k0 + kk) * N + n0 + (lane & 31)]; }
    asm volatile("s_waitcnt lgkmcnt(0)" ::: "memory");
    const int c = lane & 7;
#pragma unroll
    for (int j = 0; j < 4; ++j) { const int n = (lane >> 3) + 8 * j; const LAS float* s = scr + (8 * c) * 33 + n;
        u32x4 o; o.x = cvt_pk_bf16(s[0 * 33], s[1 * 33]); o.y = cvt_pk_bf16(s[2 * 33], s[3 * 33]); o.z = cvt_pk_bf16(s[4 * 33], s[5 * 33]); o.w = cvt_pk_bf16(s[6 * 33], s[7 * 33]);
        *(u32x4*)(WT + (size_t)(n0 + n) * K + k0 + 8 * c) = o; }
    asm volatile("s_waitcnt lgkmcnt(0)" ::: "memory");
}
__device__ __forceinline__ void convert_big(const Args& a, LAS unsigned char* lds, int l, int gw, int NGW, int wave, int lane) {
    LAS float* scr = (LAS float*)(lds + wave * 16384);
    constexpr int I_IN = (D / 64) * (D_IN / 32), I_LO = (D / 64) * (D / 32), I_PO = (D_POOL / 64) * (D / 32), I_O = I_LO, I_1 = (D / 64) * (D_FF / 32), I_2 = (D_FF / 64) * (D / 32);
    constexpr int NIT = I_IN + I_LO + I_PO + I_O + I_1 + I_2;
    unsigned char* ws = a.ws;
    for (int it = gw; it < NIT; it += NGW) { int r = it;
        if (r < I_IN) { transpose_item(a.in[I_WIN] + (size_t)l * D * D_IN, D, D_IN, (bf16*)(ws + WS_WIN), scr, r, lane); continue; } r -= I_IN;
        if (r < I_LO) { transpose_item(a.in[I_WLO] + (size_t)l * D * D, D, D, (bf16*)(ws + WS_WLO), scr, r, lane); continue; } r -= I_LO;
        if (r < I_PO) { transpose_item(a.in[I_WPO] + (size_t)l * D_POOL * D, D_POOL, D, (bf16*)(ws + WS_WPO), scr, r, lane); continue; } r -= I_PO;
        if (r < I_O) { transpose_item(a.in[I_WO] + (size_t)l * D * D, D, D, (bf16*)(ws + WS_WO), scr, r, lane); continue; } r -= I_O;
        if (r < I_1) { transpose_item(a.in[I_W1] + (size_t)l * D * D_FF, D, D_FF, (bf16*)(ws + WS_W1), scr, r, lane); continue; } r -= I_1;
        transpose_item(a.in[I_W2] + (size_t)l * D_FF * D, D_FF, D, (bf16*)(ws + WS_W2), scr, r, lane); }
}
__device__ __forceinline__ void convert_small(const Args& a, LAS unsigned char* lds, int gw, int NGW, int wave, int lane) {
    LAS float* scr = (LAS float*)(lds + wave * 16384);
    for (int it = gw; it < 256 + 64; it += NGW) {
        if (it < 256) { const int mi = it >> 1, sub = it & 1, h = mi & 15, ri = (mi >> 4) & 1, ld = mi >> 5;
            const float* src = a.in[ri ? I_WI : I_WR] + ((size_t)ld * 16 + h) * 4096;
            transpose_item(src, 64, 64, (bf16*)(a.ws + WS_GW) + ((size_t)(ld * 2 + ri) * 16 + h) * 4096, scr, sub, lane); }
        else { const int r = it - 256, mi = r >> 3, sub = r & 7;
            transpose_item(a.in[I_POOLW] + (size_t)mi * 16384, 128, 128, (bf16*)(a.ws + WS_PW) + (size_t)mi * 16384, scr, sub, lane); }
    }
}
__device__ __forceinline__ void norm_rows(const float* xl, const float* xc, bf16* H, const float* gvec, const float* mod  , int shift_i, int scale_i, int nrows, int gw, int NGW, int lane,
                                          const float* slab = nullptr, const float* sgate = nullptr, float* xcw = nullptr) {
    for (int m = gw; m < nrows; m += NGW) {
        const float* xr = m < ML ? xl + (size_t)m * D : xc + (size_t)(m - ML) * D; const int r = m < ML ? (m >> 12) : 4;
        const f32x4* x4 = (const f32x4*)xr + lane; f32x4 v[4]; float ss = 0.f;
#pragma unroll
        for (int j = 0; j < 4; ++j) v[j] = x4[64 * j];
        if (slab != nullptr && m >= ML) {
            const f32x4* s4 = (const f32x4*)(slab + (size_t)(m - ML) * D) + lane; const f32x4* g4s = (const f32x4*)sgate + lane;
#pragma unroll
            for (int j = 0; j < 4; ++j) { const f32x4 t = (s4[64 * j] + s4[64 * j + 262144]) + (s4[64 * j + 2 * 262144] + s4[64 * j + 3 * 262144]); v[j] = v[j] + g4s[64 * j] * t; }
            if (xcw != nullptr) { f32x4* w4 = (f32x4*)(xcw + (size_t)(m - ML) * D) + lane;
#pragma unroll
                for (int j = 0; j < 4; ++j) w4[64 * j] = v[j]; } }
#pragma unroll
        for (int j = 0; j < 4; ++j) ss += (v[j].x * v[j].x + v[j].y * v[j].y) + (v[j].z * v[j].z + v[j].w * v[j].w);
        const float rstd = 1.0f / sqrtf(wave_sum(ss) * (1.f / D) + EPS);
        const f32x4* g4 = (const f32x4*)gvec + lane; const f32x4* sc4 = (const f32x4*)(mod + (size_t)r * MODW + scale_i * D) + lane; const f32x4* sh4 = (const f32x4*)(mod + (size_t)r * MODW + shift_i * D) + lane;
        u32x2* o = (u32x2*)(H + (size_t)m * D) + lane;
#pragma unroll
        for (int j = 0; j < 4; ++j) { const f32x4 h = v[j] * rstd * g4[64 * j] * (1.0f + sc4[64 * j]) + sh4[64 * j]; u32x2 w; w.x = cvt_pk_bf16(h.x, h.y); w.y = cvt_pk_bf16(h.z, h.w); o[64 * j] = w; }
    }
}
__device__ __forceinline__ void final_rows(float* x, const float* gvec, int gw, int NGW, int lane) {
    for (int m = gw; m < ML; m += NGW) {
        f32x4* x4 = (f32x4*)(x + (size_t)m * D) + lane; f32x4 v[4]; float ss = 0.f;
#pragma unroll
        for (int j = 0; j < 4; ++j) { v[j] = x4[64 * j]; ss += (v[j].x * v[j].x + v[j].y * v[j].y) + (v[j].z * v[j].z + v[j].w * v[j].w); }
        const float rstd = 1.0f / sqrtf(wave_sum(ss) * (1.f / D) + EPS);
        const f32x4* g4 = (const f32x4*)gvec + lane;
#pragma unroll
        for (int j = 0; j < 4; ++j) x4[64 * j] = v[j] * rstd * g4[64 * j];
    }
}
constexpr int SCW_WAVE = 18432;
template <bool PASSB, int DIR>
__device__ __forceinline__ void scan_sweep(const Args& a, LAS unsigned char* wl, int l, int b, int q, int h, int seqbase, int L, int t0, int lane) {
    const int l31 = lane & 31, lh = lane >> 5, ld = l * 2 + DIR;
    const bf16* U = (const bf16*)(a.ws + WS_U) + (size_t)seqbase * D + h * 64 + lh * 8;
    const LAS float* cwl = (const LAS float*)(wl + 16384);
    { const bf16* g0 = (const bf16*)(a.ws + WS_GW) + (size_t)((ld * 2 + 0) * 16 + h) * 4096; const bf16* g1 = (const bf16*)(a.ws + WS_GW) + (size_t)((ld * 2 + 1) * 16 + h) * 4096;
      u32x4 v0[8], v1[8];
#pragma unroll
      for (int p = 0; p < 8; ++p) { v0[p] = *(const u32x4*)(g0 + (p * 64 + lane) * 8); v1[p] = *(const u32x4*)(g1 + (p * 64 + lane) * 8); }
#pragma unroll
      for (int p = 0; p < 8; ++p) { const int piece = p * 64 + lane, row = piece >> 3, c = piece & 7, off = row * 128 + ((c ^ (row & 7)) * 16);
          *(LAS u32x4*)(wl + off) = v0[p]; *(LAS u32x4*)(wl + 8192 + off) = v1[p]; } }
    float brr[2], bii[2], sp[2], s[2], AT[2];
#pragma unroll
    for (int nb = 0; nb < 2; ++nb) { const int ch = h * 64 + nb * 32 + l31;
        brr[nb] = a.in[I_BR][ld * D + ch]; bii[nb] = a.in[I_BI][ld * D + ch];
        const float lam = a.in[I_LAM][ld * D + ch]; sp[nb] = fmaxf(-lam, 0.f) + log1pf(__expf(-fabsf(lam)));
        AT[nb] = 1.f; s[nb] = PASSB ? ((const float*)(a.ws + WS_CARRY))[(size_t)((b * 2 + DIR) * NQ + q) * 1024 + ch] : 0.f; }
    asm volatile("s_waitcnt lgkmcnt(0)" ::: "memory"); __builtin_amdgcn_wave_barrier();
    u32x4 ur[4][4];
#define LOADU(tokv) do { _Pragma("unroll") for (int j_ = 0; j_ < 4; ++j_) { const int tc_ = min(max((tokv) - 2 + j_, 0), L - 1); \
        _Pragma("unroll") for (int ks_ = 0; ks_ < 4; ++ks_) ur[ks_][j_] = *(const u32x4*)(U + (size_t)tc_ * D + ks_ * 16); } } while (0)
#ifndef SCAN_PREFETCH
#define SCAN_PREFETCH 0
#endif
    if (SCAN_PREFETCH) LOADU(t0 + (DIR ? (NSUB - 1) * 32 : 0) + l31);
#pragma unroll 1
    for (int k = 0; k < NSUB; ++k) {
        const int tsub = t0 + (DIR ? NSUB - 1 - k : k) * 32, tok = tsub + l31;
        bf16x8 af[4];
        if (!SCAN_PREFETCH) { LOADU(tok); __builtin_amdgcn_sched_barrier(0); }
#pragma unroll
        for (int ks = 0; ks < 4; ++ks) { const int c0 = ks * 16 + lh * 8;
            f32x4 u0 = *(const LAS f32x4*)(cwl + 256 + c0), u1 = *(const LAS f32x4*)(cwl + 256 + c0 + 4);
#pragma unroll
            for (int j = 0; j < 4; ++j) { const int tt = tok - 2 + j; const bool ok = (tt >= 0 && tt < L); u32x4 uv = ur[ks][j];
                uv.x = ok ? uv.x : 0u; uv.y = ok ? uv.y : 0u; uv.z = ok ? uv.z : 0u; uv.w = ok ? uv.w : 0u;
                const f32x4 w0 = *(const LAS f32x4*)(cwl + j * 64 + c0), w1 = *(const LAS f32x4*)(cwl + j * 64 + c0 + 4);
                u0.x = fmaf(w0.x, bf_lo(uv.x), u0.x); u0.y = fmaf(w0.y, bf_hi(uv.x), u0.y); u0.z = fmaf(w0.z, bf_lo(uv.y), u0.z); u0.w = fmaf(w0.w, bf_hi(uv.y), u0.w);
                u1.x = fmaf(w1.x, bf_lo(uv.z), u1.x); u1.y = fmaf(w1.y, bf_hi(uv.z), u1.y); u1.z = fmaf(w1.z, bf_lo(uv.w), u1.z); u1.w = fmaf(w1.w, bf_hi(uv.w), u1.w); }
            u32x4 o; o.x = cvt_pk_bf16(u0.x, u0.y); o.y = cvt_pk_bf16(u0.z, u0.w); o.z = cvt_pk_bf16(u1.x, u1.y); o.w = cvt_pk_bf16(u1.z, u1.w);
            af[ks] = __builtin_bit_cast(bf16x8, o); }
        __builtin_amdgcn_sched_barrier(0);
        if (SCAN_PREFETCH) { const int kn = k < NSUB - 1 ? k + 1 : k; LOADU(t0 + (DIR ? NSUB - 1 - kn : kn) * 32 + l31); }
        __builtin_amdgcn_sched_barrier(0);
#pragma unroll
        for (int nb = 0; nb < 2; ++nb) {
            __builtin_amdgcn_sched_barrier(0);
            const size_t cbase = (size_t)(seqbase + tsub + 4 * lh) * D + h * 64 + nb * 32 + l31;
            bf16* HL = (bf16*)(a.ws + WS_H) + cbase; const bf16* Gp = (const bf16*)(a.ws + WS_G) + cbase;
            float hfv[16], gv[16];
            if (PASSB && DIR == 1) {
#pragma unroll
                for (int reg = 0; reg < 16; ++reg) { const size_t o = (size_t)(8 * (reg >> 2) + (reg & 3)) * D; hfv[reg] = __uint_as_float((unsigned)HL[o] << 16); gv[reg] = __uint_as_float((unsigned)Gp[o] << 16); } }
            f32x16 ar, ai, au;
#pragma unroll
            for (int i = 0; i < 16; ++i) { ar[i] = 0.f; ai[i] = 0.f; au[i] = 0.f; }
            const int row = nb * 32 + l31;
#pragma unroll
            for (int ks = 0; ks < 4; ++ks) {
                const int idx = row - (ks * 16 + lh * 8);
                const unsigned one = (idx >= 0 && idx < 8) ? (0x3F80u << ((idx & 1) * 16)) : 0u; const int dw = idx >> 1;
                u32x4 idv; idv.x = dw == 0 ? one : 0u; idv.y = dw == 1 ? one : 0u; idv.z = dw == 2 ? one : 0u; idv.w = dw == 3 ? one : 0u;
                const int woff = row * 128 + (((ks * 2 + lh) ^ (row & 7)) * 16);
                const bf16x8 wr = *(const LAS bf16x8*)(wl + woff), wi = *(const LAS bf16x8*)(wl + 8192 + woff);
                ar = __builtin_amdgcn_mfma_f32_32x32x16_bf16(af[ks], wr, ar, 0, 0, 0);
                ai = __builtin_amdgcn_mfma_f32_32x32x16_bf16(af[ks], wi, ai, 0, 0, 0);
                au = __builtin_amdgcn_mfma_f32_32x32x16_bf16(af[ks], __builtin_bit_cast(bf16x8, idv), au, 0, 0, 0); }
#pragma unroll
            for (int reg = 0; reg < 16; ++reg) { const float r = sigm(ar[reg] + brr[nb]), ig = sigm(ai[reg] + bii[nb]);
                const float av = __expf(-8.0f * r * sp[nb]), mult = __builtin_amdgcn_sqrtf(fmaxf(1.0f - av * av, 0.f));
                ar[reg] = av; ai[reg] = mult * ig * au[reg]; }
            float gA[4], gB[4], pA[4], pB[4], sIn[4];
#pragma unroll
            for (int gi = 0; gi < 4; ++gi) { const int j0 = DIR ? 3 : 0; float A = ar[4 * gi + j0], B = ai[4 * gi + j0];
#pragma unroll
                for (int jj = 1; jj < 4; ++jj) { const int j = DIR ? 3 - jj : jj; B = ar[4 * gi + j] * B + ai[4 * gi + j]; A *= ar[4 * gi + j]; }
                gA[gi] = A; gB[gi] = B; }
#pragma unroll
            for (int gi = 0; gi < 4; ++gi) { pA[gi] = __shfl_xor(gA[gi], 32); pB[gi] = __shfl_xor(gB[gi], 32); sIn[gi] = 0.f; }
            float st = s[nb];
#pragma unroll
            for (int g = 0; g < 8; ++g) { const int gg = DIR ? 7 - g : g, gi = gg >> 1; const bool own = (lh == (gg & 1));
                const float Ag = own ? gA[gi] : pA[gi], Bg = own ? gB[gi] : pB[gi];
                sIn[gi] = own ? st : sIn[gi]; st = Ag * st + Bg; if (!PASSB) AT[nb] *= Ag; }
            s[nb] = st;
            if (PASSB) {
#pragma unroll
                for (int gi = 0; gi < 4; ++gi) { float hc = sIn[gi];
#pragma unroll
                    for (int jj = 0; jj < 4; ++jj) { const int j = DIR ? 3 - jj : jj, reg = 4 * gi + j; hc = ar[reg] * hc + ai[reg];
                        const size_t o = (size_t)(8 * gi + j) * D;
                        if (DIR == 0) HL[o] = (bf16)(cvt_pk_bf16(hc, 0.f) & 0xffffu);
                        else HL[o] = (bf16)(cvt_pk_bf16((hfv[reg] + hc) * gelu_tanh(gv[reg]), 0.f) & 0xffffu); } }
            }
        }
    }
#undef LOADU
    if (!PASSB) {
#pragma unroll
        for (int nb = 0; nb < 2; ++nb) { float* sm = (float*)(a.ws + WS_SUMM) + ((size_t)((b * 2 + DIR) * NQ + q) * 2) * 1024 + h * 64 + nb * 32 + l31;
            if (lh == 0) { sm[0] = AT[nb]; sm[1024] = s[nb]; } }
    }
    asm volatile("s_waitcnt lgkmcnt(0)" ::: "memory"); __builtin_amdgcn_wave_barrier();
}
template <bool PASSB>
__device__ __forceinline__ void scan_task(const Args& a, LAS unsigned char* lds, int l, int item, int wave, int lane) {
    int b, chunk, h, seqbase, L, q;
    if (item < NLAT) { b = item / (NCL * 16); const int rem = item % (NCL * 16); chunk = rem >> 4; h = rem & 15; seqbase = b * SEQ; L = SEQ; q = NCC + chunk; }
    else { const int it = item - NLAT; b = it / (NCC * 16); const int rem = it % (NCC * 16); chunk = rem >> 4; h = rem & 15; seqbase = ML + b * CTX; L = CTX; q = chunk; }
    LAS unsigned char* wl = lds + wave * SCW_WAVE; LAS float* cwl = (LAS float*)(wl + 16384);
    { const float* cw = a.in[I_CONVW] + (size_t)l * 4 * D + h * 64;
#pragma unroll
      for (int j = 0; j < 4; ++j) cwl[j * 64 + lane] = cw[j * D + lane];
      cwl[256 + lane] = a.in[I_CONVB][l * D + h * 64 + lane]; }
    scan_sweep<PASSB, 0>(a, wl, l, b, q, h, seqbase, L, chunk * TCH, lane);
    scan_sweep<PASSB, 1>(a, wl, l, b, q, h, seqbase, L, chunk * TCH, lane);
}
__device__ __forceinline__ void carry_phase(const Args& a) {
    const float* sm = (const float*)(a.ws + WS_SUMM); float* cr = (float*)(a.ws + WS_CARRY);
    const int tid = opaque_tid();
    for (int idx = blockIdx.x * 64 + tid; tid < 64 && idx < NB * 2 * 1024; idx += gridDim.x * 64) {
        const int chn = idx & 1023, bd = idx >> 10, dir = bd & 1;
        const float* s0 = sm + (size_t)bd * NQ * 2048 + chn; float* c0 = cr + (size_t)bd * NQ * 1024 + chn;
        float hs = 0.f;
#pragma unroll 2
        for (int k = 0; k < NQ; ++k) { int q;
            if (dir == 0) q = k; else q = (k < NCC) ? NCC - 1 - k : (NQ - 1 - (k - NCC));
            c0[(size_t)q * 1024] = hs; hs = s0[(size_t)q * 2048] * hs + s0[(size_t)q * 2048 + 1024]; }
    }
}
constexpr int PL_PF = 0  , PL_MB = 40960  , PL_MROW = 272;
__device__ __forceinline__ void pool_item(const Args& a, LAS unsigned char* lds, int l, int item) {
    const int tid = opaque_tid(), lane = tid & 63, wave = __builtin_amdgcn_readfirstlane(tid >> 6);
    int g, R0, L, t0;
    if (item < 1024) { g = item & 3; R0 = (item >> 2) * 64; L = 64; t0 = 0; }
    else { const int it = item - 1024; g = it & 3; const int blk = (it >> 2) & 3, b = it >> 4; R0 = ML + b * CTX; L = CTX; t0 = blk * 64; }
    const bf16* P = (const bf16*)(a.ws + WS_P); LAS float* pf = (LAS float*)(lds + PL_PF);
    for (int idx = tid; idx < 1280; idx += 512) { const int row = idx >> 4, c8 = (idx & 15) * 8, tt = t0 - 8 + row;
        if (tt >= 0 && tt < L) { const u32x4 v = *(const u32x4*)(P + (size_t)(R0 + tt) * D_POOL + g * 128 + c8);
            *(LAS f32x4*)(pf + row * 128 + c8) = (f32x4){bf_lo(v.x), bf_hi(v.x), bf_lo(v.y), bf_hi(v.y)}; *(LAS f32x4*)(pf + row * 128 + c8 + 4) = (f32x4){bf_lo(v.z), bf_hi(v.z), bf_lo(v.w), bf_hi(v.w)}; } }
    __syncthreads();
    { const int c = tid & 127, tq = tid >> 7, hw = 1 << g;
      for (int k = 0; k < 16; ++k) { const int t = tq * 16 + k, tt = t0 + t; const int lo = max(tt - hw, 0), hi = min(tt + hw, L); float s = 0.f;
#pragma unroll
          for (int u = 0; u < 16; ++u) { const int uu = min(lo + u, hi - 1); const float v = pf[(uu - t0 + 8) * 128 + c]; s += (lo + u < hi) ? v : 0.f; }
          const float mval = s / (float)(hi - lo) - pf[(t + 8) * 128 + c];
          *(LAS unsigned short*)(lds + PL_MB + t * PL_MROW + c * 2) = (unsigned short)(cvt_pk_bf16(mval, 0.f) & 0xffffu); } }
    __syncthreads();
    { const int mblk = wave & 1, nblk = wave >> 1, l31 = lane & 31, lh = lane >> 5, e = nblk * 32 + l31;
      const bf16* pw = (const bf16*)(a.ws + WS_PW) + ((size_t)(l * 4 + g) * 128 + e) * 128 + lh * 8;
      f32x16 acc;
#pragma unroll
      for (int i = 0; i < 16; ++i) acc[i] = 0.f;
#pragma unroll
      for (int ks = 0; ks < 8; ++ks) { const bf16x8 af = *(const LAS bf16x8*)(lds + PL_MB + (mblk * 32 + l31) * PL_MROW + (ks * 16 + lh * 8) * 2); const bf16x8 bw = *(const bf16x8*)(pw + ks * 16);
          acc = __builtin_amdgcn_mfma_f32_32x32x16_bf16(af, bw, acc, 0, 0, 0); }
      const float scl = a.in[I_POOLS][l * D_POOL + g * 128 + e];
      bf16* PM = (bf16*)(a.ws + WS_PM) + (size_t)(R0 + t0) * D_POOL + g * 128 + e;
#pragma unroll
      for (int reg = 0; reg < 16; ++reg) { const int t = mblk * 32 + (reg & 3) + 8 * (reg >> 2) + 4 * lh; PM[(size_t)t * D_POOL] = (bf16)(cvt_pk_bf16(acc[reg] * scl, 0.f) & 0xffffu); } }
    __syncthreads();
}
#define XB_TMO      128
#define XB_XCNT(j)  (256  + 64 * (j))
#define XB_XSUB(j)  (1280 + 64 * (j))
#define XB_XGEN(j)  (2304 + 64 * (j))
#define XB_TOP      3328
#define XB_TOPGEN   3392
#define XCD_BAR_WORDS 3456
#define XB_SPIN_CAP (1u << 18)

__device__ __forceinline__ unsigned xb_ld(unsigned* p)              { return __hip_atomic_load(p, __ATOMIC_RELAXED, __HIP_MEMORY_SCOPE_AGENT); }
__device__ __forceinline__ unsigned xb_add(unsigned* p, unsigned v) { return __hip_atomic_fetch_add(p, v, __ATOMIC_RELAXED, __HIP_MEMORY_SCOPE_AGENT); }
__device__ __forceinline__ unsigned xb_xcc_id() { return (unsigned)__builtin_amdgcn_s_getreg((3 << 11) | 20) & 0xFu; }
#define XB_SPIN(cond, bar) do { unsigned _sp = 0; while (cond) { __builtin_amdgcn_s_sleep(1); \
    if ((++_sp & 255u) == 0u) { if (xb_ld(&(bar)[XB_TMO])) break; if (_sp > XB_SPIN_CAP) { atomicAdd(&(bar)[XB_TMO], 1u); break; } } } } while (0)

struct XcdBarrier {
    unsigned* bar; unsigned x;
    volatile LAS unsigned* st;
};

__device__ __forceinline__ XcdBarrier xcd_barrier_post(unsigned* bar, volatile LAS unsigned* st) {
    XcdBarrier b; b.bar = bar; b.x = xb_xcc_id(); b.st = st;
    if (threadIdx.x == 0) (void)xb_add(&bar[XB_XCNT(b.x)], 1u);
    return b;
}
__device__ __forceinline__ void xcd_barrier_complete(unsigned* bar, unsigned x, unsigned& nloc, unsigned& nx) {
    const unsigned G = gridDim.x * gridDim.y * gridDim.z;
    unsigned sum, cnt, mine, sp = 0u;
    for (;;) {
        sum = 0u; cnt = 0u; mine = 0u;
#pragma unroll
        for (unsigned j = 0; j < 16; ++j) { const unsigned c = xb_ld(&bar[XB_XCNT(j)]); sum += c; cnt += (c > 0u) ? 1u : 0u; mine = (j == x) ? c : mine; }
        if (sum == G) break;
        __builtin_amdgcn_s_sleep(1);
        if ((++sp & 255u) == 0u) { if (xb_ld(&bar[XB_TMO])) break; if (sp > XB_SPIN_CAP) { atomicAdd(&bar[XB_TMO], 1u); break; } }
    }
    nloc = mine > 0u ? mine : 1u; nx = cnt > 0u ? cnt : 1u;
}

__device__ __forceinline__ void xcd_barrier(const XcdBarrier& b) {
    asm volatile("s_waitcnt vmcnt(0)" ::: "memory");
    __syncthreads();
    if (threadIdx.x == 0) {
        unsigned* bar = b.bar;
        __builtin_amdgcn_s_waitcnt(0);
        unsigned nloc = b.st[0], nx = b.st[1];
        if (nloc == 0u) { xcd_barrier_complete(bar, b.x, nloc, nx); b.st[0] = nloc; b.st[1] = nx; }
        const unsigned old = xb_add(&bar[XB_XSUB(b.x)], 1u);
        const unsigned gen = old / nloc;
        if (old + 1u == (gen + 1u) * nloc) {
            __builtin_amdgcn_fence(__ATOMIC_RELEASE, "agent");
            asm volatile("s_waitcnt vmcnt(0)" ::: "memory");
            const unsigned og = xb_add(&bar[XB_TOP], 1u);
            const unsigned tg = og / nx;
            if (og + 1u == (tg + 1u) * nx) xb_add(&bar[XB_TOPGEN], 1u);
            else XB_SPIN(xb_ld(&bar[XB_TOPGEN]) == tg, bar);
            __builtin_amdgcn_fence(__ATOMIC_ACQUIRE, "agent");
            xb_add(&bar[XB_XGEN(b.x)], 1u);
            asm volatile("s_waitcnt vmcnt(0)" ::: "memory");
        } else {
            XB_SPIN(xb_ld(&bar[XB_XGEN(b.x)]) == gen, bar);
            __builtin_amdgcn_fence(__ATOMIC_ACQUIRE, "agent");
            asm volatile("s_waitcnt vmcnt(0)" ::: "memory");
        }
    }
    __syncthreads();
}

constexpr int NPHASE = 22;
__global__ void __launch_bounds__(512, 2) mk_fwd(Args a) {
    extern __shared__ __attribute__((aligned(16))) unsigned char lds_raw[];
    LAS unsigned char* lds = (LAS unsigned char*)lds_raw;
    cg::grid_group grid = cg::this_grid();
    volatile LAS unsigned* MISC = (volatile LAS unsigned*)(lds + MISC_OFF);
    if (threadIdx.x < 64) MISC[threadIdx.x] = 0u;
    __syncthreads();
    XcdBarrier xbar; xbar.bar = (unsigned*)(a.ws + WS_BAR); xbar.x = 0; xbar.st = MISC + 8;
    if (a.hi - a.lo > 1) xbar = xcd_barrier_post((unsigned*)(a.ws + WS_BAR), MISC + 8);
    const int G = gridDim.x, bx = blockIdx.x, NGW = G * 8;
#define WL() const int tid_ = opaque_tid(), lane = tid_ & 63, wave = __builtin_amdgcn_readfirstlane(tid_ >> 6), gw = bx * 8 + wave
    const int lo = a.lo, hi = a.hi;
    unsigned char* ws = a.ws;
    float* MOD = (float*)(ws + WS_MOD); float* XC = (float*)(ws + WS_XC);
    bf16* Hb = (bf16*)(ws + WS_H); bf16* Ub = (bf16*)(ws + WS_U); bf16* Gb = (bf16*)(ws + WS_G); bf16* Pb = (bf16*)(ws + WS_P); bf16* GTb = (bf16*)(ws + WS_GT); bf16* PMb = (bf16*)(ws + WS_PM); bf16* Fb = (bf16*)(ws + WS_F);
#ifndef PH_MASK
#define PH_MASK 0xfff
#endif
#define IN(k) (lo <= (k) && (k) < hi)
#define ON(b) ((PH_MASK >> (b)) & 1)
#ifndef REP_MASK
#define REP_MASK 0
#endif
#define REPS(b) for (int rep_ = 0; rep_ < 1 + ((REP_MASK >> (b)) & 1); ++rep_)
#ifndef SYNC_REP
#define SYNC_REP 1
#endif
#define SEAM(k) do { if (IN(k) && IN((k) + 1)) for (int sr_ = 0; sr_ < SYNC_REP; ++sr_) { if ((k) == 0) grid.sync(); else xcd_barrier(xbar); } } while (0)
    if (ON(0) && IN(0)) REPS(0) {
        for (int it = bx; it < 192; it += G) mod_item(a, lds, it);
        WL();
        convert_small(a, lds, gw, NGW, wave, lane);
        convert_big(a, lds, 0, gw, NGW, wave, lane);
    }
    SEAM(0);
#pragma unroll 1
    for (int l = 0; l < DEPTH; ++l) {
        const int pb = 1 + 10 * l; const bool last = (l == DEPTH - 1);
        const float* modl = MOD + (size_t)l * 5 * MODW;
        const float* xsrcL = l == 0 ? a.in[I_X] : a.out; const float* xsrcC = l == 0 ? a.in[I_CTX] : XC;
        const int Mrest = last ? ML : MT;
        if (ON(1) && IN(pb + 0)) REPS(1) {
            WL();
            if (l > 0) convert_big(a, lds, l, gw, NGW, wave, lane);
            norm_rows(xsrcL, xsrcC, Hb, a.in[I_N1G] + l * D, modl, 0, 1, MT, gw, NGW, lane, l > 0 ? (const float*)(ws + WS_SLAB5) : nullptr, MOD + 4 * MODW + 5 * D  , nullptr);
        }
        SEAM(pb + 0);
        if (ON(2) && IN(pb + 1)) REPS(2) {
            pg8::Gemm g{Hb, (const bf16*)(ws + WS_WIN), MT, D_IN, D, D}; pg8::StaticOrder S; S.init(MT, D_IN, G, bx);
            pg8::EpiSplit E{Ub, Gb, Pb, GTb};
            pg8::gemm_phase<pg8::EpiSplit, pg8::StaticOrder, true, true>(lds, g, S, E);
        }
        SEAM(pb + 1);
        if (ON(3) && IN(pb + 2)) REPS(3) {
            const int npool = last ? 1024 : 1088;
            { WL(); const int nit = NLAT + NCTX, nfull = (nit / NGW) * NGW;
              for (int it = gw; it < nfull; it += NGW) scan_task<false>(a, lds, l, it, wave, lane);
              { const int j = wave * G + bx; if (j < nit - nfull) scan_task<false>(a, lds, l, nfull + j, wave, lane); } }
            __syncthreads();
            for (int it = bx; it < npool; it += G) pool_item(a, lds, l, it);
        }
        SEAM(pb + 2);
        if (ON(4) && IN(pb + 3)) REPS(4) carry_phase(a);
        SEAM(pb + 3);
        if (ON(5) && IN(pb + 4)) REPS(5) { WL(); const int nit = last ? NLAT : NLAT + NCTX, nfull = (nit / NGW) * NGW;
            for (int it = gw; it < nfull; it += NGW) scan_task<true>(a, lds, l, it, wave, lane);
            { const int j = wave * G + bx; if (j < nit - nfull) scan_task<true>(a, lds, l, nfull + j, wave, lane); } }
        SEAM(pb + 4);
        if (ON(6) && IN(pb + 5)) REPS(6) {
            { pg8::Gemm g{PMb, (const bf16*)(ws + WS_WPO), Mrest, D, D_POOL, D_POOL}; pg8::StaticOrder S; S.init(Mrest, D, G, bx);
              pg8::EpiGate<0> E{Ub, GTb}; pg8::gemm_phase<pg8::EpiGate<0>, pg8::StaticOrder, true, true>(lds, g, S, E); }
            { pg8::Gemm g{Hb, (const bf16*)(ws + WS_WLO), Mrest, D, D, D}; pg8::StaticOrder S; S.init(Mrest, D, G, bx);
              pg8::EpiGate<1> E{Ub, GTb}; pg8::gemm_phase<pg8::EpiGate<1>, pg8::StaticOrder, true, true>(lds, g, S, E); }
        }
        SEAM(pb + 5);
        if (ON(7) && IN(pb + 6)) {
            { pg8::Gemm g{Ub, (const bf16*)(ws + WS_WO), ML, D, D, D}; pg8::StaticOrder S; S.init(ML, D, G, bx);
              pg8::EpiRes E{xsrcL, xsrcC, a.out, XC, modl + 2 * D};
              pg8::gemm_phase<pg8::EpiRes, pg8::StaticOrder, true, true>(lds, g, S, E); }
            if (!last) {
              int ksl = 256; asm volatile("" : "+s"(ksl));
              pg8::Gemm g{Ub + (size_t)ML * D, (const bf16*)(ws + WS_WO), MC, D, ksl, D}; pg8::SplitOrder S; S.init(MC, D, D, ksl, G, bx);
              pg8::EpiSlab E{(float*)(ws + WS_SLAB3)};
              pg8::gemm_phase<pg8::EpiSlab, pg8::SplitOrder, true, true>(lds, g, S, E); }
        }
        SEAM(pb + 6);
        if (ON(8) && IN(pb + 7)) REPS(8) { WL(); norm_rows(a.out, l == 0 ? a.in[I_CTX] : XC, Hb, a.in[I_N2G] + l * D, modl, 3, 4, Mrest, gw, NGW, lane, l == 0 ? (const float*)(ws + WS_SLAB3) : nullptr, modl + 4 * MODW + 2 * D  , XC); }
        SEAM(pb + 7);
        if (ON(9) && IN(pb + 8)) REPS(9) {
            pg8::Gemm g{Hb, (const bf16*)(ws + WS_W1), Mrest, D_FF, D, D}; pg8::StaticOrder S; S.init(Mrest, D_FF, G, bx);
            pg8::EpiSqRelu E{Fb, D_FF};
            pg8::gemm_phase<pg8::EpiSqRelu, pg8::StaticOrder, true, true>(lds, g, S, E);
        }
        SEAM(pb + 8);
        if (ON(10) && IN(pb + 9)) {
            { pg8::Gemm g{Fb, (const bf16*)(ws + WS_W2), ML, D, D_FF, D_FF}; pg8::StaticOrder S; S.init(ML, D, G, bx);
              pg8::EpiRes E{a.out, XC, a.out, XC, modl + 5 * D};
              pg8::gemm_phase<pg8::EpiRes, pg8::StaticOrder, true, true>(lds, g, S, E); }
            if (!last) {
              int ksl = 1024; asm volatile("" : "+s"(ksl));
              pg8::Gemm g{Fb + (size_t)ML * D_FF, (const bf16*)(ws + WS_W2), MC, D, ksl, D_FF}; pg8::SplitOrder S; S.init(MC, D, D_FF, ksl, G, bx);
              pg8::EpiSlab E{(float*)(ws + WS_SLAB5)};
              pg8::gemm_phase<pg8::EpiSlab, pg8::SplitOrder, true, true>(lds, g, S, E); }
        }
        SEAM(pb + 9);
    }
    if (ON(11) && IN(21)) { WL(); final_rows(a.out, a.in[I_FG], gw, NGW, lane); }
#undef IN
#undef SEAM
}

extern "C" void kernel_launch(void* const* d_in, const int* in_sizes, int n_in, void* d_out, int out_size, void* d_ws, size_t ws_size, hipStream_t stream) {
    static int grid = 0;
    if (grid == 0) {
        if (n_in != 24 || out_size != ML * D || ws_size < WS_END) { fprintf(stderr, "kernel_launch: unexpected shapes (n_in %d, out %d, ws %zu)\n", n_in, out_size, ws_size); grid = -1; return; }
        int dev = 0, cus = 0, per_cu = 0;
        if (hipGetDevice(&dev) != hipSuccess || hipDeviceGetAttribute(&cus, hipDeviceAttributeMultiprocessorCount, dev) != hipSuccess) { grid = -1; return; }
        if (hipFuncSetAttribute((const void*)mk_fwd, hipFuncAttributeMaxDynamicSharedMemorySize, LDS_BYTES) != hipSuccess) { fprintf(stderr, "kernel_launch: hipFuncSetAttribute failed\n"); grid = -1; return; }
        if (hipOccupancyMaxActiveBlocksPerMultiprocessor(&per_cu, (const void*)mk_fwd, 512, LDS_BYTES) != hipSuccess || per_cu < 1) { fprintf(stderr, "kernel_launch: occupancy query says %d\n", per_cu); per_cu = 1; }
        (void)hipGetLastError();
        grid = cus;
    }
    if (grid < 0) return;
    Args a{};
    for (int i = 0; i < 24; ++i) a.in[i] = (const float*)d_in[i];
    a.out = (float*)d_out; a.ws = (unsigned char*)d_ws;
#if MK_PER_PHASE
    for (int p = 0; p < NPHASE; ++p) { a.lo = p; a.hi = p + 1; hipLaunchKernelGGL(mk_fwd, dim3(grid), dim3(512), LDS_BYTES, stream, a); }
#else
    a.lo = 0; a.hi = NPHASE;
    if (hipMemsetAsync((char*)d_ws + WS_BAR, 0, 16384, stream) != hipSuccess) { fprintf(stderr, "kernel_launch: memset of the barrier words failed\n"); return; }
    void* args[] = {&a};
    hipError_t e = hipLaunchCooperativeKernel((const void*)mk_fwd, dim3(grid), dim3(512), args, LDS_BYTES, stream);
    if (e != hipSuccess) fprintf(stderr, "kernel_launch: cooperative launch failed: %s (grid %d)\n", hipGetErrorString(e), grid);
#endif
}
```

```cpp
#include <hip/hip_runtime.h>
#include <hip/hip_cooperative_groups.h>
#include <cstdio>
#include <cstdint>
namespace cg = cooperative_groups;
#ifndef MK_PER_PHASE
#define MK_PER_PHASE 0
#endif
__device__ __forceinline__ int opaque_tid() { int t = threadIdx.x; asm volatile("" : "+v"(t) : : "memory"); return t; }
namespace pg8 {
#define PG8_LAS __attribute__((address_space(3)))
typedef unsigned short bf16_t;
typedef short bf16x8 __attribute__((ext_vector_type(8)));
typedef float f32x4 __attribute__((ext_vector_type(4)));
typedef unsigned u32x4 __attribute__((ext_vector_type(4)));
constexpr int BM = 256, BK = 64, HALF = 128, HTB = HALF * BK * 2  , STAGE_BYTES = 8 * HTB, NXCD = 8, WGM = 8;

__host__ __device__ __forceinline__ int lds_byte(int r, int c) { const int st = (r >> 4) * 2 + (c >> 5), rr = r & 15, cc = c & 31, ob = rr * 64 + cc * 2; return st * 1024 + (ob ^ (((ob >> 9) & 1) << 5)); }
__host__ __device__ __forceinline__ void stage_rc(int b, int& R, int& C) { const int st = b / 1024, sb = b % 1024, swz = sb ^ (((sb >> 9) & 1) << 5); R = (st >> 1) * 16 + swz / 64; C = (st & 1) * 32 + (swz % 64) / 2; }
__host__ __device__ __forceinline__ int perm32(int rho) { const int n = rho >> 4, i = rho & 15; return 8 * (i >> 2) + 4 * n + (i & 3); }

struct Unit { int pm, pn, kb, ks; };
struct Gemm { const bf16_t* A; const bf16_t* Bt; int M, N, K, ld; };

struct StaticOrder {
    int nM, nN, nwg, G, c;
    __host__ __device__ void init(int M, int N, int G_, int c_) { nM = M / BM; nN = N / BM; nwg = nM * nN; G = G_; c = c_; }
    __host__ __device__ bool next(int i, Unit& u) const {
        const long L = (long)i * G + c; if (L >= nwg) return false;
        int wgid = (int)L; { const int q = nwg / NXCD, r = nwg % NXCD, xcd = wgid % NXCD, off = wgid / NXCD; wgid = (xcd < r ? xcd * (q + 1) : r * (q + 1) + (xcd - r) * q) + off; }
        const int nig = WGM * nN, gid = wgid / nig, fm = gid * WGM, gsz = (nM - fm) < WGM ? (nM - fm) : WGM;
        u.pm = fm + ((wgid % nig) % gsz); u.pn = (wgid % nig) / gsz; u.kb = 0; u.ks = 0; return true;
    }
    __device__ __forceinline__ void a_ready(const Unit&) const {}
    __device__ __forceinline__ void done(const Unit&) const {}
};
struct SplitOrder {
    int nN, nS, ksl, ntot, G, c;
    __host__ __device__ void init(int M, int N, int Kfull, int ksl_, int G_, int c_) { nN = N / BM; nS = Kfull / ksl_; ksl = ksl_; ntot = (M / BM) * nN * nS; G = G_; c = c_; }
    __host__ __device__ bool next(int i, Unit& u) const { const int j = i * G + c; if (j >= ntot) return false; const int ks = j % nS, t = j / nS; u.pn = t % nN; u.pm = t / nN; u.kb = ks * ksl; u.ks = ks; return true; }
    __device__ __forceinline__ void a_ready(const Unit&) const {}
    __device__ __forceinline__ void done(const Unit&) const {}
};
__device__ __forceinline__ unsigned cvt_pk_bf16(float lo, float hi) { unsigned r; asm volatile("v_cvt_pk_bf16_f32 %0, %1, %2" : "=v"(r) : "v"(lo), "v"(hi)); return r; }
__device__ __forceinline__ float bf_lo(unsigned w) { return __uint_as_float(w << 16); }
__device__ __forceinline__ float bf_hi(unsigned w) { return __uint_as_float(w & 0xffff0000u); }
__device__ __forceinline__ float sigm(float x) { return __builtin_amdgcn_rcpf(1.0f + __expf(-x)); }

struct EpiSplit {
    static constexpr bool PERM = true, AFTER_DRAIN = false;
    bf16_t *U, *G, *P, *GT;
    __device__ __forceinline__ void operator()(const f32x4 (&acc)[2][2][4][2], const Unit& u, int wr, int wc, int fr, int fq) const {
        bf16_t* base; int ldc, colt;
        if (u.pn < 4) { base = U; ldc = 1024; colt = u.pn * 256; }
        else if (u.pn < 8) { base = G; ldc = 1024; colt = (u.pn - 4) * 256; }
        else if (u.pn < 10) { base = P; ldc = 512; colt = (u.pn - 8) * 256; }
        else { base = GT; ldc = 2048; colt = (u.pn - 10) * 256; }
        const int row0 = u.pm * BM + wr * 64 + fr, col0 = colt + wc * 32 + 8 * fq;
#pragma unroll
        for (int ai = 0; ai < 2; ++ai)
#pragma unroll
            for (int m = 0; m < 4; ++m) { bf16_t* rowp = base + (size_t)(row0 + ai * HALF + m * 16) * ldc + col0;
#pragma unroll
                for (int bj = 0; bj < 2; ++bj) { const f32x4 v0 = acc[ai][bj][m][0], v1 = acc[ai][bj][m][1];
                    u32x4 w; w.x = cvt_pk_bf16(v0[0], v0[1]); w.y = cvt_pk_bf16(v0[2], v0[3]); w.z = cvt_pk_bf16(v1[0], v1[1]); w.w = cvt_pk_bf16(v1[2], v1[3]);
                    *(u32x4*)(rowp + bj * HALF) = w; } }
    }
};
template <int MODE> struct EpiGate {
    static constexpr bool PERM = true, AFTER_DRAIN = false;
    bf16_t* Z; const bf16_t* GT;
    __device__ __forceinline__ void operator()(const f32x4 (&acc)[2][2][4][2], const Unit& u, int wr, int wc, int fr, int fq) const {
        const int row0 = u.pm * BM + wr * 64 + fr, col0 = u.pn * BM + wc * 32 + 8 * fq;
#pragma unroll
        for (int ai = 0; ai < 2; ++ai)
#pragma unroll
            for (int m = 0; m < 4; ++m) { const size_t row = (size_t)(row0 + ai * HALF + m * 16);
#pragma unroll
                for (int bj = 0; bj < 2; ++bj) { const int col = col0 + bj * HALF;
                    const u32x4 gt = *(const u32x4*)(GT + row * 2048 + (MODE == 0 ? 1024 : 0) + col);
                    f32x4 v0 = acc[ai][bj][m][0], v1 = acc[ai][bj][m][1];
                    v0[0] *= sigm(bf_lo(gt.x)); v0[1] *= sigm(bf_hi(gt.x)); v0[2] *= sigm(bf_lo(gt.y)); v0[3] *= sigm(bf_hi(gt.y));
                    v1[0] *= sigm(bf_lo(gt.z)); v1[1] *= sigm(bf_hi(gt.z)); v1[2] *= sigm(bf_lo(gt.w)); v1[3] *= sigm(bf_hi(gt.w));
                    u32x4* zp = (u32x4*)(Z + row * 1024 + col);
                    if (MODE == 1) { const u32x4 z = *zp;
                        v0[0] += bf_lo(z.x); v0[1] += bf_hi(z.x); v0[2] += bf_lo(z.y); v0[3] += bf_hi(z.y);
                        v1[0] += bf_lo(z.z); v1[1] += bf_hi(z.z); v1[2] += bf_lo(z.w); v1[3] += bf_hi(z.w); }
                    u32x4 w; w.x = cvt_pk_bf16(v0[0], v0[1]); w.y = cvt_pk_bf16(v0[2], v0[3]); w.z = cvt_pk_bf16(v1[0], v1[1]); w.w = cvt_pk_bf16(v1[2], v1[3]);
                    *zp = w; }
                asm volatile("" ::: "memory"); }
    }
};
struct EpiRes {
    static constexpr bool PERM = false, AFTER_DRAIN = false;
    const float* srcL; const float* srcC; float* dstL; float* dstC; const float* gate;
    __device__ __forceinline__ void operator()(const f32x4 (&acc)[2][2][4][2], const Unit& u, int wr, int wc, int fr, int fq) const {
        const bool lat = u.pm < 64;
        const size_t tb = (size_t)(lat ? u.pm : u.pm - 64) * 256 * 1024;
        const float* src = (lat ? srcL : srcC) + tb; float* dst = (lat ? dstL : dstC) + tb;
        const float* gv = gate + (lat ? (u.pm >> 4) : 4) * 6144;
        const int rl0 = wr * 64 + fr, col0 = u.pn * BM + wc * 32 + 4 * fq;
        f32x4 g[2][2];
#pragma unroll
        for (int bj = 0; bj < 2; ++bj)
#pragma unroll
            for (int n = 0; n < 2; ++n) g[bj][n] = *(const f32x4*)(gv + col0 + bj * HALF + n * 16);
#pragma unroll
        for (int ai = 0; ai < 2; ++ai)
#pragma unroll
            for (int m = 0; m < 4; ++m) { const size_t off = (size_t)(rl0 + ai * HALF + m * 16) * 1024 + col0;
#pragma unroll
                for (int bj = 0; bj < 2; ++bj)
#pragma unroll
                    for (int n = 0; n < 2; ++n) { const f32x4 s = *(const f32x4*)(src + off + bj * HALF + n * 16);
                        *(f32x4*)(dst + off + bj * HALF + n * 16) = s + g[bj][n] * acc[ai][bj][m][n]; }
                asm volatile("" ::: "memory"); }
    }
};
struct EpiSqRelu {
    static constexpr bool PERM = true, AFTER_DRAIN = false;
    bf16_t* F; int ldc;
    __device__ __forceinline__ void operator()(const f32x4 (&acc)[2][2][4][2], const Unit& u, int wr, int wc, int fr, int fq) const {
        const int row0 = u.pm * BM + wr * 64 + fr, col0 = u.pn * BM + wc * 32 + 8 * fq;
#pragma unroll
        for (int ai = 0; ai < 2; ++ai)
#pragma unroll
            for (int m = 0; m < 4; ++m) { bf16_t* rowp = F + (size_t)(row0 + ai * HALF + m * 16) * ldc + col0;
#pragma unroll
                for (int bj = 0; bj < 2; ++bj) { f32x4 v0 = acc[ai][bj][m][0], v1 = acc[ai][bj][m][1];
#pragma unroll
                    for (int j = 0; j < 4; ++j) { const float a0 = fmaxf(v0[j], 0.f), a1 = fmaxf(v1[j], 0.f); v0[j] = a0 * a0; v1[j] = a1 * a1; }
                    u32x4 w; w.x = cvt_pk_bf16(v0[0], v0[1]); w.y = cvt_pk_bf16(v0[2], v0[3]); w.z = cvt_pk_bf16(v1[0], v1[1]); w.w = cvt_pk_bf16(v1[2], v1[3]);
                    *(u32x4*)(rowp + bj * HALF) = w; } }
    }
};

struct EpiSlab {
    static constexpr bool PERM = false, AFTER_DRAIN = false;
    float* slab;
    __device__ __forceinline__ void operator()(const f32x4 (&acc)[2][2][4][2], const Unit& u, int wr, int wc, int fr, int fq) const {
        float* p0 = slab + ((size_t)u.ks * 1024 + u.pm * BM + wr * 64 + fr) * 1024 + u.pn * BM + wc * 32 + 4 * fq;
#pragma unroll
        for (int ai = 0; ai < 2; ++ai)
#pragma unroll
            for (int m = 0; m < 4; ++m) { float* rowp = p0 + (size_t)(ai * HALF + m * 16) * 1024;
#pragma unroll
                for (int bj = 0; bj < 2; ++bj)
#pragma unroll
                    for (int n = 0; n < 2; ++n) *(f32x4*)(rowp + bj * HALF + n * 16) = acc[ai][bj][m][n]; }
    }
};

template <class Epi, class Sched, bool ALIGN_EPI = false, bool SP2 = false>
__device__ __forceinline__ void gemm_phase(PG8_LAS unsigned char* lds, const Gemm g, const Sched& S, const Epi& E) {
    const int tid = opaque_tid(), wid = __builtin_amdgcn_readfirstlane(tid >> 6), lane = tid & 63, wr = wid >> 2, wc = wid & 3, fr = lane & 15, fq = lane >> 4;
    const int K = g.ld, nt = g.K / BK;
    unsigned voffA[2], voffB[2];
#pragma unroll
    for (int i = 0; i < 2; ++i) { int R, C; stage_rc(tid * 16 + i * 8192, R, C); const int Rb = Epi::PERM ? ((R & ~31) + perm32(R & 31)) : R;
        voffA[i] = (unsigned)(R * K + C) * 2u; voffB[i] = (unsigned)(Rb * K + C) * 2u; }
    const size_t kstep = (size_t)(BK * 2);
    const size_t hstep = (size_t)HALF * K * 2;
    const size_t tstep = 2 * hstep;
    const unsigned ldsw = (unsigned)wid * 1024u;
    const int aoff = lds_byte(wr * 64 + fr, fq * 8), boff = lds_byte(wc * 32 + fr, fq * 8);
#define PG8_SA(b, h) (((b) * 2 + (h)) * HTB)
#define PG8_SB(b, h) ((4 + (b) * 2 + (h)) * HTB)
#define PG8_STAGE(bufoff, gbase, voff) do { _Pragma("unroll") for (int _i = 0; _i < 2; ++_i) \
        __builtin_amdgcn_global_load_lds((const unsigned*)((const char*)(gbase) + (voff)[_i]), (PG8_LAS unsigned*)(lds + (bufoff) + ldsw + _i * 8192), 16, 0, 0); } while (0)
#define PG8_LDA(dst, b, h) do { _Pragma("unroll") for (int m = 0; m < 4; ++m) _Pragma("unroll") for (int k = 0; k < 2; ++k) dst[m][k] = *(const PG8_LAS bf16x8*)(lds + PG8_SA(b, h) + aoff + m * 2048 + k * 1024); } while (0)
#define PG8_LDB(dst, b, h) do { _Pragma("unroll") for (int n = 0; n < 2; ++n) _Pragma("unroll") for (int k = 0; k < 2; ++k) dst[n][k] = *(const PG8_LAS bf16x8*)(lds + PG8_SB(b, h) + boff + n * 2048 + k * 1024); } while (0)
#define PG8_MMA(ai, bj, At, Bt) do { __builtin_amdgcn_s_setprio(1); _Pragma("unroll") for (int m = 0; m < 4; ++m) _Pragma("unroll") for (int n = 0; n < 2; ++n) _Pragma("unroll") for (int k = 0; k < 2; ++k) \
        acc[ai][bj][m][n] = __builtin_amdgcn_mfma_f32_16x16x32_bf16(Bt[n][k], At[m][k], acc[ai][bj][m][n], 0, 0, 0); __builtin_amdgcn_s_setprio(0); } while (0)
#define PG8_WAIT_V(n) asm volatile("s_waitcnt vmcnt(" #n ")" ::: "memory")
#define PG8_WAIT_L(n) asm volatile("s_waitcnt lgkmcnt(" #n ")" ::: "memory")
#define PG8_BAR __builtin_amdgcn_s_barrier()
#define PG8_SCHED __builtin_amdgcn_sched_barrier(0)
    Unit cur, nxt; int ui = 0;
    if (!S.next(0, cur)) return;
    f32x4 acc[2][2][4][2];
#pragma unroll
    for (int a = 0; a < 2; ++a)
#pragma unroll
        for (int b = 0; b < 2; ++b)
#pragma unroll
            for (int m = 0; m < 4; ++m)
#pragma unroll
                for (int n = 0; n < 2; ++n) acc[a][b][m][n] = (f32x4){0.f, 0.f, 0.f, 0.f};
    bf16x8 At[4][2], B0[2][2], B1[2][2];
    const char* cA = (const char*)g.A + (size_t)cur.pm * tstep + (size_t)cur.kb * 2; const char* cB = (const char*)g.Bt + (size_t)cur.pn * tstep + (size_t)cur.kb * 2;
    S.a_ready(cur);
    if constexpr (SP2) {
        PG8_STAGE(PG8_SB(0, 0), cB, voffB); PG8_STAGE(PG8_SB(0, 1), cB + hstep, voffB); PG8_STAGE(PG8_SA(0, 0), cA, voffA); PG8_STAGE(PG8_SA(0, 1), cA + hstep, voffA);
        if (wr == 1) PG8_BAR;
        PG8_WAIT_V(2); PG8_BAR;
        PG8_STAGE(PG8_SB(1, 0), cB + kstep, voffB); PG8_STAGE(PG8_SA(1, 0), cA + kstep, voffA); PG8_STAGE(PG8_SB(1, 1), cB + hstep + kstep, voffB);
        PG8_WAIT_V(6); PG8_BAR;
    } else {
        PG8_STAGE(PG8_SB(0, 0), cB, voffB); PG8_STAGE(PG8_SA(0, 0), cA, voffA); PG8_STAGE(PG8_SB(0, 1), cB + hstep, voffB); PG8_STAGE(PG8_SA(0, 1), cA + hstep, voffA);
        if (wr == 1) PG8_BAR;
        PG8_WAIT_V(4); PG8_BAR;
        PG8_STAGE(PG8_SB(1, 0), cB + kstep, voffB); PG8_STAGE(PG8_SA(1, 0), cA + kstep, voffA); PG8_STAGE(PG8_SB(1, 1), cB + hstep + kstep, voffB);
        PG8_WAIT_V(6); PG8_BAR;
    }
    for (;;) {
        const bool has_next = S.next(ui + 1, nxt);
        const char* nA = has_next ? (const char*)g.A + (size_t)nxt.pm * tstep + (size_t)nxt.kb * 2 : cA; const char* nB = has_next ? (const char*)g.Bt + (size_t)nxt.pn * tstep + (size_t)nxt.kb * 2 : cB;
        for (int t = 0; t < nt; t += 2) {
            const bool last = (t == nt - 2);
            const char* a1 = cA + (size_t)(t + 1) * kstep;
            const char* a2 = last ? nA : cA + (size_t)(t + 2) * kstep; const char* b2 = last ? nB : cB + (size_t)(t + 2) * kstep;
            const char* a3 = a2 + kstep; const char* b3 = b2 + kstep;
            if (last && has_next) S.a_ready(nxt);
            if constexpr (SP2) {
            PG8_LDB(B0, 0, 0); PG8_LDB(B1, 0, 1); PG8_SCHED; PG8_LDA(At, 0, 0); PG8_STAGE(PG8_SA(1, 1), a1 + hstep, voffA);
            PG8_WAIT_V(8); PG8_WAIT_L(0); PG8_BAR; PG8_MMA(0, 0, At, B0); PG8_MMA(0, 1, At, B1); PG8_BAR; PG8_SCHED;
            PG8_LDA(At, 0, 1); PG8_STAGE(PG8_SB(0, 0), b2, voffB); PG8_STAGE(PG8_SB(0, 1), b2 + hstep, voffB); PG8_STAGE(PG8_SA(0, 0), a2, voffA);
            PG8_WAIT_V(8); PG8_WAIT_L(0); PG8_BAR; PG8_MMA(1, 0, At, B0); PG8_MMA(1, 1, At, B1); PG8_BAR; PG8_SCHED;
            PG8_LDB(B0, 1, 0); PG8_LDB(B1, 1, 1); PG8_SCHED; PG8_LDA(At, 1, 0); PG8_STAGE(PG8_SA(0, 1), a2 + hstep, voffA);
            PG8_WAIT_V(8); PG8_WAIT_L(0); PG8_BAR; PG8_MMA(0, 0, At, B0); PG8_MMA(0, 1, At, B1); PG8_BAR; PG8_SCHED;
            PG8_LDA(At, 1, 1); PG8_STAGE(PG8_SB(1, 0), b3, voffB); PG8_STAGE(PG8_SB(1, 1), b3 + hstep, voffB); PG8_STAGE(PG8_SA(1, 0), a3, voffA);
            PG8_WAIT_V(8); PG8_WAIT_L(0); PG8_BAR; PG8_MMA(1, 0, At, B0); PG8_MMA(1, 1, At, B1); PG8_BAR; PG8_SCHED;
            } else {
            PG8_LDB(B0, 0, 0); PG8_SCHED; PG8_LDA(At, 0, 0); PG8_STAGE(PG8_SA(1, 1), a1 + hstep, voffA);
            PG8_WAIT_L(8); PG8_BAR; PG8_WAIT_L(0); PG8_MMA(0, 0, At, B0); PG8_BAR; PG8_SCHED;
            PG8_LDB(B1, 0, 1); PG8_STAGE(PG8_SB(0, 0), b2, voffB);
            PG8_BAR; PG8_WAIT_L(0); PG8_MMA(0, 1, At, B1); PG8_BAR;
            PG8_LDA(At, 0, 1); PG8_STAGE(PG8_SA(0, 0), a2, voffA);
            PG8_BAR; PG8_WAIT_L(0); PG8_MMA(1, 0, At, B0); PG8_BAR; PG8_SCHED;
            PG8_STAGE(PG8_SB(0, 1), b2 + hstep, voffB);
            PG8_WAIT_V(6); PG8_BAR; PG8_MMA(1, 1, At, B1); PG8_BAR;
            PG8_LDB(B0, 1, 0); PG8_SCHED; PG8_LDA(At, 1, 0); PG8_STAGE(PG8_SA(0, 1), a2 + hstep, voffA);
            PG8_WAIT_L(8); PG8_BAR; PG8_WAIT_L(0); PG8_MMA(0, 0, At, B0); PG8_BAR; PG8_SCHED;
            PG8_LDB(B1, 1, 1); PG8_STAGE(PG8_SB(1, 0), b3, voffB);
            PG8_BAR; PG8_WAIT_L(0); PG8_MMA(0, 1, At, B1); PG8_BAR;
            PG8_LDA(At, 1, 1); PG8_STAGE(PG8_SA(1, 0), a3, voffA);
            PG8_BAR; PG8_WAIT_L(0); PG8_MMA(1, 0, At, B0); PG8_BAR; PG8_SCHED;
            PG8_STAGE(PG8_SB(1, 1), b3 + hstep, voffB);
            PG8_WAIT_V(6); PG8_BAR; PG8_MMA(1, 1, At, B1); PG8_BAR;
            }
        }
        if constexpr (ALIGN_EPI) { if (wr == 0) PG8_BAR; }
        if constexpr (!Epi::AFTER_DRAIN) { E(acc, cur, wr, wc, fr, fq); S.done(cur); }
        if (!has_next) break;
#pragma unroll
        for (int a = 0; a < 2; ++a)
#pragma unroll
            for (int b = 0; b < 2; ++b)
#pragma unroll
                for (int m = 0; m < 4; ++m)
#pragma unroll
                    for (int n = 0; n < 2; ++n) acc[a][b][m][n] = (f32x4){0.f, 0.f, 0.f, 0.f};
        cur = nxt; cA = nA; cB = nB; ++ui;
        if constexpr (ALIGN_EPI) { if (wr == 1) PG8_BAR; }
    }
    PG8_WAIT_V(0);
    if constexpr (!ALIGN_EPI) { if (wr == 0) PG8_BAR; }
    PG8_BAR;
    if constexpr (Epi::AFTER_DRAIN) { E.fused(acc, cur, wr, wc, fr, fq, lds, wid, lane); S.done(cur); }
#undef PG8_SA
#undef PG8_SB
#undef PG8_STAGE
#undef PG8_LDA
#undef PG8_LDB
#undef PG8_MMA
#undef PG8_WAIT_V
#undef PG8_WAIT_L
#undef PG8_BAR
#undef PG8_SCHED
}
}
constexpr int D = 1024, NB = 4, SEQ = 4096, CTX = 256, DEPTH = 2;
constexpr int ML = NB * SEQ, MC = NB * CTX, MT = ML + MC;
constexpr int D_IN = 4608, D_POOL = 512, D_FF = 4096, MODW = 6 * D;
constexpr int TCH = 64;
constexpr int NSUB = TCH / 32, NCL = SEQ / TCH, NCC = CTX / TCH, NLAT = NB * NCL * 16, NCTX = NB * NCC * 16;
constexpr int NQ = NCC + NCL;
constexpr float EPS = 1e-6f;
constexpr size_t MiB = 1u << 20;
constexpr size_t WS_MOD = 0;
constexpr size_t WS_BAR = 256 * 1024;
constexpr size_t WS_SUMM = 244 * MiB;
constexpr size_t WS_CARRY = WS_SUMM + (size_t)NB * 2 * NQ * 2 * 1024 * 4;
constexpr size_t WS_XC = 4 * MiB;
constexpr size_t WS_WIN = 8 * MiB, WS_WLO = 17 * MiB, WS_WPO = 19 * MiB, WS_WO = 20 * MiB, WS_W1 = 22 * MiB, WS_W2 = 30 * MiB;
constexpr size_t WS_GW = 38 * MiB;
constexpr size_t WS_PW = 39 * MiB;
constexpr size_t WS_H = 40 * MiB;
constexpr size_t WS_U = 74 * MiB;
constexpr size_t WS_G = 108 * MiB;
constexpr size_t WS_P = 142 * MiB;
constexpr size_t WS_GT = 159 * MiB;
constexpr size_t WS_PM = 227 * MiB;
constexpr size_t WS_SLAB3 = WS_G;
constexpr size_t WS_SLAB5 = 210 * MiB;
constexpr size_t WS_F = WS_U;
constexpr size_t WS_END = 256 * MiB;
static_assert(WS_CARRY + (size_t)NB * 2 * NQ * 1024 * 4 <= 256 * MiB, "ws map (tail)");
static_assert(WS_F + (size_t)MT * D_FF * 2 <= WS_PM && WS_H + (size_t)MT * D * 2 <= WS_U && WS_GT + (size_t)MT * 2048 * 2 <= WS_PM, "ws map");
constexpr int LDS_BYTES = 8 * 19456 + 256, MISC_OFF = 8 * 19456;

#define LAS __attribute__((address_space(3)))
typedef unsigned short bf16;
typedef unsigned u32x4 __attribute__((ext_vector_type(4)));
typedef unsigned u32x2 __attribute__((ext_vector_type(2)));
typedef float f32x4 __attribute__((ext_vector_type(4)));
typedef float f32x16 __attribute__((ext_vector_type(16)));
typedef short bf16x8 __attribute__((ext_vector_type(8)));
using pg8::cvt_pk_bf16; using pg8::bf_lo; using pg8::bf_hi; using pg8::sigm;

struct Args { const float* in[24]; float* out; unsigned char* ws; int lo, hi; };
enum { I_X = 0, I_C, I_CTX, I_CCTX, I_WADA, I_BADA, I_N1G, I_N2G, I_WIN, I_CONVW, I_CONVB, I_WR, I_BR, I_WI, I_BI, I_LAM, I_WLO, I_POOLW, I_POOLS, I_WPO, I_WO, I_W1, I_W2, I_FG };

__device__ __forceinline__ float wave_sum(float v) {
#pragma unroll
    for (int o = 1; o < 64; o <<= 1) v += __shfl_xor(v, o);
    return v;
}
__device__ __forceinline__ float gelu_tanh(float x) { const float z = 0.7978845608f * (x + 0.044715f * x * x * x); const float e = __expf(2.f * z); return 0.5f * x * (2.f - 2.f * __builtin_amdgcn_rcpf(e + 1.f)); }

__device__ __forceinline__ void mod_item(const Args& a, LAS unsigned char* lds, int item) {
    const int tid = opaque_tid(), l = item / 96, cb = item % 96, cq = tid & 15, kg = tid >> 4;
    LAS float* s = (LAS float*)lds;
    LAS float* part = (LAS float*)(lds + 20480);
    const float* c = a.in[I_C]; const float* cc = a.in[I_CCTX];
    for (int i = tid; i < 5120; i += 512) { const int r = i >> 10, k = i & 1023; const float v = r < 4 ? c[r * 1024 + k] : cc[k]; s[i] = v * sigm(v); }
    __syncthreads();
    const float* W = a.in[I_WADA] + (size_t)l * D * MODW + cb * 64 + cq * 4;
    float acc[5][4];
#pragma unroll
    for (int r = 0; r < 5; ++r)
#pragma unroll
        for (int j = 0; j < 4; ++j) acc[r][j] = 0.f;
#pragma unroll 8
    for (int kk = 0; kk < 32; ++kk) { const int k = kg * 32 + kk; const f32x4 w = *(const f32x4*)(W + (size_t)k * MODW);
#pragma unroll
        for (int r = 0; r < 5; ++r) { const float sv = s[r * 1024 + k];
#pragma unroll
            for (int j = 0; j < 4; ++j) acc[r][j] += sv * w[j]; } }
#pragma unroll
    for (int r = 0; r < 5; ++r)
#pragma unroll
        for (int j = 0; j < 4; ++j) part[(kg * 5 + r) * 64 + cq * 4 + j] = acc[r][j];
    __syncthreads();
    if (tid < 320) { const int r = tid >> 6, col = tid & 63; float t = 0.f;
#pragma unroll 8
        for (int g = 0; g < 32; ++g) t += part[(g * 5 + r) * 64 + col];
        ((float*)(a.ws + WS_MOD))[(size_t)(l * 5 + r) * MODW + cb * 64 + col] = t + a.in[I_BADA][l * MODW + cb * 64 + col]; }
    __syncthreads();
}
__device__ __forceinline__ void transpose_item(const float* W, int K, int N, bf16* WT, LAS float* scr, int item, int lane) {
    const int nblk = N / 32, kb = item / nblk, nb = item % nblk, k0 = 64 * kb, n0 = 32 * nb;
#pragma unroll 8
    for (int i = 0; i < 32; ++i) { const int kk = 2 * i + (lane >> 5); scr[kk * 33 + (lane & 31)] = W[(size_t)(k0 + kk) * N + n0 + (lane & 31)]; }
    asm volatile("s_waitcnt lgkmcnt(0)" ::: "memory");
    const int c = lane & 7;
#pragma unroll
    for (int j = 0; j < 4; ++j) { const int n = (lane >> 3) + 8 * j; const LAS float* s = scr + (8 * c) * 33 + n;
        u32x4 o; o.x = cvt_pk_bf16(s[0 * 33], s[1 * 33]); o.y = cvt_pk_bf16(s[2 * 33], s[3 * 33]); o.z = cvt_pk_bf16(s[4 * 33], s[5 * 33]); o.w = cvt_pk_bf16(s[6 * 33], s[7 * 33]);
        *(u32x4*)(WT + (size_t)(n0 + n) * K + k0 + 8 * c) = o; }
    asm volatile("s_waitcnt lgkmcnt(0)" ::: "memory");
}
__device__ __forceinline__ void convert_big(const Args& a, LAS unsigned char* lds, int l, int gw, int NGW, int wave, int lane) {
    LAS float* scr = (LAS float*)(lds + wave * 16384);
    constexpr int I_IN = (D / 64) * (D_IN / 32), I_LO = (D / 64) * (D / 32), I_PO = (D_POOL / 64) * (D / 32), I_O = I_LO, I_1 = (D / 64) * (D_FF / 32), I_2 = (D_FF / 64) * (D / 32);
    constexpr int NIT = I_IN + I_LO + I_PO + I_O + I_1 + I_2;
    unsigned char* ws = a.ws;
    for (int it = gw; it < NIT; it += NGW) { int r = it;
        if (r < I_IN) { transpose_item(a.in[I_WIN] + (size_t)l * D * D_IN, D, D_IN, (bf16*)(ws + WS_WIN), scr, r, lane); continue; } r -= I_IN;
        if (r < I_LO) { transpose_item(a.in[I_WLO] + (size_t)l * D * D, D, D, (bf16*)(ws + WS_WLO), scr, r, lane); continue; } r -= I_LO;
        if (r < I_PO) { transpose_item(a.in[I_WPO] + (size_t)l * D_POOL * D, D_POOL, D, (bf16*)(ws + WS_WPO), scr, r, lane); continue; } r -= I_PO;
        if (r < I_O) { transpose_item(a.in[I_WO] + (size_t)l * D * D, D, D, (bf16*)(ws + WS_WO), scr, r, lane); continue; } r -= I_O;
        if (r < I_1) { transpose_item(a.in[I_W1] + (size_t)l * D * D_FF, D, D_FF, (bf16*)(ws + WS_W1), scr, r, lane); continue; } r -= I_1;
        transpose_item(a.in[I_W2] + (size_t)l * D_FF * D, D_FF, D, (bf16*)(ws + WS_W2), scr, r, lane); }
}
__device__ __forceinline__ void convert_small(const Args& a, LAS unsigned char* lds, int gw, int NGW, int wave, int lane) {
    LAS float* scr = (LAS float*)(lds + wave * 16384);
    for (int it = gw; it < 256 + 64; it += NGW) {
        if (it < 256) { const int mi = it >> 1, sub = it & 1, h = mi & 15, ri = (mi >> 4) & 1, ld = mi >> 5;
            const float* src = a.in[ri ? I_WI : I_WR] + ((size_t)ld * 16 + h) * 4096;
            transpose_item(src, 64, 64, (bf16*)(a.ws + WS_GW) + ((size_t)(ld * 2 + ri) * 16 + h) * 4096, scr, sub, lane); }
        else { const int r = it - 256, mi = r >> 3, sub = r & 7;
            transpose_item(a.in[I_POOLW] + (size_t)mi * 16384, 128, 128, (bf16*)(a.ws + WS_PW) + (size_t)mi * 16384, scr, sub, lane); }
    }
}
__device__ __forceinline__ void norm_rows(const float* xl, const float* xc, bf16* H, const float* gvec, const float* mod  , int shift_i, int scale_i, int nrows, int gw, int NGW, int lane,
                                          const float* slab = nullptr, const float* sgate = nullptr, float* xcw = nullptr) {
    for (int m = gw; m < nrows; m += NGW) {
        const float* xr = m < ML ? xl + (size_t)m * D : xc + (size_t)(m - ML) * D; const int r = m < ML ? (m >> 12) : 4;
        const f32x4* x4 = (const f32x4*)xr + lane; f32x4 v[4]; float ss = 0.f;
#pragma unroll
        for (int j = 0; j < 4; ++j) v[j] = x4[64 * j];
        if (slab != nullptr && m >= ML) {
            const f32x4* s4 = (const f32x4*)(slab + (size_t)(m - ML) * D) + lane; const f32x4* g4s = (const f32x4*)sgate + lane;
#pragma unroll
            for (int j = 0; j < 4; ++j) { const f32x4 t = (s4[64 * j] + s4[64 * j + 262144]) + (s4[64 * j + 2 * 262144] + s4[64 * j + 3 * 262144]); v[j] = v[j] + g4s[64 * j] * t; }
            if (xcw != nullptr) { f32x4* w4 = (f32x4*)(xcw + (size_t)(m - ML) * D) + lane;
#pragma unroll
                for (int j = 0; j < 4; ++j) w4[64 * j] = v[j]; } }
#pragma unroll
        for (int j = 0; j < 4; ++j) ss += (v[j].x * v[j].x + v[j].y * v[j].y) + (v[j].z * v[j].z + v[j].w * v[j].w);
        const float rstd = 1.0f / sqrtf(wave_sum(ss) * (1.f / D) + EPS);
        const f32x4* g4 = (const f32x4*)gvec + lane; const f32x4* sc4 = (const f32x4*)(mod + (size_t)r * MODW + scale_i * D) + lane; const f32x4* sh4 = (const f32x4*)(mod + (size_t)r * MODW + shift_i * D) + lane;
        u32x2* o = (u32x2*)(H + (size_t)m * D) + lane;
#pragma unroll
        for (int j = 0; j < 4; ++j) { const f32x4 h = v[j] * rstd * g4[64 * j] * (1.0f + sc4[64 * j]) + sh4[64 * j]; u32x2 w; w.x = cvt_pk_bf16(h.x, h.y); w.y = cvt_pk_bf16(h.z, h.w); o[64 * j] = w; }
    }
}
__device__ __forceinline__ void final_rows(float* x, const float* gvec, int gw, int NGW, int lane) {
    for (int m = gw; m < ML; m += NGW) {
        f32x4* x4 = (f32x4*)(x + (size_t)m * D) + lane; f32x4 v[4]; float ss = 0.f;
#pragma unroll
        for (int j = 0; j < 4; ++j) { v[j] = x4[64 * j]; ss += (v[j].x * v[j].x + v[j].y * v[j].y) + (v[j].z * v[j].z + v[j].w * v[j].w); }
        const float rstd = 1.0f / sqrtf(wave_sum(ss) * (1.f / D) + EPS);
        const f32x4* g4 = (const f32x4*)gvec + lane;
#pragma unroll
        for (int j = 0; j < 4; ++j) x4[64 * j] = v[j] * rstd * g4[64 * j];
    }
}
constexpr int SCW_WAVE = 19456, SCW_TILE = 17664;
constexpr int SCW_WAVE_OLD = 18432;
template <bool PASSB, int DIR>
__device__ __forceinline__ void scan_sweep(const Args& a, LAS unsigned char* wl, int l, int b, int q, int h, int seqbase, int L, int t0, int lane, unsigned (&st)[NSUB][16]) {
    const int l31 = lane & 31, lh = lane >> 5, ld = l * 2 + DIR;
    const bf16* U = (const bf16*)(a.ws + WS_U) + (size_t)seqbase * D + h * 64 + lh * 8;
    const LAS float* cwl = (const LAS float*)(wl + 16384);
    { const bf16* g0 = (const bf16*)(a.ws + WS_GW) + (size_t)((ld * 2 + 0) * 16 + h) * 4096; const bf16* g1 = (const bf16*)(a.ws + WS_GW) + (size_t)((ld * 2 + 1) * 16 + h) * 4096;
      u32x4 v0[8], v1[8];
#pragma unroll
      for (int p = 0; p < 8; ++p) { v0[p] = *(const u32x4*)(g0 + (p * 64 + lane) * 8); v1[p] = *(const u32x4*)(g1 + (p * 64 + lane) * 8); }
#pragma unroll
      for (int p = 0; p < 8; ++p) { const int piece = p * 64 + lane, row = piece >> 3, c = piece & 7, off = row * 128 + ((c ^ (row & 7)) * 16);
          *(LAS u32x4*)(wl + off) = v0[p]; *(LAS u32x4*)(wl + 8192 + off) = v1[p]; } }
    float brr[2], bii[2], sp[2], s[2], AT[2];
#pragma unroll
    for (int nb = 0; nb < 2; ++nb) { const int ch = h * 64 + nb * 32 + l31;
        brr[nb] = -1.44269504f * a.in[I_BR][ld * D + ch]; bii[nb] = -1.44269504f * a.in[I_BI][ld * D + ch];
        const float lam = a.in[I_LAM][ld * D + ch]; sp[nb] = (-8.0f * 1.44269504f) * (fmaxf(-lam, 0.f) + log1pf(__expf(-fabsf(lam))));
        AT[nb] = 1.f; s[nb] = PASSB ? ((const float*)(a.ws + WS_CARRY))[(size_t)((b * 2 + DIR) * NQ + q) * 1024 + ch] : 0.f; }
    asm volatile("s_waitcnt lgkmcnt(0)" ::: "memory"); __builtin_amdgcn_wave_barrier();
    u32x4 ur[4][4];
#define LOADU(tokv) do { _Pragma("unroll") for (int j_ = 0; j_ < 4; ++j_) { const int tc_ = min(max((tokv) - 2 + j_, 0), L - 1); \
        _Pragma("unroll") for (int ks_ = 0; ks_ < 4; ++ks_) ur[ks_][j_] = *(const u32x4*)(U + (size_t)tc_ * D + ks_ * 16); } } while (0)
#ifndef SCAN_PREFETCH
#define SCAN_PREFETCH 0
#endif
    if (SCAN_PREFETCH) LOADU(t0 + (DIR ? (NSUB - 1) * 32 : 0) + l31);
#pragma unroll 1
    for (int k = 0; k < NSUB; ++k) {
        const int tsub = t0 + (DIR ? NSUB - 1 - k : k) * 32, tok = tsub + l31;
        bf16x8 af[4];
        if (!SCAN_PREFETCH) { LOADU(tok); __builtin_amdgcn_sched_barrier(0); }
#pragma unroll
        for (int ks = 0; ks < 4; ++ks) { const int c0 = ks * 16 + lh * 8;
            f32x4 u0 = *(const LAS f32x4*)(cwl + 256 + c0), u1 = *(const LAS f32x4*)(cwl + 256 + c0 + 4);
#pragma unroll
            for (int j = 0; j < 4; ++j) { const int tt = tok - 2 + j; const bool ok = (tt >= 0 && tt < L); u32x4 uv = ur[ks][j];
                uv.x = ok ? uv.x : 0u; uv.y = ok ? uv.y : 0u; uv.z = ok ? uv.z : 0u; uv.w = ok ? uv.w : 0u;
                const f32x4 w0 = *(const LAS f32x4*)(cwl + j * 64 + c0), w1 = *(const LAS f32x4*)(cwl + j * 64 + c0 + 4);
                u0.x = fmaf(w0.x, bf_lo(uv.x), u0.x); u0.y = fmaf(w0.y, bf_hi(uv.x), u0.y); u0.z = fmaf(w0.z, bf_lo(uv.y), u0.z); u0.w = fmaf(w0.w, bf_hi(uv.y), u0.w);
                u1.x = fmaf(w1.x, bf_lo(uv.z), u1.x); u1.y = fmaf(w1.y, bf_hi(uv.z), u1.y); u1.z = fmaf(w1.z, bf_lo(uv.w), u1.z); u1.w = fmaf(w1.w, bf_hi(uv.w), u1.w); }
            u32x4 o; o.x = cvt_pk_bf16(u0.x, u0.y); o.y = cvt_pk_bf16(u0.z, u0.w); o.z = cvt_pk_bf16(u1.x, u1.y); o.w = cvt_pk_bf16(u1.z, u1.w);
            af[ks] = __builtin_bit_cast(bf16x8, o); }
        __builtin_amdgcn_sched_barrier(0);
        if (SCAN_PREFETCH) { const int kn = k < NSUB - 1 ? k + 1 : k; LOADU(t0 + (DIR ? NSUB - 1 - kn : kn) * 32 + l31); }
        __builtin_amdgcn_sched_barrier(0);
        unsigned cur[16];
        if (PASSB && DIR == 1) {
#pragma unroll
            for (int i = 0; i < 16; ++i) { cur[i] = st[0][i];
#pragma unroll
                for (int d = 0; d + 1 < NSUB; ++d) st[d][i] = st[d + 1][i]; } }
        float gall[2][16]; unsigned outp[2][8];
        LAS unsigned char* tile = wl + SCW_TILE; const int r8 = lane >> 3, c8 = lane & 7;
        if (PASSB && DIR == 1) {
            const bf16* Grow = (const bf16*)(a.ws + WS_G) + (size_t)(seqbase + tsub + r8) * D + h * 64 + c8 * 8;
            u32x4 gq[4];
#pragma unroll
            for (int gi = 0; gi < 4; ++gi) gq[gi] = *(const u32x4*)(Grow + (size_t)(8 * gi) * D);
#pragma unroll
            for (int gi = 0; gi < 4; ++gi) { *(LAS u32x4*)(tile + r8 * 128 + c8 * 16) = gq[gi];
#pragma unroll
                for (int nb2 = 0; nb2 < 2; ++nb2)
#pragma unroll
                    for (int j = 0; j < 4; ++j) gall[nb2][4 * gi + j] = __uint_as_float((unsigned)(*(const LAS unsigned short*)(tile + (4 * lh + j) * 128 + (nb2 * 32 + l31) * 2)) << 16); } }
#pragma unroll
        for (int nb = 0; nb < 2; ++nb) {
            __builtin_amdgcn_sched_barrier(0);
            const size_t cbase = (size_t)(seqbase + tsub + 4 * lh) * D + h * 64 + nb * 32 + l31;
            bf16* HL = (bf16*)(a.ws + WS_H) + cbase; const bf16* Gp = (const bf16*)(a.ws + WS_G) + cbase;
            float hfv[16], gv[16];
            if (PASSB && DIR == 1) {
#pragma unroll
                for (int reg = 0; reg < 16; ++reg) { gv[reg] = gall[nb][reg];
                    hfv[reg] = (reg & 1) ? bf_hi(cur[nb * 8 + (reg >> 1)]) : bf_lo(cur[nb * 8 + (reg >> 1)]); } }
            f32x16 ar, ai, au;
#pragma unroll
            for (int i = 0; i < 16; ++i) { ar[i] = 0.f; ai[i] = 0.f; au[i] = 0.f; }
            const int row = nb * 32 + l31;
#pragma unroll
            for (int ks = 0; ks < 4; ++ks) {
                const int idx = row - (ks * 16 + lh * 8);
                const unsigned one = (idx >= 0 && idx < 8) ? (0x3F80u << ((idx & 1) * 16)) : 0u; const int dw = idx >> 1;
                u32x4 idv; idv.x = dw == 0 ? one : 0u; idv.y = dw == 1 ? one : 0u; idv.z = dw == 2 ? one : 0u; idv.w = dw == 3 ? one : 0u;
                const int woff = row * 128 + (((ks * 2 + lh) ^ (row & 7)) * 16);
                const bf16x8 wr = *(const LAS bf16x8*)(wl + woff), wi = *(const LAS bf16x8*)(wl + 8192 + woff);
                ar = __builtin_amdgcn_mfma_f32_32x32x16_bf16(af[ks], wr, ar, 0, 0, 0);
                ai = __builtin_amdgcn_mfma_f32_32x32x16_bf16(af[ks], wi, ai, 0, 0, 0);
                if ((ks >> 1) == nb) au = __builtin_amdgcn_mfma_f32_32x32x16_bf16(af[ks], __builtin_bit_cast(bf16x8, idv), au, 0, 0, 0); }
#pragma unroll
            for (int reg = 0; reg < 16; ++reg) {
                const float r = __builtin_amdgcn_rcpf(1.0f + __builtin_amdgcn_exp2f(fmaf(ar[reg], -1.44269504f, brr[nb])));
                const float ig = __builtin_amdgcn_rcpf(1.0f + __builtin_amdgcn_exp2f(fmaf(ai[reg], -1.44269504f, bii[nb])));
                const float av = __builtin_amdgcn_exp2f(r * sp[nb]), mult = __builtin_amdgcn_sqrtf(fmaf(-av, av, 1.0f));
                ar[reg] = av; ai[reg] = (mult * ig) * au[reg]; }
            float gA[4], gB[4], pA[4], pB[4], sIn[4];
#pragma unroll
            for (int gi = 0; gi < 4; ++gi) { const int j0 = DIR ? 3 : 0; float A = ar[4 * gi + j0], B = ai[4 * gi + j0];
#pragma unroll
                for (int jj = 1; jj < 4; ++jj) { const int j = DIR ? 3 - jj : jj; B = ar[4 * gi + j] * B + ai[4 * gi + j]; A *= ar[4 * gi + j]; }
                gA[gi] = A; gB[gi] = B; }
#pragma unroll
            for (int gi = 0; gi < 4; ++gi) { pA[gi] = __shfl_xor(gA[gi], 32); pB[gi] = __shfl_xor(gB[gi], 32); sIn[gi] = 0.f; }
            float st = s[nb];
#pragma unroll
            for (int g = 0; g < 8; ++g) { const int gg = DIR ? 7 - g : g, gi = gg >> 1; const bool own = (lh == (gg & 1));
                const float Ag = own ? gA[gi] : pA[gi], Bg = own ? gB[gi] : pB[gi];
                sIn[gi] = own ? st : sIn[gi]; st = Ag * st + Bg; if (!PASSB) AT[nb] *= Ag; }
            s[nb] = st;
            if (PASSB) {
#pragma unroll
                for (int gi = 0; gi < 4; ++gi) { float hc = sIn[gi];
#pragma unroll
                    for (int jj = 0; jj < 4; ++jj) { const int j = DIR ? 3 - jj : jj, reg = 4 * gi + j; hc = ar[reg] * hc + ai[reg];
                        const size_t o = (size_t)(8 * gi + j) * D;
                        if (DIR == 0) ar[reg] = hc;
                        else ar[reg] = (hfv[reg] + hc) * gelu_tanh(gv[reg]); } }
#pragma unroll
                for (int p = 0; p < 8; ++p) { const unsigned pk = cvt_pk_bf16(ar[2 * p], ar[2 * p + 1]); if (DIR == 0) cur[nb * 8 + p] = pk; else outp[nb][p] = pk; }
            }
        }
        if (PASSB && DIR == 0) {
#pragma unroll
            for (int i = 0; i < 16; ++i) {
#pragma unroll
                for (int d = NSUB - 1; d > 0; --d) st[d][i] = st[d - 1][i];
                st[0][i] = cur[i]; } }
        if (PASSB && DIR == 1) {
            bf16* HLrow = (bf16*)(a.ws + WS_H) + (size_t)(seqbase + tsub + r8) * D + h * 64 + c8 * 8;
#pragma unroll
            for (int gi = 0; gi < 4; ++gi) {
#pragma unroll
                for (int nb2 = 0; nb2 < 2; ++nb2)
#pragma unroll
                    for (int j = 0; j < 4; ++j) { const unsigned pk = outp[nb2][2 * gi + (j >> 1)];
                        *(LAS unsigned short*)(tile + (4 * lh + j) * 128 + (nb2 * 32 + l31) * 2) = (unsigned short)((j & 1) ? (pk >> 16) : (pk & 0xffffu)); }
                const u32x4 row = *(const LAS u32x4*)(tile + r8 * 128 + c8 * 16);
                *(u32x4*)(HLrow + (size_t)(8 * gi) * D) = row; } }
    }
#undef LOADU
    if (!PASSB) {
#pragma unroll
        for (int nb = 0; nb < 2; ++nb) { float* sm = (float*)(a.ws + WS_SUMM) + ((size_t)((b * 2 + DIR) * NQ + q) * 2) * 1024 + h * 64 + nb * 32 + l31;
            if (lh == 0) { sm[0] = AT[nb]; sm[1024] = s[nb]; } }
    }
    asm volatile("s_waitcnt lgkmcnt(0)" ::: "memory"); __builtin_amdgcn_wave_barrier();
}
template <bool PASSB>
__device__ __forceinline__ void scan_task(const Args& a, LAS unsigned char* lds, int l, int item, int wave, int lane) {
    int b, chunk, h, seqbase, L, q;
    if (item < NLAT) { b = item / (NCL * 16); const int rem = item % (NCL * 16); chunk = rem >> 4; h = rem & 15; seqbase = b * SEQ; L = SEQ; q = NCC + chunk; }
    else { const int it = item - NLAT; b = it / (NCC * 16); const int rem = it % (NCC * 16); chunk = rem >> 4; h = rem & 15; seqbase = ML + b * CTX; L = CTX; q = chunk; }
    LAS unsigned char* wl = lds + wave * SCW_WAVE; LAS float* cwl = (LAS float*)(wl + 16384);
    { const float* cw = a.in[I_CONVW] + (size_t)l * 4 * D + h * 64;
#pragma unroll
      for (int j = 0; j < 4; ++j) cwl[j * 64 + lane] = cw[j * D + lane];
      cwl[256 + lane] = a.in[I_CONVB][l * D + h * 64 + lane]; }
    unsigned st[NSUB][16];
#pragma unroll
    for (int d = 0; d < NSUB; ++d)
#pragma unroll
        for (int i = 0; i < 16; ++i) st[d][i] = 0u;
    scan_sweep<PASSB, 0>(a, wl, l, b, q, h, seqbase, L, chunk * TCH, lane, st);
    scan_sweep<PASSB, 1>(a, wl, l, b, q, h, seqbase, L, chunk * TCH, lane, st);
}
__device__ __forceinline__ void carry_phase(const Args& a) {
    const float* sm = (const float*)(a.ws + WS_SUMM); float* cr = (float*)(a.ws + WS_CARRY);
    const int tid = opaque_tid();
    for (int idx = blockIdx.x * 64 + tid; tid < 64 && idx < NB * 2 * 1024; idx += gridDim.x * 64) {
        const int chn = idx & 1023, bd = idx >> 10, dir = bd & 1;
        const float* s0 = sm + (size_t)bd * NQ * 2048 + chn; float* c0 = cr + (size_t)bd * NQ * 1024 + chn;
        float hs = 0.f;
#pragma unroll 2
        for (int k = 0; k < NQ; ++k) { int q;
            if (dir == 0) q = k; else q = (k < NCC) ? NCC - 1 - k : (NQ - 1 - (k - NCC));
            c0[(size_t)q * 1024] = hs; hs = s0[(size_t)q * 2048] * hs + s0[(size_t)q * 2048 + 1024]; }
    }
}
constexpr int PL_PF = 0  , PL_MB = 40960  , PL_MROW = 272;
__device__ __forceinline__ void pool_item(const Args& a, LAS unsigned char* lds, int l, int item) {
    const int tid = opaque_tid(), lane = tid & 63, wave = __builtin_amdgcn_readfirstlane(tid >> 6);
    int g, R0, L, t0;
    if (item < 1024) { g = item & 3; R0 = (item >> 2) * 64; L = 64; t0 = 0; }
    else { const int it = item - 1024; g = it & 3; const int blk = (it >> 2) & 3, b = it >> 4; R0 = ML + b * CTX; L = CTX; t0 = blk * 64; }
    const bf16* P = (const bf16*)(a.ws + WS_P); LAS float* pf = (LAS float*)(lds + PL_PF);
    for (int idx = tid; idx < 1280; idx += 512) { const int row = idx >> 4, c8 = (idx & 15) * 8, tt = t0 - 8 + row;
        if (tt >= 0 && tt < L) { const u32x4 v = *(const u32x4*)(P + (size_t)(R0 + tt) * D_POOL + g * 128 + c8);
            *(LAS f32x4*)(pf + row * 128 + c8) = (f32x4){bf_lo(v.x), bf_hi(v.x), bf_lo(v.y), bf_hi(v.y)}; *(LAS f32x4*)(pf + row * 128 + c8 + 4) = (f32x4){bf_lo(v.z), bf_hi(v.z), bf_lo(v.w), bf_hi(v.w)}; } }
    __syncthreads();
    { const int c = tid & 127, tq = tid >> 7, hw = 1 << g;
      for (int k = 0; k < 16; ++k) { const int t = tq * 16 + k, tt = t0 + t; const int lo = max(tt - hw, 0), hi = min(tt + hw, L); float s = 0.f;
#pragma unroll
          for (int u = 0; u < 16; ++u) { const int uu = min(lo + u, hi - 1); const float v = pf[(uu - t0 + 8) * 128 + c]; s += (lo + u < hi) ? v : 0.f; }
          const float mval = s / (float)(hi - lo) - pf[(t + 8) * 128 + c];
          *(LAS unsigned short*)(lds + PL_MB + t * PL_MROW + c * 2) = (unsigned short)(cvt_pk_bf16(mval, 0.f) & 0xffffu); } }
    __syncthreads();
    { const int mblk = wave & 1, nblk = wave >> 1, l31 = lane & 31, lh = lane >> 5, e = nblk * 32 + l31;
      const bf16* pw = (const bf16*)(a.ws + WS_PW) + ((size_t)(l * 4 + g) * 128 + e) * 128 + lh * 8;
      f32x16 acc;
#pragma unroll
      for (int i = 0; i < 16; ++i) acc[i] = 0.f;
#pragma unroll
      for (int ks = 0; ks < 8; ++ks) { const bf16x8 af = *(const LAS bf16x8*)(lds + PL_MB + (mblk * 32 + l31) * PL_MROW + (ks * 16 + lh * 8) * 2); const bf16x8 bw = *(const bf16x8*)(pw + ks * 16);
          acc = __builtin_amdgcn_mfma_f32_32x32x16_bf16(af, bw, acc, 0, 0, 0); }
      const float scl = a.in[I_POOLS][l * D_POOL + g * 128 + e];
      LAS unsigned short* ot = (LAS unsigned short*)(lds + PL_PF);
#pragma unroll
      for (int reg = 0; reg < 16; ++reg) { const int t = mblk * 32 + (reg & 3) + 8 * (reg >> 2) + 4 * lh; ot[t * 128 + e] = (unsigned short)cvt_pk_bf16(acc[reg] * scl, 0.f); } }
    __syncthreads();
    { bf16* PM = (bf16*)(a.ws + WS_PM) + (size_t)(R0 + t0) * D_POOL + g * 128;
#pragma unroll
      for (int i = 0; i < 2; ++i) { const int idx = tid + 512 * i, row = idx >> 4, c16 = idx & 15;
          *(u32x4*)(PM + (size_t)row * D_POOL + c16 * 8) = *(const LAS u32x4*)(lds + PL_PF + row * 256 + c16 * 16); } }
    __syncthreads();
}
#define XB_TMO      128
#define XB_XCNT(j)  (256  + 64 * (j))
#define XB_XSUB(j)  (1280 + 64 * (j))
#define XB_XGEN(j)  (2304 + 64 * (j))
#define XB_TOP      3328
#define XB_TOPGEN   3392
#define XCD_BAR_WORDS 3456
#define XB_SPIN_CAP (1u << 18)

__device__ __forceinline__ unsigned xb_ld(unsigned* p)              { return __hip_atomic_load(p, __ATOMIC_RELAXED, __HIP_MEMORY_SCOPE_AGENT); }
__device__ __forceinline__ unsigned xb_add(unsigned* p, unsigned v) { return __hip_atomic_fetch_add(p, v, __ATOMIC_RELAXED, __HIP_MEMORY_SCOPE_AGENT); }
__device__ __forceinline__ unsigned xb_xcc_id() { return (unsigned)__builtin_amdgcn_s_getreg((3 << 11) | 20) & 0xFu; }
#define XB_SPIN(cond, bar) do { unsigned _sp = 0; while (cond) { __builtin_amdgcn_s_sleep(1); \
    if ((++_sp & 255u) == 0u) { if (xb_ld(&(bar)[XB_TMO])) break; if (_sp > XB_SPIN_CAP) { atomicAdd(&(bar)[XB_TMO], 1u); break; } } } } while (0)

struct XcdBarrier {
    unsigned* bar; unsigned x;
    volatile LAS unsigned* st;
};

__device__ __forceinline__ XcdBarrier xcd_barrier_post(unsigned* bar, volatile LAS unsigned* st) {
    XcdBarrier b; b.bar = bar; b.x = xb_xcc_id(); b.st = st;
    if (threadIdx.x == 0) (void)xb_add(&bar[XB_XCNT(b.x)], 1u);
    return b;
}
__device__ __forceinline__ void xcd_barrier_complete(unsigned* bar, unsigned x, unsigned& nloc, unsigned& nx) {
    const unsigned G = gridDim.x * gridDim.y * gridDim.z;
    unsigned sum, cnt, mine, sp = 0u;
    for (;;) {
        sum = 0u; cnt = 0u; mine = 0u;
#pragma unroll
        for (unsigned j = 0; j < 16; ++j) { const unsigned c = xb_ld(&bar[XB_XCNT(j)]); sum += c; cnt += (c > 0u) ? 1u : 0u; mine = (j == x) ? c : mine; }
        if (sum == G) break;
        __builtin_amdgcn_s_sleep(1);
        if ((++sp & 255u) == 0u) { if (xb_ld(&bar[XB_TMO])) break; if (sp > XB_SPIN_CAP) { atomicAdd(&bar[XB_TMO], 1u); break; } }
    }
    nloc = mine > 0u ? mine : 1u; nx = cnt > 0u ? cnt : 1u;
}

__device__ __forceinline__ void xcd_barrier(const XcdBarrier& b) {
    asm volatile("s_waitcnt vmcnt(0)" ::: "memory");
    __syncthreads();
    if (threadIdx.x == 0) {
        unsigned* bar = b.bar;
        __builtin_amdgcn_s_waitcnt(0);
        unsigned nloc = b.st[0], nx = b.st[1];
        if (nloc == 0u) { xcd_barrier_complete(bar, b.x, nloc, nx); b.st[0] = nloc; b.st[1] = nx; }
        const unsigned old = xb_add(&bar[XB_XSUB(b.x)], 1u);
        const unsigned gen = old / nloc;
        if (old + 1u == (gen + 1u) * nloc) {
            __builtin_amdgcn_fence(__ATOMIC_RELEASE, "agent");
            asm volatile("s_waitcnt vmcnt(0)" ::: "memory");
            const unsigned og = xb_add(&bar[XB_TOP], 1u);
            const unsigned tg = og / nx;
            if (og + 1u == (tg + 1u) * nx) xb_add(&bar[XB_TOPGEN], 1u);
            else XB_SPIN(xb_ld(&bar[XB_TOPGEN]) == tg, bar);
            __builtin_amdgcn_fence(__ATOMIC_ACQUIRE, "agent");
            xb_add(&bar[XB_XGEN(b.x)], 1u);
            asm volatile("s_waitcnt vmcnt(0)" ::: "memory");
        } else {
            XB_SPIN(xb_ld(&bar[XB_XGEN(b.x)]) == gen, bar);
            __builtin_amdgcn_fence(__ATOMIC_ACQUIRE, "agent");
            asm volatile("s_waitcnt vmcnt(0)" ::: "memory");
        }
    }
    __syncthreads();
}

constexpr int NPHASE = 22;
__global__ void __launch_bounds__(512, 2) mk_fwd(Args a) {
    extern __shared__ __attribute__((aligned(16))) unsigned char lds_raw[];
    LAS unsigned char* lds = (LAS unsigned char*)lds_raw;
    cg::grid_group grid = cg::this_grid();
    volatile LAS unsigned* MISC = (volatile LAS unsigned*)(lds + MISC_OFF);
    if (threadIdx.x < 64) MISC[threadIdx.x] = 0u;
    __syncthreads();
    XcdBarrier xbar; xbar.bar = (unsigned*)(a.ws + WS_BAR); xbar.x = 0; xbar.st = MISC + 8;
    if (a.hi - a.lo > 1) xbar = xcd_barrier_post((unsigned*)(a.ws + WS_BAR), MISC + 8);
    const int G = gridDim.x, bx = blockIdx.x, NGW = G * 8;
#define WL() const int tid_ = opaque_tid(), lane = tid_ & 63, wave = __builtin_amdgcn_readfirstlane(tid_ >> 6), gw = bx * 8 + wave
    const int lo = a.lo, hi = a.hi;
    unsigned char* ws = a.ws;
    float* MOD = (float*)(ws + WS_MOD); float* XC = (float*)(ws + WS_XC);
    bf16* Hb = (bf16*)(ws + WS_H); bf16* Ub = (bf16*)(ws + WS_U); bf16* Gb = (bf16*)(ws + WS_G); bf16* Pb = (bf16*)(ws + WS_P); bf16* GTb = (bf16*)(ws + WS_GT); bf16* PMb = (bf16*)(ws + WS_PM); bf16* Fb = (bf16*)(ws + WS_F);
#ifndef PH_MASK
#define PH_MASK 0xfff
#endif
#define IN(k) (lo <= (k) && (k) < hi)
#define ON(b) ((PH_MASK >> (b)) & 1)
#ifndef REP_MASK
#define REP_MASK 0
#endif
#define REPS(b) for (int rep_ = 0; rep_ < 1 + ((REP_MASK >> (b)) & 1); ++rep_)
#ifndef SYNC_REP
#define SYNC_REP 1
#endif
#define SEAM(k) do { if (IN(k) && IN((k) + 1)) for (int sr_ = 0; sr_ < SYNC_REP; ++sr_) { if (a.hi < 0) grid.sync(); xcd_barrier(xbar); } } while (0)
    if (ON(0) && IN(0)) REPS(0) {
        for (int it = bx; it < 192; it += G) mod_item(a, lds, it);
        WL();
        convert_small(a, lds, gw, NGW, wave, lane);
        convert_big(a, lds, 0, gw, NGW, wave, lane);
    }
    SEAM(0);
#pragma unroll 1
    for (int l = 0; l < DEPTH; ++l) {
        const int pb = 1 + 10 * l; const bool last = (l == DEPTH - 1);
        const float* modl = MOD + (size_t)l * 5 * MODW;
        const float* xsrcL = l == 0 ? a.in[I_X] : a.out; const float* xsrcC = l == 0 ? a.in[I_CTX] : XC;
        const int Mrest = last ? ML : MT;
        if (ON(1) && IN(pb + 0)) REPS(1) {
            WL();
            if (l > 0) convert_big(a, lds, l, gw, NGW, wave, lane);
            norm_rows(xsrcL, xsrcC, Hb, a.in[I_N1G] + l * D, modl, 0, 1, MT, gw, NGW, lane, l > 0 ? (const float*)(ws + WS_SLAB5) : nullptr, MOD + 4 * MODW + 5 * D  , nullptr);
        }
        SEAM(pb + 0);
        if (ON(2) && IN(pb + 1)) REPS(2) {
            pg8::Gemm g{Hb, (const bf16*)(ws + WS_WIN), MT, D_IN, D, D}; pg8::StaticOrder S; S.init(MT, D_IN, G, bx);
            pg8::EpiSplit E{Ub, Gb, Pb, GTb};
            pg8::gemm_phase<pg8::EpiSplit, pg8::StaticOrder, true, true>(lds, g, S, E);
        }
        SEAM(pb + 1);
        if (ON(3) && IN(pb + 2)) REPS(3) {
            const int npool = last ? 1024 : 1088;
            { WL(); const int nit = NLAT + NCTX, nfull = (nit / NGW) * NGW;
              for (int r = 0;; ++r) { const int it = (r * NGW < nfull) ? r * NGW + gw : nfull + wave * G + bx; if (r * NGW > nfull || it >= nit) break;
                  scan_task<false>(a, lds, l, it, wave, lane); } }
            __syncthreads();
            for (int it = bx; it < npool; it += G) pool_item(a, lds, l, it);
        }
        SEAM(pb + 2);
        if (ON(4) && IN(pb + 3)) REPS(4) carry_phase(a);
        SEAM(pb + 3);
        if (ON(5) && IN(pb + 4)) REPS(5) { WL(); const int nit = last ? NLAT : NLAT + NCTX, nfull = (nit / NGW) * NGW;
            for (int r = 0;; ++r) { const int it = (r * NGW < nfull) ? r * NGW + gw : nfull + wave * G + bx; if (r * NGW > nfull || it >= nit) break;
                scan_task<true>(a, lds, l, it, wave, lane); } }
        SEAM(pb + 4);
        if (ON(6) && IN(pb + 5)) REPS(6) {
            { pg8::Gemm g{PMb, (const bf16*)(ws + WS_WPO), Mrest, D, D_POOL, D_POOL}; pg8::StaticOrder S; S.init(Mrest, D, G, bx);
              pg8::EpiGate<0> E{Ub, GTb}; pg8::gemm_phase<pg8::EpiGate<0>, pg8::StaticOrder, true, true>(lds, g, S, E); }
            { pg8::Gemm g{Hb, (const bf16*)(ws + WS_WLO), Mrest, D, D, D}; pg8::StaticOrder S; S.init(Mrest, D, G, bx);
              pg8::EpiGate<1> E{Ub, GTb}; pg8::gemm_phase<pg8::EpiGate<1>, pg8::StaticOrder, true, true>(lds, g, S, E); }
        }
        SEAM(pb + 5);
        if (ON(7) && IN(pb + 6)) {
            { pg8::Gemm g{Ub, (const bf16*)(ws + WS_WO), ML, D, D, D}; pg8::StaticOrder S; S.init(ML, D, G, bx);
              pg8::EpiRes E{xsrcL, xsrcC, a.out, XC, modl + 2 * D};
              pg8::gemm_phase<pg8::EpiRes, pg8::StaticOrder, true, true>(lds, g, S, E); }
            if (!last) {
              int ksl = 256; asm volatile("" : "+s"(ksl));
              pg8::Gemm g{Ub + (size_t)ML * D, (const bf16*)(ws + WS_WO), MC, D, ksl, D}; pg8::SplitOrder S; S.init(MC, D, D, ksl, G, bx);
              pg8::EpiSlab E{(float*)(ws + WS_SLAB3)};
              pg8::gemm_phase<pg8::EpiSlab, pg8::SplitOrder, true, true>(lds, g, S, E); }
        }
        SEAM(pb + 6);
        if (ON(8) && IN(pb + 7)) REPS(8) { WL(); norm_rows(a.out, l == 0 ? a.in[I_CTX] : XC, Hb, a.in[I_N2G] + l * D, modl, 3, 4, Mrest, gw, NGW, lane, l == 0 ? (const float*)(ws + WS_SLAB3) : nullptr, modl + 4 * MODW + 2 * D  , XC); }
        SEAM(pb + 7);
        if (ON(9) && IN(pb + 8)) REPS(9) {
            pg8::Gemm g{Hb, (const bf16*)(ws + WS_W1), Mrest, D_FF, D, D}; pg8::StaticOrder S; S.init(Mrest, D_FF, G, bx);
            pg8::EpiSqRelu E{Fb, D_FF};
            pg8::gemm_phase<pg8::EpiSqRelu, pg8::StaticOrder, true, true>(lds, g, S, E);
        }
        SEAM(pb + 8);
        if (ON(10) && IN(pb + 9)) {
            { pg8::Gemm g{Fb, (const bf16*)(ws + WS_W2), ML, D, D_FF, D_FF}; pg8::StaticOrder S; S.init(ML, D, G, bx);
              pg8::EpiRes E{a.out, XC, a.out, XC, modl + 5 * D};
              pg8::gemm_phase<pg8::EpiRes, pg8::StaticOrder, true, true>(lds, g, S, E); }
            if (!last) {
              int ksl = 1024; asm volatile("" : "+s"(ksl));
              pg8::Gemm g{Fb + (size_t)ML * D_FF, (const bf16*)(ws + WS_W2), MC, D, ksl, D_FF}; pg8::SplitOrder S; S.init(MC, D, D_FF, ksl, G, bx);
              pg8::EpiSlab E{(float*)(ws + WS_SLAB5)};
              pg8::gemm_phase<pg8::EpiSlab, pg8::SplitOrder, true, true>(lds, g, S, E); }
        }
        SEAM(pb + 9);
    }
    if (ON(11) && IN(21)) { WL(); final_rows(a.out, a.in[I_FG], gw, NGW, lane); }
#undef IN
#undef SEAM
}

extern "C" void kernel_launch(void* const* d_in, const int* in_sizes, int n_in, void* d_out, int out_size, void* d_ws, size_t ws_size, hipStream_t stream) {
    static int grid = 0;
    if (grid == 0) {
        if (n_in != 24 || out_size != ML * D || ws_size < WS_END) { fprintf(stderr, "kernel_launch: unexpected shapes (n_in %d, out %d, ws %zu)\n", n_in, out_size, ws_size); grid = -1; return; }
        int dev = 0, cus = 0, per_cu = 0;
        if (hipGetDevice(&dev) != hipSuccess || hipDeviceGetAttribute(&cus, hipDeviceAttributeMultiprocessorCount, dev) != hipSuccess) { grid = -1; return; }
        if (hipFuncSetAttribute((const void*)mk_fwd, hipFuncAttributeMaxDynamicSharedMemorySize, LDS_BYTES) != hipSuccess) { fprintf(stderr, "kernel_launch: hipFuncSetAttribute failed\n"); grid = -1; return; }
        if (hipOccupancyMaxActiveBlocksPerMultiprocessor(&per_cu, (const void*)mk_fwd, 512, LDS_BYTES) != hipSuccess || per_cu < 1) { fprintf(stderr, "kernel_launch: occupancy query says %d\n", per_cu); per_cu = 1; }
        (void)hipGetLastError();
        grid = cus;
    }
    if (grid < 0) return;
    Args a{};
    for (int i = 0; i < 24; ++i) a.in[i] = (const float*)d_in[i];
    a.out = (float*)d_out; a.ws = (unsigned char*)d_ws;
#if MK_PER_PHASE
    for (int p = 0; p < NPHASE; ++p) { a.lo = p; a.hi = p + 1; hipLaunchKernelGGL(mk_fwd, dim3(grid), dim3(512), LDS_BYTES, stream, a); }
#else
    a.lo = 0; a.hi = NPHASE;
    if (hipMemsetAsync((char*)d_ws + WS_BAR, 0, 16384, stream) != hipSuccess) { fprintf(stderr, "kernel_launch: memset of the barrier words failed\n"); return; }
    void* args[] = {&a};
    hipError_t e = hipLaunchCooperativeKernel((const void*)mk_fwd, dim3(grid), dim3(512), args, LDS_BYTES, stream);
    if (e != hipSuccess) fprintf(stderr, "kernel_launch: cooperative launch failed: %s (grid %d)\n", hipGetErrorString(e), grid);
#endif
}
```

```cpp
#include <hip/hip_runtime.h>
#include <hip/hip_cooperative_groups.h>
#include <cstdio>
#include <cstdint>
namespace cg = cooperative_groups;
#ifndef MK_PER_PHASE
#define MK_PER_PHASE 0
#endif
__device__ __forceinline__ int opaque_tid() { int t = threadIdx.x; asm volatile("" : "+v"(t) : : "memory"); return t; }
namespace pg8 {
#define PG8_LAS __attribute__((address_space(3)))
typedef unsigned short bf16_t;
typedef short bf16x8 __attribute__((ext_vector_type(8)));
typedef float f32x4 __attribute__((ext_vector_type(4)));
typedef unsigned u32x4 __attribute__((ext_vector_type(4)));
constexpr int BM = 256, BK = 64, HALF = 128, HTB = HALF * BK * 2  , STAGE_BYTES = 8 * HTB, NXCD = 8, WGM = 8;

__host__ __device__ __forceinline__ int lds_byte(int r, int c) { const int st = (r >> 4) * 2 + (c >> 5), rr = r & 15, cc = c & 31, ob = rr * 64 + cc * 2; return st * 1024 + (ob ^ (((ob >> 9) & 1) << 5)); }
__host__ __device__ __forceinline__ void stage_rc(int b, int& R, int& C) { const int st = b / 1024, sb = b % 1024, swz = sb ^ (((sb >> 9) & 1) << 5); R = (st >> 1) * 16 + swz / 64; C = (st & 1) * 32 + (swz % 64) / 2; }
__host__ __device__ __forceinline__ int perm32(int rho) { const int n = rho >> 4, i = rho & 15; return 8 * (i >> 2) + 4 * n + (i & 3); }

struct Unit { int pm, pn, kb, ks; };
struct Gemm { const bf16_t* A; const bf16_t* Bt; int M, N, K, ld; };

struct StaticOrder {
    int nM, nN, nwg, G, c;
    __host__ __device__ void init(int M, int N, int G_, int c_) { nM = M / BM; nN = N / BM; nwg = nM * nN; G = G_; c = c_; }
    __host__ __device__ bool next(int i, Unit& u) const {
        const long L = (long)i * G + c; if (L >= nwg) return false;
        int wgid = (int)L; { const int q = nwg / NXCD, r = nwg % NXCD, xcd = wgid % NXCD, off = wgid / NXCD; wgid = (xcd < r ? xcd * (q + 1) : r * (q + 1) + (xcd - r) * q) + off; }
        const int nig = WGM * nN, gid = wgid / nig, fm = gid * WGM, gsz = (nM - fm) < WGM ? (nM - fm) : WGM;
        u.pm = fm + ((wgid % nig) % gsz); u.pn = (wgid % nig) / gsz; u.kb = 0; u.ks = 0; return true;
    }
    __device__ __forceinline__ void a_ready(const Unit&) const {}
    __device__ __forceinline__ void done(const Unit&) const {}
};
struct SplitOrder {
    int nN, nS, ksl, ntot, G, c;
    __host__ __device__ void init(int M, int N, int Kfull, int ksl_, int G_, int c_) { nN = N / BM; nS = Kfull / ksl_; ksl = ksl_; ntot = (M / BM) * nN * nS; G = G_; c = c_; }
    __host__ __device__ bool next(int i, Unit& u) const { const int j = i * G + c; if (j >= ntot) return false; const int ks = j % nS, t = j / nS; u.pn = t % nN; u.pm = t / nN; u.kb = ks * ksl; u.ks = ks; return true; }
    __device__ __forceinline__ void a_ready(const Unit&) const {}
    __device__ __forceinline__ void done(const Unit&) const {}
};
__device__ __forceinline__ unsigned cvt_pk_bf16(float lo, float hi) { unsigned r; asm volatile("v_cvt_pk_bf16_f32 %0, %1, %2" : "=v"(r) : "v"(lo), "v"(hi)); return r; }
__device__ __forceinline__ float bf_lo(unsigned w) { return __uint_as_float(w << 16); }
__device__ __forceinline__ float bf_hi(unsigned w) { return __uint_as_float(w & 0xffff0000u); }
__device__ __forceinline__ float sigm(float x) { return __builtin_amdgcn_rcpf(1.0f + __expf(-x)); }

struct EpiSplit {
    static constexpr bool PERM = true, AFTER_DRAIN = false;
    bf16_t *U, *G, *P, *GT;
    __device__ __forceinline__ void operator()(const f32x4 (&acc)[2][2][4][2], const Unit& u, int wr, int wc, int fr, int fq) const {
        bf16_t* base; int ldc, colt;
        if (u.pn < 4) { base = U; ldc = 1024; colt = u.pn * 256; }
        else if (u.pn < 8) { base = G; ldc = 1024; colt = (u.pn - 4) * 256; }
        else if (u.pn < 10) { base = P; ldc = 512; colt = (u.pn - 8) * 256; }
        else { base = GT; ldc = 2048; colt = (u.pn - 10) * 256; }
        const int row0 = u.pm * BM + wr * 64 + fr, col0 = colt + wc * 32 + 8 * fq;
#pragma unroll
        for (int ai = 0; ai < 2; ++ai)
#pragma unroll
            for (int m = 0; m < 4; ++m) { bf16_t* rowp = base + (size_t)(row0 + ai * HALF + m * 16) * ldc + col0;
#pragma unroll
                for (int bj = 0; bj < 2; ++bj) { const f32x4 v0 = acc[ai][bj][m][0], v1 = acc[ai][bj][m][1];
                    u32x4 w; w.x = cvt_pk_bf16(v0[0], v0[1]); w.y = cvt_pk_bf16(v0[2], v0[3]); w.z = cvt_pk_bf16(v1[0], v1[1]); w.w = cvt_pk_bf16(v1[2], v1[3]);
                    *(u32x4*)(rowp + bj * HALF) = w; } }
    }
};
template <int MODE> struct EpiGate {
    static constexpr bool PERM = true, AFTER_DRAIN = false;
    bf16_t* Z; const bf16_t* GT;
    __device__ __forceinline__ void operator()(const f32x4 (&acc)[2][2][4][2], const Unit& u, int wr, int wc, int fr, int fq) const {
        const int row0 = u.pm * BM + wr * 64 + fr, col0 = u.pn * BM + wc * 32 + 8 * fq;
#pragma unroll
        for (int ai = 0; ai < 2; ++ai)
#pragma unroll
            for (int m = 0; m < 4; ++m) { const size_t row = (size_t)(row0 + ai * HALF + m * 16);
#pragma unroll
                for (int bj = 0; bj < 2; ++bj) { const int col = col0 + bj * HALF;
                    const u32x4 gt = *(const u32x4*)(GT + row * 2048 + (MODE == 0 ? 1024 : 0) + col);
                    f32x4 v0 = acc[ai][bj][m][0], v1 = acc[ai][bj][m][1];
                    v0[0] *= sigm(bf_lo(gt.x)); v0[1] *= sigm(bf_hi(gt.x)); v0[2] *= sigm(bf_lo(gt.y)); v0[3] *= sigm(bf_hi(gt.y));
                    v1[0] *= sigm(bf_lo(gt.z)); v1[1] *= sigm(bf_hi(gt.z)); v1[2] *= sigm(bf_lo(gt.w)); v1[3] *= sigm(bf_hi(gt.w));
                    u32x4* zp = (u32x4*)(Z + row * 1024 + col);
                    if (MODE == 1) { const u32x4 z = *zp;
                        v0[0] += bf_lo(z.x); v0[1] += bf_hi(z.x); v0[2] += bf_lo(z.y); v0[3] += bf_hi(z.y);
                        v1[0] += bf_lo(z.z); v1[1] += bf_hi(z.z); v1[2] += bf_lo(z.w); v1[3] += bf_hi(z.w); }
                    u32x4 w; w.x = cvt_pk_bf16(v0[0], v0[1]); w.y = cvt_pk_bf16(v0[2], v0[3]); w.z = cvt_pk_bf16(v1[0], v1[1]); w.w = cvt_pk_bf16(v1[2], v1[3]);
                    *zp = w; }
                asm volatile("" ::: "memory"); }
    }
};
struct EpiRes {
    static constexpr bool PERM = false, AFTER_DRAIN = false;
    const float* srcL; const float* srcC; float* dstL; float* dstC; const float* gate;
    __device__ __forceinline__ void operator()(const f32x4 (&acc)[2][2][4][2], const Unit& u, int wr, int wc, int fr, int fq) const {
        const bool lat = u.pm < 64;
        const size_t tb = (size_t)(lat ? u.pm : u.pm - 64) * 256 * 1024;
        const float* src = (lat ? srcL : srcC) + tb; float* dst = (lat ? dstL : dstC) + tb;
        const float* gv = gate + (lat ? (u.pm >> 4) : 4) * 6144;
        const int rl0 = wr * 64 + fr, col0 = u.pn * BM + wc * 32 + 4 * fq;
        f32x4 g[2][2];
#pragma unroll
        for (int bj = 0; bj < 2; ++bj)
#pragma unroll
            for (int n = 0; n < 2; ++n) g[bj][n] = *(const f32x4*)(gv + col0 + bj * HALF + n * 16);
#pragma unroll
        for (int ai = 0; ai < 2; ++ai)
#pragma unroll
            for (int m = 0; m < 4; ++m) { const size_t off = (size_t)(rl0 + ai * HALF + m * 16) * 1024 + col0;
#pragma unroll
                for (int bj = 0; bj < 2; ++bj)
#pragma unroll
                    for (int n = 0; n < 2; ++n) { const f32x4 s = *(const f32x4*)(src + off + bj * HALF + n * 16);
                        *(f32x4*)(dst + off + bj * HALF + n * 16) = s + g[bj][n] * acc[ai][bj][m][n]; }
                if (m == 3) asm volatile("" ::: "memory"); }
    }
};
struct EpiSqRelu {
    static constexpr bool PERM = true, AFTER_DRAIN = false;
    bf16_t* F; int ldc;
    __device__ __forceinline__ void operator()(const f32x4 (&acc)[2][2][4][2], const Unit& u, int wr, int wc, int fr, int fq) const {
        const int row0 = u.pm * BM + wr * 64 + fr, col0 = u.pn * BM + wc * 32 + 8 * fq;
#pragma unroll
        for (int ai = 0; ai < 2; ++ai)
#pragma unroll
            for (int m = 0; m < 4; ++m) { bf16_t* rowp = F + (size_t)(row0 + ai * HALF + m * 16) * ldc + col0;
#pragma unroll
                for (int bj = 0; bj < 2; ++bj) { f32x4 v0 = acc[ai][bj][m][0], v1 = acc[ai][bj][m][1];
#pragma unroll
                    for (int j = 0; j < 4; ++j) { const float a0 = fmaxf(v0[j], 0.f), a1 = fmaxf(v1[j], 0.f); v0[j] = a0 * a0; v1[j] = a1 * a1; }
                    u32x4 w; w.x = cvt_pk_bf16(v0[0], v0[1]); w.y = cvt_pk_bf16(v0[2], v0[3]); w.z = cvt_pk_bf16(v1[0], v1[1]); w.w = cvt_pk_bf16(v1[2], v1[3]);
                    *(u32x4*)(rowp + bj * HALF) = w; } }
    }
};

struct EpiSlab {
    static constexpr bool PERM = false, AFTER_DRAIN = false;
    float* slab;
    __device__ __forceinline__ void operator()(const f32x4 (&acc)[2][2][4][2], const Unit& u, int wr, int wc, int fr, int fq) const {
        float* p0 = slab + ((size_t)u.ks * 1024 + u.pm * BM + wr * 64 + fr) * 1024 + u.pn * BM + wc * 32 + 4 * fq;
#pragma unroll
        for (int ai = 0; ai < 2; ++ai)
#pragma unroll
            for (int m = 0; m < 4; ++m) { float* rowp = p0 + (size_t)(ai * HALF + m * 16) * 1024;
#pragma unroll
                for (int bj = 0; bj < 2; ++bj)
#pragma unroll
                    for (int n = 0; n < 2; ++n) *(f32x4*)(rowp + bj * HALF + n * 16) = acc[ai][bj][m][n]; }
    }
};

template <class Epi, class Sched, bool ALIGN_EPI = false, bool SP2 = false>
__device__ __forceinline__ void gemm_phase(PG8_LAS unsigned char* lds, const Gemm g, const Sched& S, const Epi& E) {
    const int tid = opaque_tid(), wid = __builtin_amdgcn_readfirstlane(tid >> 6), lane = tid & 63, wr = wid >> 2, wc = wid & 3, fr = lane & 15, fq = lane >> 4;
    const int K = g.ld, nt = g.K / BK;
    unsigned voffA[2], voffB[2];
#pragma unroll
    for (int i = 0; i < 2; ++i) { int R, C; stage_rc(tid * 16 + i * 8192, R, C); const int Rb = Epi::PERM ? ((R & ~31) + perm32(R & 31)) : R;
        voffA[i] = (unsigned)(R * K + C) * 2u; voffB[i] = (unsigned)(Rb * K + C) * 2u; }
    const size_t kstep = (size_t)(BK * 2);
    const size_t hstep = (size_t)HALF * K * 2;
    const size_t tstep = 2 * hstep;
    const unsigned ldsw = (unsigned)wid * 1024u;
    const int aoff = lds_byte(wr * 64 + fr, fq * 8), boff = lds_byte(wc * 32 + fr, fq * 8);
#define PG8_SA(b, h) (((b) * 2 + (h)) * HTB)
#define PG8_SB(b, h) ((4 + (b) * 2 + (h)) * HTB)
#define PG8_STAGE(bufoff, gbase, voff) do { _Pragma("unroll") for (int _i = 0; _i < 2; ++_i) \
        __builtin_amdgcn_global_load_lds((const unsigned*)((const char*)(gbase) + (voff)[_i]), (PG8_LAS unsigned*)(lds + (bufoff) + ldsw + _i * 8192), 16, 0, 0); } while (0)
#define PG8_LDA(dst, b, h) do { _Pragma("unroll") for (int m = 0; m < 4; ++m) _Pragma("unroll") for (int k = 0; k < 2; ++k) dst[m][k] = *(const PG8_LAS bf16x8*)(lds + PG8_SA(b, h) + aoff + m * 2048 + k * 1024); } while (0)
#define PG8_LDB(dst, b, h) do { _Pragma("unroll") for (int n = 0; n < 2; ++n) _Pragma("unroll") for (int k = 0; k < 2; ++k) dst[n][k] = *(const PG8_LAS bf16x8*)(lds + PG8_SB(b, h) + boff + n * 2048 + k * 1024); } while (0)
#define PG8_MMA(ai, bj, At, Bt) do { __builtin_amdgcn_s_setprio(1); _Pragma("unroll") for (int m = 0; m < 4; ++m) _Pragma("unroll") for (int n = 0; n < 2; ++n) _Pragma("unroll") for (int k = 0; k < 2; ++k) \
        acc[ai][bj][m][n] = __builtin_amdgcn_mfma_f32_16x16x32_bf16(Bt[n][k], At[m][k], acc[ai][bj][m][n], 0, 0, 0); __builtin_amdgcn_s_setprio(0); } while (0)
#define PG8_WAIT_V(n) asm volatile("s_waitcnt vmcnt(" #n ")" ::: "memory")
#define PG8_WAIT_L(n) asm volatile("s_waitcnt lgkmcnt(" #n ")" ::: "memory")
#define PG8_BAR __builtin_amdgcn_s_barrier()
#define PG8_SCHED __builtin_amdgcn_sched_barrier(0)
    Unit cur, nxt; int ui = 0;
    if (!S.next(0, cur)) return;
    f32x4 acc[2][2][4][2];
#pragma unroll
    for (int a = 0; a < 2; ++a)
#pragma unroll
        for (int b = 0; b < 2; ++b)
#pragma unroll
            for (int m = 0; m < 4; ++m)
#pragma unroll
                for (int n = 0; n < 2; ++n) acc[a][b][m][n] = (f32x4){0.f, 0.f, 0.f, 0.f};
    bf16x8 At[4][2], B0[2][2], B1[2][2];
    const char* cA = (const char*)g.A + (size_t)cur.pm * tstep + (size_t)cur.kb * 2; const char* cB = (const char*)g.Bt + (size_t)cur.pn * tstep + (size_t)cur.kb * 2;
    S.a_ready(cur);
    if constexpr (SP2) {
        PG8_STAGE(PG8_SB(0, 0), cB, voffB); PG8_STAGE(PG8_SB(0, 1), cB + hstep, voffB); PG8_STAGE(PG8_SA(0, 0), cA, voffA); PG8_STAGE(PG8_SA(0, 1), cA + hstep, voffA);
        if (wr == 1) PG8_BAR;
        PG8_WAIT_V(2); PG8_BAR;
        PG8_STAGE(PG8_SB(1, 0), cB + kstep, voffB); PG8_STAGE(PG8_SA(1, 0), cA + kstep, voffA); PG8_STAGE(PG8_SB(1, 1), cB + hstep + kstep, voffB);
        PG8_WAIT_V(6); PG8_BAR;
    } else {
        PG8_STAGE(PG8_SB(0, 0), cB, voffB); PG8_STAGE(PG8_SA(0, 0), cA, voffA); PG8_STAGE(PG8_SB(0, 1), cB + hstep, voffB); PG8_STAGE(PG8_SA(0, 1), cA + hstep, voffA);
        if (wr == 1) PG8_BAR;
        PG8_WAIT_V(4); PG8_BAR;
        PG8_STAGE(PG8_SB(1, 0), cB + kstep, voffB); PG8_STAGE(PG8_SA(1, 0), cA + kstep, voffA); PG8_STAGE(PG8_SB(1, 1), cB + hstep + kstep, voffB);
        PG8_WAIT_V(6); PG8_BAR;
    }
    for (;;) {
        const bool has_next = S.next(ui + 1, nxt);
        const char* nA = has_next ? (const char*)g.A + (size_t)nxt.pm * tstep + (size_t)nxt.kb * 2 : cA; const char* nB = has_next ? (const char*)g.Bt + (size_t)nxt.pn * tstep + (size_t)nxt.kb * 2 : cB;
        for (int t = 0; t < nt; t += 2) {
            const bool last = (t == nt - 2);
            const char* a1 = cA + (size_t)(t + 1) * kstep;
            const char* a2 = last ? nA : cA + (size_t)(t + 2) * kstep; const char* b2 = last ? nB : cB + (size_t)(t + 2) * kstep;
            const char* a3 = a2 + kstep; const char* b3 = b2 + kstep;
            if (last && has_next) S.a_ready(nxt);
            if constexpr (SP2) {
            PG8_LDB(B0, 0, 0); PG8_LDB(B1, 0, 1); PG8_SCHED; PG8_LDA(At, 0, 0); PG8_STAGE(PG8_SA(1, 1), a1 + hstep, voffA);
            PG8_WAIT_V(8); PG8_WAIT_L(0); PG8_BAR; PG8_MMA(0, 0, At, B0); PG8_MMA(0, 1, At, B1); PG8_BAR; PG8_SCHED;
            PG8_LDA(At, 0, 1); PG8_STAGE(PG8_SB(0, 0), b2, voffB); PG8_STAGE(PG8_SB(0, 1), b2 + hstep, voffB); PG8_STAGE(PG8_SA(0, 0), a2, voffA);
            PG8_WAIT_V(8); PG8_WAIT_L(0); PG8_BAR; PG8_MMA(1, 0, At, B0); PG8_MMA(1, 1, At, B1); PG8_BAR; PG8_SCHED;
            PG8_LDB(B0, 1, 0); PG8_LDB(B1, 1, 1); PG8_SCHED; PG8_LDA(At, 1, 0); PG8_STAGE(PG8_SA(0, 1), a2 + hstep, voffA);
            PG8_WAIT_V(8); PG8_WAIT_L(0); PG8_BAR; PG8_MMA(0, 0, At, B0); PG8_MMA(0, 1, At, B1); PG8_BAR; PG8_SCHED;
            PG8_LDA(At, 1, 1); PG8_STAGE(PG8_SB(1, 0), b3, voffB); PG8_STAGE(PG8_SB(1, 1), b3 + hstep, voffB); PG8_STAGE(PG8_SA(1, 0), a3, voffA);
            PG8_WAIT_V(8); PG8_WAIT_L(0); PG8_BAR; PG8_MMA(1, 0, At, B0); PG8_MMA(1, 1, At, B1); PG8_BAR; PG8_SCHED;
            } else {
            PG8_LDB(B0, 0, 0); PG8_SCHED; PG8_LDA(At, 0, 0); PG8_STAGE(PG8_SA(1, 1), a1 + hstep, voffA);
            PG8_WAIT_L(8); PG8_BAR; PG8_WAIT_L(0); PG8_MMA(0, 0, At, B0); PG8_BAR; PG8_SCHED;
            PG8_LDB(B1, 0, 1); PG8_STAGE(PG8_SB(0, 0), b2, voffB);
            PG8_BAR; PG8_WAIT_L(0); PG8_MMA(0, 1, At, B1); PG8_BAR;
            PG8_LDA(At, 0, 1); PG8_STAGE(PG8_SA(0, 0), a2, voffA);
            PG8_BAR; PG8_WAIT_L(0); PG8_MMA(1, 0, At, B0); PG8_BAR; PG8_SCHED;
            PG8_STAGE(PG8_SB(0, 1), b2 + hstep, voffB);
            PG8_WAIT_V(6); PG8_BAR; PG8_MMA(1, 1, At, B1); PG8_BAR;
            PG8_LDB(B0, 1, 0); PG8_SCHED; PG8_LDA(At, 1, 0); PG8_STAGE(PG8_SA(0, 1), a2 + hstep, voffA);
            PG8_WAIT_L(8); PG8_BAR; PG8_WAIT_L(0); PG8_MMA(0, 0, At, B0); PG8_BAR; PG8_SCHED;
            PG8_LDB(B1, 1, 1); PG8_STAGE(PG8_SB(1, 0), b3, voffB);
            PG8_BAR; PG8_WAIT_L(0); PG8_MMA(0, 1, At, B1); PG8_BAR;
            PG8_LDA(At, 1, 1); PG8_STAGE(PG8_SA(1, 0), a3, voffA);
            PG8_BAR; PG8_WAIT_L(0); PG8_MMA(1, 0, At, B0); PG8_BAR; PG8_SCHED;
            PG8_STAGE(PG8_SB(1, 1), b3 + hstep, voffB);
            PG8_WAIT_V(6); PG8_BAR; PG8_MMA(1, 1, At, B1); PG8_BAR;
            }
        }
        if constexpr (ALIGN_EPI) { if (wr == 0) PG8_BAR; }
        if constexpr (!Epi::AFTER_DRAIN) { E(acc, cur, wr, wc, fr, fq); S.done(cur); }
        if (!has_next) break;
#pragma unroll
        for (int a = 0; a < 2; ++a)
#pragma unroll
            for (int b = 0; b < 2; ++b)
#pragma unroll
                for (int m = 0; m < 4; ++m)
#pragma unroll
                    for (int n = 0; n < 2; ++n) acc[a][b][m][n] = (f32x4){0.f, 0.f, 0.f, 0.f};
        cur = nxt; cA = nA; cB = nB; ++ui;
        if constexpr (ALIGN_EPI) { if (wr == 1) PG8_BAR; }
    }
    PG8_WAIT_V(0);
    if constexpr (!ALIGN_EPI) { if (wr == 0) PG8_BAR; }
    PG8_BAR;
    if constexpr (Epi::AFTER_DRAIN) { E.fused(acc, cur, wr, wc, fr, fq, lds, wid, lane); S.done(cur); }
#undef PG8_SA
#undef PG8_SB
#undef PG8_STAGE
#undef PG8_LDA
#undef PG8_LDB
#undef PG8_MMA
#undef PG8_WAIT_V
#undef PG8_WAIT_L
#undef PG8_BAR
#undef PG8_SCHED
}
}
constexpr int D = 1024, NB = 4, SEQ = 4096, CTX = 256, DEPTH = 2;
constexpr int ML = NB * SEQ, MC = NB * CTX, MT = ML + MC;
constexpr int D_IN = 4608, D_POOL = 512, D_FF = 4096, MODW = 6 * D;
constexpr int TCH = 64;
constexpr int NSUB = TCH / 32, NCL = SEQ / TCH, NCC = CTX / TCH, NLAT = NB * NCL * 16, NCTX = NB * NCC * 16;
constexpr int NQ = NCC + NCL;
constexpr float EPS = 1e-6f;
constexpr size_t MiB = 1u << 20;
constexpr size_t WS_MOD = 0;
constexpr size_t WS_BAR = 256 * 1024;
constexpr size_t WS_SUMM = 244 * MiB;
constexpr size_t WS_CARRY = WS_SUMM + (size_t)NB * 2 * NQ * 2 * 1024 * 4;
constexpr size_t WS_XC = 4 * MiB;
constexpr size_t WS_WIN = 8 * MiB, WS_WLO = 17 * MiB, WS_WPO = 19 * MiB, WS_WO = 20 * MiB, WS_W1 = 22 * MiB, WS_W2 = 30 * MiB;
constexpr size_t WS_GW = 38 * MiB;
constexpr size_t WS_PW = 39 * MiB;
constexpr size_t WS_H = 40 * MiB;
constexpr size_t WS_U = 74 * MiB;
constexpr size_t WS_G = 108 * MiB;
constexpr size_t WS_P = 142 * MiB;
constexpr size_t WS_GT = 159 * MiB;
constexpr size_t WS_PM = 227 * MiB;
constexpr size_t WS_SLAB3 = WS_G;
constexpr size_t WS_SLAB5 = 210 * MiB;
constexpr size_t WS_F = WS_U;
constexpr size_t WS_END = 256 * MiB;
static_assert(WS_CARRY + (size_t)NB * 2 * NQ * 1024 * 4 <= 256 * MiB, "ws map (tail)");
static_assert(WS_F + (size_t)MT * D_FF * 2 <= WS_PM && WS_H + (size_t)MT * D * 2 <= WS_U && WS_GT + (size_t)MT * 2048 * 2 <= WS_PM, "ws map");
constexpr int LDS_BYTES = 8 * 19456 + 256, MISC_OFF = 8 * 19456;

#define LAS __attribute__((address_space(3)))
typedef unsigned short bf16;
typedef unsigned u32x4 __attribute__((ext_vector_type(4)));
typedef unsigned u32x2 __attribute__((ext_vector_type(2)));
typedef float f32x4 __attribute__((ext_vector_type(4)));
typedef float f32x16 __attribute__((ext_vector_type(16)));
typedef short bf16x8 __attribute__((ext_vector_type(8)));
using pg8::cvt_pk_bf16; using pg8::bf_lo; using pg8::bf_hi; using pg8::sigm;

struct Args { const float* in[24]; float* out; unsigned char* ws; int lo, hi; };
enum { I_X = 0, I_C, I_CTX, I_CCTX, I_WADA, I_BADA, I_N1G, I_N2G, I_WIN, I_CONVW, I_CONVB, I_WR, I_BR, I_WI, I_BI, I_LAM, I_WLO, I_POOLW, I_POOLS, I_WPO, I_WO, I_W1, I_W2, I_FG };

__device__ __forceinline__ float wave_sum(float v) {
#pragma unroll
    for (int o = 1; o < 64; o <<= 1) v += __shfl_xor(v, o);
    return v;
}
__device__ __forceinline__ float gelu_tanh(float x) { const float z = 0.7978845608f * (x + 0.044715f * x * x * x); const float e = __expf(2.f * z); return 0.5f * x * (2.f - 2.f * __builtin_amdgcn_rcpf(e + 1.f)); }

__device__ __forceinline__ void mod_item(const Args& a, LAS unsigned char* lds, int item) {
    const int tid = opaque_tid(), l = item / 96, cb = item % 96, cq = tid & 15, kg = tid >> 4;
    LAS float* s = (LAS float*)lds;
    LAS float* part = (LAS float*)(lds + 20480);
    const float* c = a.in[I_C]; const float* cc = a.in[I_CCTX];
    for (int i = tid; i < 5120; i += 512) { const int r = i >> 10, k = i & 1023; const float v = r < 4 ? c[r * 1024 + k] : cc[k]; s[i] = v * sigm(v); }
    __syncthreads();
    const float* W = a.in[I_WADA] + (size_t)l * D * MODW + cb * 64 + cq * 4;
    float acc[5][4];
#pragma unroll
    for (int r = 0; r < 5; ++r)
#pragma unroll
        for (int j = 0; j < 4; ++j) acc[r][j] = 0.f;
#pragma unroll 8
    for (int kk = 0; kk < 32; ++kk) { const int k = kg * 32 + kk; const f32x4 w = *(const f32x4*)(W + (size_t)k * MODW);
#pragma unroll
        for (int r = 0; r < 5; ++r) { const float sv = s[r * 1024 + k];
#pragma unroll
            for (int j = 0; j < 4; ++j) acc[r][j] += sv * w[j]; } }
#pragma unroll
    for (int r = 0; r < 5; ++r)
#pragma unroll
        for (int j = 0; j < 4; ++j) part[(kg * 5 + r) * 64 + cq * 4 + j] = acc[r][j];
    __syncthreads();
    if (tid < 320) { const int r = tid >> 6, col = tid & 63; float t = 0.f;
#pragma unroll 8
        for (int g = 0; g < 32; ++g) t += part[(g * 5 + r) * 64 + col];
        ((float*)(a.ws + WS_MOD))[(size_t)(l * 5 + r) * MODW + cb * 64 + col] = t + a.in[I_BADA][l * MODW + cb * 64 + col]; }
    __syncthreads();
}
__device__ __forceinline__ void transpose_item(const float* W, int K, int N, bf16* WT, LAS float* scr, int item, int lane) {
    const int nblk = N / 32, kb = item / nblk, nb = item % nblk, k0 = 64 * kb, n0 = 32 * nb;
#pragma unroll 8
    for (int i = 0; i < 32; ++i) { const int kk = 2 * i + (lane >> 5); scr[kk * 33 + (lane & 31)] = W[(size_t)(k0 + kk) * N + n0 + (lane & 31)]; }
    asm volatile("s_waitcnt lgkmcnt(0)" ::: "memory");
    const int c = lane & 7;
#pragma unroll
    for (int j = 0; j < 4; ++j) { const int n = (lane >> 3) + 8 * j; const LAS float* s = scr + (8 * c) * 33 + n;
        u32x4 o; o.x = cvt_pk_bf16(s[0 * 33], s[1 * 33]); o.y = cvt_pk_bf16(s[2 * 33], s[3 * 33]); o.z = cvt_pk_bf16(s[4 * 33], s[5 * 33]); o.w = cvt_pk_bf16(s[6 * 33], s[7 * 33]);
        *(u32x4*)(WT + (size_t)(n0 + n) * K + k0 + 8 * c) = o; }
    asm volatile("s_waitcnt lgkmcnt(0)" ::: "memory");
}
__device__ __forceinline__ void convert_big(const Args& a, LAS unsigned char* lds, int l, int gw, int NGW, int wave, int lane) {
    LAS float* scr = (LAS float*)(lds + wave * 16384);
    constexpr int I_IN = (D / 64) * (D_IN / 32), I_LO = (D / 64) * (D / 32), I_PO = (D_POOL / 64) * (D / 32), I_O = I_LO, I_1 = (D / 64) * (D_FF / 32), I_2 = (D_FF / 64) * (D / 32);
    constexpr int NIT = I_IN + I_LO + I_PO + I_O + I_1 + I_2;
    unsigned char* ws = a.ws;
    for (int it = gw; it < NIT; it += NGW) { int r = it;
        if (r < I_IN) { transpose_item(a.in[I_WIN] + (size_t)l * D * D_IN, D, D_IN, (bf16*)(ws + WS_WIN), scr, r, lane); continue; } r -= I_IN;
        if (r < I_LO) { transpose_item(a.in[I_WLO] + (size_t)l * D * D, D, D, (bf16*)(ws + WS_WLO), scr, r, lane); continue; } r -= I_LO;
        if (r < I_PO) { transpose_item(a.in[I_WPO] + (size_t)l * D_POOL * D, D_POOL, D, (bf16*)(ws + WS_WPO), scr, r, lane); continue; } r -= I_PO;
        if (r < I_O) { transpose_item(a.in[I_WO] + (size_t)l * D * D, D, D, (bf16*)(ws + WS_WO), scr, r, lane); continue; } r -= I_O;
        if (r < I_1) { transpose_item(a.in[I_W1] + (size_t)l * D * D_FF, D, D_FF, (bf16*)(ws + WS_W1), scr, r, lane); continue; } r -= I_1;
        transpose_item(a.in[I_W2] + (size_t)l * D_FF * D, D_FF, D, (bf16*)(ws + WS_W2), scr, r, lane); }
}
__device__ __forceinline__ void convert_small(const Args& a, LAS unsigned char* lds, int gw, int NGW, int wave, int lane) {
    LAS float* scr = (LAS float*)(lds + wave * 16384);
    for (int it = gw; it < 256 + 64; it += NGW) {
        if (it < 256) { const int mi = it >> 1, sub = it & 1, h = mi & 15, ri = (mi >> 4) & 1, ld = mi >> 5;
            const float* src = a.in[ri ? I_WI : I_WR] + ((size_t)ld * 16 + h) * 4096;
            transpose_item(src, 64, 64, (bf16*)(a.ws + WS_GW) + ((size_t)(ld * 2 + ri) * 16 + h) * 4096, scr, sub, lane); }
        else { const int r = it - 256, mi = r >> 3, sub = r & 7;
            transpose_item(a.in[I_POOLW] + (size_t)mi * 16384, 128, 128, (bf16*)(a.ws + WS_PW) + (size_t)mi * 16384, scr, sub, lane); }
    }
}
__device__ __forceinline__ void norm_rows(const float* xl, const float* xc, bf16* H, const float* gvec, const float* mod  , int shift_i, int scale_i, int nrows, int gw, int NGW, int lane,
                                          const float* slab = nullptr, const float* sgate = nullptr, float* xcw = nullptr) {
    for (int m = gw; m < nrows; m += NGW) {
        const float* xr = m < ML ? xl + (size_t)m * D : xc + (size_t)(m - ML) * D; const int r = m < ML ? (m >> 12) : 4;
        const f32x4* x4 = (const f32x4*)xr + lane; f32x4 v[4]; float ss = 0.f;
#pragma unroll
        for (int j = 0; j < 4; ++j) v[j] = x4[64 * j];
        if (slab != nullptr && m >= ML) {
            const f32x4* s4 = (const f32x4*)(slab + (size_t)(m - ML) * D) + lane; const f32x4* g4s = (const f32x4*)sgate + lane;
#pragma unroll
            for (int j = 0; j < 4; ++j) { const f32x4 t = (s4[64 * j] + s4[64 * j + 262144]) + (s4[64 * j + 2 * 262144] + s4[64 * j + 3 * 262144]); v[j] = v[j] + g4s[64 * j] * t; }
            if (xcw != nullptr) { f32x4* w4 = (f32x4*)(xcw + (size_t)(m - ML) * D) + lane;
#pragma unroll
                for (int j = 0; j < 4; ++j) w4[64 * j] = v[j]; } }
#pragma unroll
        for (int j = 0; j < 4; ++j) ss += (v[j].x * v[j].x + v[j].y * v[j].y) + (v[j].z * v[j].z + v[j].w * v[j].w);
        const float rstd = 1.0f / sqrtf(wave_sum(ss) * (1.f / D) + EPS);
        const f32x4* g4 = (const f32x4*)gvec + lane; const f32x4* sc4 = (const f32x4*)(mod + (size_t)r * MODW + scale_i * D) + lane; const f32x4* sh4 = (const f32x4*)(mod + (size_t)r * MODW + shift_i * D) + lane;
        u32x2* o = (u32x2*)(H + (size_t)m * D) + lane;
#pragma unroll
        for (int j = 0; j < 4; ++j) { const f32x4 h = v[j] * rstd * g4[64 * j] * (1.0f + sc4[64 * j]) + sh4[64 * j]; u32x2 w; w.x = cvt_pk_bf16(h.x, h.y); w.y = cvt_pk_bf16(h.z, h.w); o[64 * j] = w; }
    }
}
__device__ __forceinline__ void final_rows(float* x, const float* gvec, int gw, int NGW, int lane) {
    for (int m = gw; m < ML; m += NGW) {
        f32x4* x4 = (f32x4*)(x + (size_t)m * D) + lane; f32x4 v[4]; float ss = 0.f;
#pragma unroll
        for (int j = 0; j < 4; ++j) { v[j] = x4[64 * j]; ss += (v[j].x * v[j].x + v[j].y * v[j].y) + (v[j].z * v[j].z + v[j].w * v[j].w); }
        const float rstd = 1.0f / sqrtf(wave_sum(ss) * (1.f / D) + EPS);
        const f32x4* g4 = (const f32x4*)gvec + lane;
#pragma unroll
        for (int j = 0; j < 4; ++j) x4[64 * j] = v[j] * rstd * g4[64 * j];
    }
}
constexpr int SCW_WAVE = 19456, SCW_TILE = 17664;
constexpr int SCW_WAVE_OLD = 18432;
template <bool PASSB, int DIR>
__device__ __forceinline__ void scan_sweep(const Args& a, LAS unsigned char* wl, int l, int b, int q, int h, int seqbase, int L, int t0, int lane, unsigned (&st)[NSUB][16]) {
    const int l31 = lane & 31, lh = lane >> 5, ld = l * 2 + DIR;
    const bf16* U = (const bf16*)(a.ws + WS_U) + (size_t)seqbase * D + h * 64 + lh * 8;
    const LAS float* cwl = (const LAS float*)(wl + 16384);
    { const bf16* g0 = (const bf16*)(a.ws + WS_GW) + (size_t)((ld * 2 + 0) * 16 + h) * 4096; const bf16* g1 = (const bf16*)(a.ws + WS_GW) + (size_t)((ld * 2 + 1) * 16 + h) * 4096;
      u32x4 v0[8], v1[8];
#pragma unroll
      for (int p = 0; p < 8; ++p) { v0[p] = *(const u32x4*)(g0 + (p * 64 + lane) * 8); v1[p] = *(const u32x4*)(g1 + (p * 64 + lane) * 8); }
#pragma unroll
      for (int p = 0; p < 8; ++p) { const int piece = p * 64 + lane, row = piece >> 3, c = piece & 7, off = row * 128 + ((c ^ (row & 7)) * 16);
          *(LAS u32x4*)(wl + off) = v0[p]; *(LAS u32x4*)(wl + 8192 + off) = v1[p]; } }
    float brr[2], bii[2], sp[2], s[2], AT[2];
#pragma unroll
    for (int nb = 0; nb < 2; ++nb) { const int ch = h * 64 + nb * 32 + l31;
        brr[nb] = -1.44269504f * a.in[I_BR][ld * D + ch]; bii[nb] = -1.44269504f * a.in[I_BI][ld * D + ch];
        const float lam = a.in[I_LAM][ld * D + ch]; sp[nb] = (-8.0f * 1.44269504f) * (fmaxf(-lam, 0.f) + log1pf(__expf(-fabsf(lam))));
        AT[nb] = 1.f; s[nb] = PASSB ? ((const float*)(a.ws + WS_CARRY))[(size_t)((b * 2 + DIR) * NQ + q) * 1024 + ch] : 0.f; }
    asm volatile("s_waitcnt lgkmcnt(0)" ::: "memory"); __builtin_amdgcn_wave_barrier();
    u32x4 ur[4][4];
#define LOADU(tokv) do { _Pragma("unroll") for (int j_ = 0; j_ < 4; ++j_) { const int tc_ = min(max((tokv) - 2 + j_, 0), L - 1); \
        _Pragma("unroll") for (int ks_ = 0; ks_ < 4; ++ks_) ur[ks_][j_] = *(const u32x4*)(U + (size_t)tc_ * D + ks_ * 16); } } while (0)
#ifndef SCAN_PREFETCH
#define SCAN_PREFETCH 0
#endif
    if (SCAN_PREFETCH) LOADU(t0 + (DIR ? (NSUB - 1) * 32 : 0) + l31);
#pragma unroll 1
    for (int k = 0; k < NSUB; ++k) {
        const int tsub = t0 + (DIR ? NSUB - 1 - k : k) * 32, tok = tsub + l31;
        bf16x8 af[4];
        if (!SCAN_PREFETCH) { LOADU(tok); __builtin_amdgcn_sched_barrier(0); }
#pragma unroll
        for (int ks = 0; ks < 4; ++ks) { const int c0 = ks * 16 + lh * 8;
            f32x4 u0 = *(const LAS f32x4*)(cwl + 256 + c0), u1 = *(const LAS f32x4*)(cwl + 256 + c0 + 4);
#pragma unroll
            for (int j = 0; j < 4; ++j) { const int tt = tok - 2 + j; const bool ok = (tt >= 0 && tt < L); u32x4 uv = ur[ks][j];
                uv.x = ok ? uv.x : 0u; uv.y = ok ? uv.y : 0u; uv.z = ok ? uv.z : 0u; uv.w = ok ? uv.w : 0u;
                const f32x4 w0 = *(const LAS f32x4*)(cwl + j * 64 + c0), w1 = *(const LAS f32x4*)(cwl + j * 64 + c0 + 4);
                u0.x = fmaf(w0.x, bf_lo(uv.x), u0.x); u0.y = fmaf(w0.y, bf_hi(uv.x), u0.y); u0.z = fmaf(w0.z, bf_lo(uv.y), u0.z); u0.w = fmaf(w0.w, bf_hi(uv.y), u0.w);
                u1.x = fmaf(w1.x, bf_lo(uv.z), u1.x); u1.y = fmaf(w1.y, bf_hi(uv.z), u1.y); u1.z = fmaf(w1.z, bf_lo(uv.w), u1.z); u1.w = fmaf(w1.w, bf_hi(uv.w), u1.w); }
            u32x4 o; o.x = cvt_pk_bf16(u0.x, u0.y); o.y = cvt_pk_bf16(u0.z, u0.w); o.z = cvt_pk_bf16(u1.x, u1.y); o.w = cvt_pk_bf16(u1.z, u1.w);
            af[ks] = __builtin_bit_cast(bf16x8, o); }
        __builtin_amdgcn_sched_barrier(0);
        if (SCAN_PREFETCH) { const int kn = k < NSUB - 1 ? k + 1 : k; LOADU(t0 + (DIR ? NSUB - 1 - kn : kn) * 32 + l31); }
        __builtin_amdgcn_sched_barrier(0);
        unsigned cur[16];
        if (PASSB && DIR == 1) {
#pragma unroll
            for (int i = 0; i < 16; ++i) { cur[i] = st[0][i];
#pragma unroll
                for (int d = 0; d + 1 < NSUB; ++d) st[d][i] = st[d + 1][i]; } }
        float gall[2][16]; unsigned outp[2][8];
        LAS unsigned char* tile = wl + SCW_TILE; const int r8 = lane >> 3, c8 = lane & 7;
        if (PASSB && DIR == 1) {
            const bf16* Grow = (const bf16*)(a.ws + WS_G) + (size_t)(seqbase + tsub + r8) * D + h * 64 + c8 * 8;
            u32x4 gq[4];
#pragma unroll
            for (int gi = 0; gi < 4; ++gi) gq[gi] = *(const u32x4*)(Grow + (size_t)(8 * gi) * D);
#pragma unroll
            for (int gi = 0; gi < 4; ++gi) { *(LAS u32x4*)(tile + r8 * 128 + c8 * 16) = gq[gi];
#pragma unroll
                for (int nb2 = 0; nb2 < 2; ++nb2)
#pragma unroll
                    for (int j = 0; j < 4; ++j) gall[nb2][4 * gi + j] = __uint_as_float((unsigned)(*(const LAS unsigned short*)(tile + (4 * lh + j) * 128 + (nb2 * 32 + l31) * 2)) << 16); } }
#pragma unroll
        for (int nb = 0; nb < 2; ++nb) {
            __builtin_amdgcn_sched_barrier(0);
            const size_t cbase = (size_t)(seqbase + tsub + 4 * lh) * D + h * 64 + nb * 32 + l31;
            bf16* HL = (bf16*)(a.ws + WS_H) + cbase; const bf16* Gp = (const bf16*)(a.ws + WS_G) + cbase;
            float hfv[16], gv[16];
            if (PASSB && DIR == 1) {
#pragma unroll
                for (int reg = 0; reg < 16; ++reg) { gv[reg] = gall[nb][reg];
                    hfv[reg] = (reg & 1) ? bf_hi(cur[nb * 8 + (reg >> 1)]) : bf_lo(cur[nb * 8 + (reg >> 1)]); } }
            f32x16 ar, ai, au;
#pragma unroll
            for (int i = 0; i < 16; ++i) { ar[i] = 0.f; ai[i] = 0.f; au[i] = 0.f; }
            const int row = nb * 32 + l31;
#pragma unroll
            for (int ks = 0; ks < 4; ++ks) {
                const int idx = row - (ks * 16 + lh * 8);
                const unsigned one = (idx >= 0 && idx < 8) ? (0x3F80u << ((idx & 1) * 16)) : 0u; const int dw = idx >> 1;
                u32x4 idv; idv.x = dw == 0 ? one : 0u; idv.y = dw == 1 ? one : 0u; idv.z = dw == 2 ? one : 0u; idv.w = dw == 3 ? one : 0u;
                const int woff = row * 128 + (((ks * 2 + lh) ^ (row & 7)) * 16);
                const bf16x8 wr = *(const LAS bf16x8*)(wl + woff), wi = *(const LAS bf16x8*)(wl + 8192 + woff);
                ar = __builtin_amdgcn_mfma_f32_32x32x16_bf16(af[ks], wr, ar, 0, 0, 0);
                ai = __builtin_amdgcn_mfma_f32_32x32x16_bf16(af[ks], wi, ai, 0, 0, 0);
                if ((ks >> 1) == nb) au = __builtin_amdgcn_mfma_f32_32x32x16_bf16(af[ks], __builtin_bit_cast(bf16x8, idv), au, 0, 0, 0); }
#pragma unroll
            for (int reg = 0; reg < 16; ++reg) {
                const float r = __builtin_amdgcn_rcpf(1.0f + __builtin_amdgcn_exp2f(fmaf(ar[reg], -1.44269504f, brr[nb])));
                const float ig = __builtin_amdgcn_rcpf(1.0f + __builtin_amdgcn_exp2f(fmaf(ai[reg], -1.44269504f, bii[nb])));
                float rs = r * sp[nb]; asm volatile("" : "+v"(rs));
                const float av = __builtin_amdgcn_exp2f(rs); float om = fmaf(-av, av, 1.0f); asm volatile("" : "+v"(om));
                float bq = (__builtin_amdgcn_sqrtf(om) * ig) * au[reg]; asm volatile("" : "+v"(bq));
                ar[reg] = av; ai[reg] = bq; }
            float gA[4], gB[4], pA[4], pB[4], sIn[4];
#pragma unroll
            for (int gi = 0; gi < 4; ++gi) { const int j0 = DIR ? 3 : 0; float A = ar[4 * gi + j0], B = ai[4 * gi + j0];
#pragma unroll
                for (int jj = 1; jj < 4; ++jj) { const int j = DIR ? 3 - jj : jj; B = ar[4 * gi + j] * B + ai[4 * gi + j]; A *= ar[4 * gi + j]; }
                gA[gi] = A; gB[gi] = B; }
#pragma unroll
            for (int gi = 0; gi < 4; ++gi) { pA[gi] = __shfl_xor(gA[gi], 32); pB[gi] = __shfl_xor(gB[gi], 32); sIn[gi] = 0.f; }
            float st = s[nb];
#pragma unroll
            for (int g = 0; g < 8; ++g) { const int gg = DIR ? 7 - g : g, gi = gg >> 1; const bool own = (lh == (gg & 1));
                const float Ag = own ? gA[gi] : pA[gi], Bg = own ? gB[gi] : pB[gi];
                sIn[gi] = own ? st : sIn[gi]; st = Ag * st + Bg; if (!PASSB) AT[nb] *= Ag; }
            s[nb] = st;
            if (PASSB) {
#pragma unroll
                for (int gi = 0; gi < 4; ++gi) { float hc = sIn[gi];
#pragma unroll
                    for (int jj = 0; jj < 4; ++jj) { const int j = DIR ? 3 - jj : jj, reg = 4 * gi + j; hc = ar[reg] * hc + ai[reg];
                        const size_t o = (size_t)(8 * gi + j) * D;
                        if (DIR == 0) ar[reg] = hc;
                        else ar[reg] = (hfv[reg] + hc) * gelu_tanh(gv[reg]); } }
#pragma unroll
                for (int p = 0; p < 8; ++p) { const unsigned pk = cvt_pk_bf16(ar[2 * p], ar[2 * p + 1]); if (DIR == 0) cur[nb * 8 + p] = pk; else outp[nb][p] = pk; }
            }
        }
        if (PASSB && DIR == 0) {
#pragma unroll
            for (int i = 0; i < 16; ++i) {
#pragma unroll
                for (int d = NSUB - 1; d > 0; --d) st[d][i] = st[d - 1][i];
                st[0][i] = cur[i]; } }
        if (PASSB && DIR == 1) {
            bf16* HLrow = (bf16*)(a.ws + WS_H) + (size_t)(seqbase + tsub + r8) * D + h * 64 + c8 * 8;
#pragma unroll
            for (int gi = 0; gi < 4; ++gi) {
#pragma unroll
                for (int nb2 = 0; nb2 < 2; ++nb2)
#pragma unroll
                    for (int j = 0; j < 4; ++j) { const unsigned pk = outp[nb2][2 * gi + (j >> 1)];
                        *(LAS unsigned short*)(tile + (4 * lh + j) * 128 + (nb2 * 32 + l31) * 2) = (unsigned short)((j & 1) ? (pk >> 16) : (pk & 0xffffu)); }
                const u32x4 row = *(const LAS u32x4*)(tile + r8 * 128 + c8 * 16);
                *(u32x4*)(HLrow + (size_t)(8 * gi) * D) = row; } }
    }
#undef LOADU
    if (!PASSB) {
#pragma unroll
        for (int nb = 0; nb < 2; ++nb) { float* sm = (float*)(a.ws + WS_SUMM) + ((size_t)((b * 2 + DIR) * NQ + q) * 2) * 1024 + h * 64 + nb * 32 + l31;
            if (lh == 0) { sm[0] = AT[nb]; sm[1024] = s[nb]; } }
    }
    asm volatile("s_waitcnt lgkmcnt(0)" ::: "memory"); __builtin_amdgcn_wave_barrier();
}
template <bool PASSB>
__device__ __forceinline__ void scan_task(const Args& a, LAS unsigned char* lds, int l, int item, int wave, int lane) {
    int b, chunk, h, seqbase, L, q;
    if (item < NLAT) { b = item / (NCL * 16); const int rem = item % (NCL * 16); chunk = rem >> 4; h = rem & 15; seqbase = b * SEQ; L = SEQ; q = NCC + chunk; }
    else { const int it = item - NLAT; b = it / (NCC * 16); const int rem = it % (NCC * 16); chunk = rem >> 4; h = rem & 15; seqbase = ML + b * CTX; L = CTX; q = chunk; }
    LAS unsigned char* wl = lds + wave * SCW_WAVE; LAS float* cwl = (LAS float*)(wl + 16384);
    { const float* cw = a.in[I_CONVW] + (size_t)l * 4 * D + h * 64;
#pragma unroll
      for (int j = 0; j < 4; ++j) cwl[j * 64 + lane] = cw[j * D + lane];
      cwl[256 + lane] = a.in[I_CONVB][l * D + h * 64 + lane]; }
    unsigned st[NSUB][16];
#pragma unroll
    for (int d = 0; d < NSUB; ++d)
#pragma unroll
        for (int i = 0; i < 16; ++i) st[d][i] = 0u;
    scan_sweep<PASSB, 0>(a, wl, l, b, q, h, seqbase, L, chunk * TCH, lane, st);
    scan_sweep<PASSB, 1>(a, wl, l, b, q, h, seqbase, L, chunk * TCH, lane, st);
}
__device__ __forceinline__ void carry_phase(const Args& a) {
    const float* sm = (const float*)(a.ws + WS_SUMM); float* cr = (float*)(a.ws + WS_CARRY);
    const int tid = opaque_tid();
    for (int idx = blockIdx.x * 64 + tid; tid < 64 && idx < NB * 2 * 1024; idx += gridDim.x * 64) {
        const int chn = idx & 1023, bd = idx >> 10, dir = bd & 1;
        const float* s0 = sm + (size_t)bd * NQ * 2048 + chn; float* c0 = cr + (size_t)bd * NQ * 1024 + chn;
        float hs = 0.f;
#pragma unroll 2
        for (int k = 0; k < NQ; ++k) { int q;
            if (dir == 0) q = k; else q = (k < NCC) ? NCC - 1 - k : (NQ - 1 - (k - NCC));
            c0[(size_t)q * 1024] = hs; hs = s0[(size_t)q * 2048] * hs + s0[(size_t)q * 2048 + 1024]; }
    }
}
constexpr int PL_PF = 0  , PL_MB = 40960  , PL_MROW = 272;
__device__ __forceinline__ void pool_item(const Args& a, LAS unsigned char* lds, int l, int item) {
    const int tid = opaque_tid(), lane = tid & 63, wave = __builtin_amdgcn_readfirstlane(tid >> 6);
    int g, R0, L, t0;
    if (item < 1024) { g = item & 3; R0 = (item >> 2) * 64; L = 64; t0 = 0; }
    else { const int it = item - 1024; g = it & 3; const int blk = (it >> 2) & 3, b = it >> 4; R0 = ML + b * CTX; L = CTX; t0 = blk * 64; }
    const bf16* P = (const bf16*)(a.ws + WS_P); LAS float* pf = (LAS float*)(lds + PL_PF);
    { u32x4 v[3];
#pragma unroll
      for (int i = 0; i < 3; ++i) { const int idx = min(tid + 512 * i, 1279), row = idx >> 4, c8 = (idx & 15) * 8, tt = t0 - 8 + row, tc = min(max(tt, 0), L - 1);
          v[i] = *(const u32x4*)(P + (size_t)(R0 + tc) * D_POOL + g * 128 + c8);
          const bool ok = (tt == tc); v[i].x = ok ? v[i].x : 0u; v[i].y = ok ? v[i].y : 0u; v[i].z = ok ? v[i].z : 0u; v[i].w = ok ? v[i].w : 0u; }
#pragma unroll
      for (int i = 0; i < 3; ++i) { const int idx = tid + 512 * i, row = idx >> 4, c8 = (idx & 15) * 8;
          if (idx < 1280) { *(LAS f32x4*)(pf + row * 128 + c8) = (f32x4){bf_lo(v[i].x), bf_hi(v[i].x), bf_lo(v[i].y), bf_hi(v[i].y)}; *(LAS f32x4*)(pf + row * 128 + c8 + 4) = (f32x4){bf_lo(v[i].z), bf_hi(v[i].z), bf_lo(v[i].w), bf_hi(v[i].w)}; } } }
    __syncthreads();
    { const int c = tid & 127, tq = tid >> 7, hw = 1 << g;
      const LAS float* pc = pf + c; const int tb = tq * 16; float s = 0.f;
#pragma unroll
      for (int u = 0; u < 16; ++u) { const int r = min(tb + 8 - hw + u, tb + 8 + hw - 1); const float v = pc[r * 128]; s += (u < 2 * hw) ? v : 0.f; }
#pragma unroll
      for (int k = 0; k < 16; ++k) { const int t = tb + k, tt = t0 + t; const int cnt = min(tt + hw, L) - max(tt - hw, 0);
          const float mval = s * __builtin_amdgcn_rcpf((float)cnt) - pc[(t + 8) * 128];
          *(LAS unsigned short*)(lds + PL_MB + t * PL_MROW + c * 2) = (unsigned short)cvt_pk_bf16(mval, 0.f);
          if (k < 15) s += pc[(t + 8 + hw) * 128] - pc[(t + 8 - hw) * 128]; } }
    __syncthreads();
    { const int mblk = wave & 1, nblk = wave >> 1, l31 = lane & 31, lh = lane >> 5, e = nblk * 32 + l31;
      const bf16* pw = (const bf16*)(a.ws + WS_PW) + ((size_t)(l * 4 + g) * 128 + e) * 128 + lh * 8;
      f32x16 acc;
#pragma unroll
      for (int i = 0; i < 16; ++i) acc[i] = 0.f;
#pragma unroll
      for (int ks = 0; ks < 8; ++ks) { const bf16x8 af = *(const LAS bf16x8*)(lds + PL_MB + (mblk * 32 + l31) * PL_MROW + (ks * 16 + lh * 8) * 2); const bf16x8 bw = *(const bf16x8*)(pw + ks * 16);
          acc = __builtin_amdgcn_mfma_f32_32x32x16_bf16(af, bw, acc, 0, 0, 0); }
      const float scl = a.in[I_POOLS][l * D_POOL + g * 128 + e];
      LAS unsigned short* ot = (LAS unsigned short*)(lds + PL_PF);
#pragma unroll
      for (int reg = 0; reg < 16; ++reg) { const int t = mblk * 32 + (reg & 3) + 8 * (reg >> 2) + 4 * lh; ot[t * 128 + e] = (unsigned short)cvt_pk_bf16(acc[reg] * scl, 0.f); } }
    __syncthreads();
    { bf16* PM = (bf16*)(a.ws + WS_PM) + (size_t)(R0 + t0) * D_POOL + g * 128;
#pragma unroll
      for (int i = 0; i < 2; ++i) { const int idx = tid + 512 * i, row = idx >> 4, c16 = idx & 15;
          *(u32x4*)(PM + (size_t)row * D_POOL + c16 * 8) = *(const LAS u32x4*)(lds + PL_PF + row * 256 + c16 * 16); } }
    __syncthreads();
}
#define XB_TMO      128
#define XB_XCNT(j)  (256  + 64 * (j))
#define XB_XSUB(j)  (1280 + 64 * (j))
#define XB_XGEN(j)  (2304 + 64 * (j))
#define XB_TOP      3328
#define XB_TOPGEN   3392
#define XCD_BAR_WORDS 3456
#define XB_SPIN_CAP (1u << 18)

__device__ __forceinline__ unsigned xb_ld(unsigned* p)              { return __hip_atomic_load(p, __ATOMIC_RELAXED, __HIP_MEMORY_SCOPE_AGENT); }
__device__ __forceinline__ unsigned xb_add(unsigned* p, unsigned v) { return __hip_atomic_fetch_add(p, v, __ATOMIC_RELAXED, __HIP_MEMORY_SCOPE_AGENT); }
__device__ __forceinline__ unsigned xb_xcc_id() { return (unsigned)__builtin_amdgcn_s_getreg((3 << 11) | 20) & 0xFu; }
#define XB_SPIN(cond, bar) do { unsigned _sp = 0; while (cond) { __builtin_amdgcn_s_sleep(1); \
    if ((++_sp & 255u) == 0u) { if (xb_ld(&(bar)[XB_TMO])) break; if (_sp > XB_SPIN_CAP) { atomicAdd(&(bar)[XB_TMO], 1u); break; } } } } while (0)

struct XcdBarrier {
    unsigned* bar; unsigned x;
    volatile LAS unsigned* st;
};

__device__ __forceinline__ XcdBarrier xcd_barrier_post(unsigned* bar, volatile LAS unsigned* st) {
    XcdBarrier b; b.bar = bar; b.x = xb_xcc_id(); b.st = st;
    if (threadIdx.x == 0) (void)xb_add(&bar[XB_XCNT(b.x)], 1u);
    return b;
}
__device__ __forceinline__ void xcd_barrier_complete(unsigned* bar, unsigned x, unsigned& nloc, unsigned& nx) {
    const unsigned G = gridDim.x * gridDim.y * gridDim.z;
    unsigned sum, cnt, mine, sp = 0u;
    for (;;) {
        sum = 0u; cnt = 0u; mine = 0u;
#pragma unroll
        for (unsigned j = 0; j < 16; ++j) { const unsigned c = xb_ld(&bar[XB_XCNT(j)]); sum += c; cnt += (c > 0u) ? 1u : 0u; mine = (j == x) ? c : mine; }
        if (sum == G) break;
        __builtin_amdgcn_s_sleep(1);
        if ((++sp & 255u) == 0u) { if (xb_ld(&bar[XB_TMO])) break; if (sp > XB_SPIN_CAP) { atomicAdd(&bar[XB_TMO], 1u); break; } }
    }
    nloc = mine > 0u ? mine : 1u; nx = cnt > 0u ? cnt : 1u;
}

__device__ __forceinline__ void xcd_barrier(const XcdBarrier& b) {
    asm volatile("s_waitcnt vmcnt(0)" ::: "memory");
    __syncthreads();
    if (threadIdx.x == 0) {
        unsigned* bar = b.bar;
        __builtin_amdgcn_s_waitcnt(0);
        unsigned nloc = b.st[0], nx = b.st[1];
        if (nloc == 0u) { xcd_barrier_complete(bar, b.x, nloc, nx); b.st[0] = nloc; b.st[1] = nx; }
        const unsigned old = xb_add(&bar[XB_XSUB(b.x)], 1u);
        const unsigned gen = old / nloc;
        if (old + 1u == (gen + 1u) * nloc) {
            __builtin_amdgcn_fence(__ATOMIC_RELEASE, "agent");
            asm volatile("s_waitcnt vmcnt(0)" ::: "memory");
            const unsigned og = xb_add(&bar[XB_TOP], 1u);
            const unsigned tg = og / nx;
            if (og + 1u == (tg + 1u) * nx) xb_add(&bar[XB_TOPGEN], 1u);
            else XB_SPIN(xb_ld(&bar[XB_TOPGEN]) == tg, bar);
            __builtin_amdgcn_fence(__ATOMIC_ACQUIRE, "agent");
            xb_add(&bar[XB_XGEN(b.x)], 1u);
            asm volatile("s_waitcnt vmcnt(0)" ::: "memory");
        } else {
            XB_SPIN(xb_ld(&bar[XB_XGEN(b.x)]) == gen, bar);
            __builtin_amdgcn_fence(__ATOMIC_ACQUIRE, "agent");
            asm volatile("s_waitcnt vmcnt(0)" ::: "memory");
        }
    }
    __syncthreads();
}

constexpr int NPHASE = 22;
__global__ void __launch_bounds__(512, 2) mk_fwd(Args a) {
    extern __shared__ __attribute__((aligned(16))) unsigned char lds_raw[];
    LAS unsigned char* lds = (LAS unsigned char*)lds_raw;
    cg::grid_group grid = cg::this_grid();
    volatile LAS unsigned* MISC = (volatile LAS unsigned*)(lds + MISC_OFF);
    if (threadIdx.x < 64) MISC[threadIdx.x] = 0u;
    __syncthreads();
    XcdBarrier xbar; xbar.bar = (unsigned*)(a.ws + WS_BAR); xbar.x = 0; xbar.st = MISC + 8;
    if (a.hi - a.lo > 1) xbar = xcd_barrier_post((unsigned*)(a.ws + WS_BAR), MISC + 8);
    const int G = gridDim.x, bx = blockIdx.x, NGW = G * 8;
#define WL() const int tid_ = opaque_tid(), lane = tid_ & 63, wave = __builtin_amdgcn_readfirstlane(tid_ >> 6), gw = bx * 8 + wave
    const int lo = a.lo, hi = a.hi;
    unsigned char* ws = a.ws;
    float* MOD = (float*)(ws + WS_MOD); float* XC = (float*)(ws + WS_XC);
    bf16* Hb = (bf16*)(ws + WS_H); bf16* Ub = (bf16*)(ws + WS_U); bf16* Gb = (bf16*)(ws + WS_G); bf16* Pb = (bf16*)(ws + WS_P); bf16* GTb = (bf16*)(ws + WS_GT); bf16* PMb = (bf16*)(ws + WS_PM); bf16* Fb = (bf16*)(ws + WS_F);
#ifndef PH_MASK
#define PH_MASK 0xfff
#endif
#define IN(k) (lo <= (k) && (k) < hi)
#define ON(b) ((PH_MASK >> (b)) & 1)
#ifndef REP_MASK
#define REP_MASK 0
#endif
#define REPS(b) for (int rep_ = 0; rep_ < 1 + ((REP_MASK >> (b)) & 1); ++rep_)
#ifndef SYNC_REP
#define SYNC_REP 1
#endif
#define SEAM(k) do { if (IN(k) && IN((k) + 1)) for (int sr_ = 0; sr_ < SYNC_REP; ++sr_) { if (a.hi < 0) grid.sync(); xcd_barrier(xbar); } } while (0)
    if (ON(0) && IN(0)) REPS(0) {
        for (int it = bx; it < 192; it += G) mod_item(a, lds, it);
        WL();
        convert_small(a, lds, gw, NGW, wave, lane);
        convert_big(a, lds, 0, gw, NGW, wave, lane);
    }
    SEAM(0);
#pragma unroll 1
    for (int l = 0; l < DEPTH; ++l) {
        const int pb = 1 + 10 * l; const bool last = (l == DEPTH - 1);
        const float* modl = MOD + (size_t)l * 5 * MODW;
        const float* xsrcL = l == 0 ? a.in[I_X] : a.out; const float* xsrcC = l == 0 ? a.in[I_CTX] : XC;
        const int Mrest = last ? ML : MT;
        if (ON(1) && IN(pb + 0)) REPS(1) {
            WL();
            if (l > 0) convert_big(a, lds, l, gw, NGW, wave, lane);
            norm_rows(xsrcL, xsrcC, Hb, a.in[I_N1G] + l * D, modl, 0, 1, MT, gw, NGW, lane, l > 0 ? (const float*)(ws + WS_SLAB5) : nullptr, MOD + 4 * MODW + 5 * D  , nullptr);
        }
        SEAM(pb + 0);
        if (ON(2) && IN(pb + 1)) REPS(2) {
            pg8::Gemm g{Hb, (const bf16*)(ws + WS_WIN), MT, D_IN, D, D}; pg8::StaticOrder S; S.init(MT, D_IN, G, bx);
            pg8::EpiSplit E{Ub, Gb, Pb, GTb};
            pg8::gemm_phase<pg8::EpiSplit, pg8::StaticOrder, true, true>(lds, g, S, E);
        }
        SEAM(pb + 1);
        if (ON(3) && IN(pb + 2)) REPS(3) {
            const int npool = last ? 1024 : 1088;
            { WL(); const int nit = NLAT + NCTX, nfull = (nit / NGW) * NGW;
              for (int r = 0;; ++r) { const int it = (r * NGW < nfull) ? r * NGW + gw : nfull + wave * G + bx; if (r * NGW > nfull || it >= nit) break;
                  scan_task<false>(a, lds, l, it, wave, lane); } }
            __syncthreads();
            for (int it = bx; it < npool; it += G) pool_item(a, lds, l, it);
        }
        SEAM(pb + 2);
        if (ON(4) && IN(pb + 3)) REPS(4) carry_phase(a);
        SEAM(pb + 3);
        if (ON(5) && IN(pb + 4)) REPS(5) { WL(); const int nit = last ? NLAT : NLAT + NCTX, nfull = (nit / NGW) * NGW;
            for (int r = 0;; ++r) { const int it = (r * NGW < nfull) ? r * NGW + gw : nfull + wave * G + bx; if (r * NGW > nfull || it >= nit) break;
                scan_task<true>(a, lds, l, it, wave, lane); } }
        SEAM(pb + 4);
        if (ON(6) && IN(pb + 5)) REPS(6) {
            { pg8::Gemm g{PMb, (const bf16*)(ws + WS_WPO), Mrest, D, D_POOL, D_POOL}; pg8::StaticOrder S; S.init(Mrest, D, G, bx);
              pg8::EpiGate<0> E{Ub, GTb}; pg8::gemm_phase<pg8::EpiGate<0>, pg8::StaticOrder, true, true>(lds, g, S, E); }
            { pg8::Gemm g{Hb, (const bf16*)(ws + WS_WLO), Mrest, D, D, D}; pg8::StaticOrder S; S.init(Mrest, D, G, bx);
              pg8::EpiGate<1> E{Ub, GTb}; pg8::gemm_phase<pg8::EpiGate<1>, pg8::StaticOrder, true, true>(lds, g, S, E); }
        }
        SEAM(pb + 5);
        if (ON(7) && IN(pb + 6)) {
            { pg8::Gemm g{Ub, (const bf16*)(ws + WS_WO), ML, D, D, D}; pg8::StaticOrder S; S.init(ML, D, G, bx);
              pg8::EpiRes E{xsrcL, xsrcC, a.out, XC, modl + 2 * D};
              pg8::gemm_phase<pg8::EpiRes, pg8::StaticOrder, true, true>(lds, g, S, E); }
            if (!last) {
              int ksl = 256; asm volatile("" : "+s"(ksl));
              pg8::Gemm g{Ub + (size_t)ML * D, (const bf16*)(ws + WS_WO), MC, D, ksl, D}; pg8::SplitOrder S; S.init(MC, D, D, ksl, G, bx);
              pg8::EpiSlab E{(float*)(ws + WS_SLAB3)};
              pg8::gemm_phase<pg8::EpiSlab, pg8::SplitOrder, true, true>(lds, g, S, E); }
        }
        SEAM(pb + 6);
        if (ON(8) && IN(pb + 7)) REPS(8) { WL(); norm_rows(a.out, l == 0 ? a.in[I_CTX] : XC, Hb, a.in[I_N2G] + l * D, modl, 3, 4, Mrest, gw, NGW, lane, l == 0 ? (const float*)(ws + WS_SLAB3) : nullptr, modl + 4 * MODW + 2 * D  , XC); }
        SEAM(pb + 7);
        if (ON(9) && IN(pb + 8)) REPS(9) {
            pg8::Gemm g{Hb, (const bf16*)(ws + WS_W1), Mrest, D_FF, D, D}; pg8::StaticOrder S; S.init(Mrest, D_FF, G, bx);
            pg8::EpiSqRelu E{Fb, D_FF};
            pg8::gemm_phase<pg8::EpiSqRelu, pg8::StaticOrder, true, true>(lds, g, S, E);
        }
        SEAM(pb + 8);
        if (ON(10) && IN(pb + 9)) {
            { pg8::Gemm g{Fb, (const bf16*)(ws + WS_W2), ML, D, D_FF, D_FF}; pg8::StaticOrder S; S.init(ML, D, G, bx);
              pg8::EpiRes E{a.out, XC, a.out, XC, modl + 5 * D};
              pg8::gemm_phase<pg8::EpiRes, pg8::StaticOrder, true, true>(lds, g, S, E); }
            if (!last) {
              int ksl = 1024; asm volatile("" : "+s"(ksl));
              pg8::Gemm g{Fb + (size_t)ML * D_FF, (const bf16*)(ws + WS_W2), MC, D, ksl, D_FF}; pg8::SplitOrder S; S.init(MC, D, D_FF, ksl, G, bx);
              pg8::EpiSlab E{(float*)(ws + WS_SLAB5)};
              pg8::gemm_phase<pg8::EpiSlab, pg8::SplitOrder, true, true>(lds, g, S, E); }
        }
        SEAM(pb + 9);
    }
    if (ON(11) && IN(21)) { WL(); final_rows(a.out, a.in[I_FG], gw, NGW, lane); }
#undef IN
#undef SEAM
}

extern "C" void kernel_launch(void* const* d_in, const int* in_sizes, int n_in, void* d_out, int out_size, void* d_ws, size_t ws_size, hipStream_t stream) {
    static int grid = 0;
    if (grid == 0) {
        if (n_in != 24 || out_size != ML * D || ws_size < WS_END) { fprintf(stderr, "kernel_launch: unexpected shapes (n_in %d, out %d, ws %zu)\n", n_in, out_size, ws_size); grid = -1; return; }
        int dev = 0, cus = 0, per_cu = 0;
        if (hipGetDevice(&dev) != hipSuccess || hipDeviceGetAttribute(&cus, hipDeviceAttributeMultiprocessorCount, dev) != hipSuccess) { grid = -1; return; }
        if (hipFuncSetAttribute((const void*)mk_fwd, hipFuncAttributeMaxDynamicSharedMemorySize, LDS_BYTES) != hipSuccess) { fprintf(stderr, "kernel_launch: hipFuncSetAttribute failed\n"); grid = -1; return; }
        if (hipOccupancyMaxActiveBlocksPerMultiprocessor(&per_cu, (const void*)mk_fwd, 512, LDS_BYTES) != hipSuccess || per_cu < 1) { fprintf(stderr, "kernel_launch: occupancy query says %d\n", per_cu); per_cu = 1; }
        (void)hipGetLastError();
        grid = cus;
    }
    if (grid < 0) return;
    Args a{};
    for (int i = 0; i < 24; ++i) a.in[i] = (const float*)d_in[i];
    a.out = (float*)d_out; a.ws = (unsigned char*)d_ws;
#if MK_PER_PHASE
    for (int p = 0; p < NPHASE; ++p) { a.lo = p; a.hi = p + 1; hipLaunchKernelGGL(mk_fwd, dim3(grid), dim3(512), LDS_BYTES, stream, a); }
#else
    a.lo = 0; a.hi = NPHASE;
    if (hipMemsetAsync((char*)d_ws + WS_BAR, 0, 16384, stream) != hipSuccess) { fprintf(stderr, "kernel_launch: memset of the barrier words failed\n"); return; }
    void* args[] = {&a};
    hipError_t e = hipLaunchCooperativeKernel((const void*)mk_fwd, dim3(grid), dim3(512), args, LDS_BYTES, stream);
    if (e != hipSuccess) fprintf(stderr, "kernel_launch: cooperative launch failed: %s (grid %d)\n", hipGetErrorString(e), grid);
#endif
}
```

```cpp
#include <hip/hip_runtime.h>
#include <hip/hip_cooperative_groups.h>
#include <cstdio>
#include <cstdint>
namespace cg = cooperative_groups;
#ifndef MK_PER_PHASE
#define MK_PER_PHASE 0
#endif
__device__ __forceinline__ int opaque_tid() { int t = threadIdx.x; asm volatile("" : "+v"(t) : : "memory"); return t; }
namespace pg8 {
#define PG8_LAS __attribute__((address_space(3)))
typedef unsigned short bf16_t;
typedef short bf16x8 __attribute__((ext_vector_type(8)));
typedef float f32x4 __attribute__((ext_vector_type(4)));
typedef unsigned u32x4 __attribute__((ext_vector_type(4)));
constexpr int BM = 256, BK = 64, HALF = 128, HTB = HALF * BK * 2  , STAGE_BYTES = 8 * HTB, NXCD = 8, WGM = 8;

__host__ __device__ __forceinline__ int lds_byte(int r, int c) { const int st = (r >> 4) * 2 + (c >> 5), rr = r & 15, cc = c & 31, ob = rr * 64 + cc * 2; return st * 1024 + (ob ^ (((ob >> 9) & 1) << 5)); }
__host__ __device__ __forceinline__ void stage_rc(int b, int& R, int& C) { const int st = b / 1024, sb = b % 1024, swz = sb ^ (((sb >> 9) & 1) << 5); R = (st >> 1) * 16 + swz / 64; C = (st & 1) * 32 + (swz % 64) / 2; }
__host__ __device__ __forceinline__ int perm32(int rho) { const int n = rho >> 4, i = rho & 15; return 8 * (i >> 2) + 4 * n + (i & 3); }

struct Unit { int pm, pn, kb, ks; };
struct Gemm { const bf16_t* A; const bf16_t* Bt; int M, N, K, ld; };

struct StaticOrder {
    int nM, nN, nwg, G, c;
    __host__ __device__ void init(int M, int N, int G_, int c_) { nM = M / BM; nN = N / BM; nwg = nM * nN; G = G_; c = c_; }
    __host__ __device__ bool next(int i, Unit& u) const {
        const long L = (long)i * G + c; if (L >= nwg) return false;
        int wgid = (int)L; { const int q = nwg / NXCD, r = nwg % NXCD, xcd = wgid % NXCD, off = wgid / NXCD; wgid = (xcd < r ? xcd * (q + 1) : r * (q + 1) + (xcd - r) * q) + off; }
        const int nig = WGM * nN, gid = wgid / nig, fm = gid * WGM, gsz = (nM - fm) < WGM ? (nM - fm) : WGM;
        u.pm = fm + ((wgid % nig) % gsz); u.pn = (wgid % nig) / gsz; u.kb = 0; u.ks = 0; return true;
    }
    __device__ __forceinline__ void a_ready(const Unit&) const {}
    __device__ __forceinline__ void done(const Unit&) const {}
};
struct SplitOrder {
    int nN, nS, ksl, ntot, G, c;
    __host__ __device__ void init(int M, int N, int Kfull, int ksl_, int G_, int c_) { nN = N / BM; nS = Kfull / ksl_; ksl = ksl_; ntot = (M / BM) * nN * nS; G = G_; c = c_; }
    __host__ __device__ bool next(int i, Unit& u) const { const int j = i * G + c; if (j >= ntot) return false; const int ks = j % nS, t = j / nS; u.pn = t % nN; u.pm = t / nN; u.kb = ks * ksl; u.ks = ks; return true; }
    __device__ __forceinline__ void a_ready(const Unit&) const {}
    __device__ __forceinline__ void done(const Unit&) const {}
};
__device__ __forceinline__ unsigned cvt_pk_bf16(float lo, float hi) { unsigned r; asm volatile("v_cvt_pk_bf16_f32 %0, %1, %2" : "=v"(r) : "v"(lo), "v"(hi)); return r; }
__device__ __forceinline__ float bf_lo(unsigned w) { return __uint_as_float(w << 16); }
__device__ __forceinline__ float bf_hi(unsigned w) { return __uint_as_float(w & 0xffff0000u); }
__device__ __forceinline__ float sigm(float x) { return __builtin_amdgcn_rcpf(1.0f + __expf(-x)); }

struct EpiSplit {
    static constexpr bool PERM = true, AFTER_DRAIN = false;
    bf16_t *U, *G, *P, *GT;
    __device__ __forceinline__ void operator()(const f32x4 (&acc)[2][2][4][2], const Unit& u, int wr, int wc, int fr, int fq) const {
        bf16_t* base; int ldc, colt;
        if (u.pn < 4) { base = U; ldc = 1024; colt = u.pn * 256; }
        else if (u.pn < 8) { base = G; ldc = 1024; colt = (u.pn - 4) * 256; }
        else if (u.pn < 10) { base = P; ldc = 512; colt = (u.pn - 8) * 256; }
        else { base = GT; ldc = 2048; colt = (u.pn - 10) * 256; }
        const int row0 = u.pm * BM + wr * 64 + fr, col0 = colt + wc * 32 + 8 * fq;
#pragma unroll
        for (int ai = 0; ai < 2; ++ai)
#pragma unroll
            for (int m = 0; m < 4; ++m) { bf16_t* rowp = base + (size_t)(row0 + ai * HALF + m * 16) * ldc + col0;
#pragma unroll
                for (int bj = 0; bj < 2; ++bj) { const f32x4 v0 = acc[ai][bj][m][0], v1 = acc[ai][bj][m][1];
                    u32x4 w; w.x = cvt_pk_bf16(v0[0], v0[1]); w.y = cvt_pk_bf16(v0[2], v0[3]); w.z = cvt_pk_bf16(v1[0], v1[1]); w.w = cvt_pk_bf16(v1[2], v1[3]);
                    *(u32x4*)(rowp + bj * HALF) = w; } }
    }
};
template <int MODE> struct EpiGate {
    static constexpr bool PERM = true, AFTER_DRAIN = false;
    bf16_t* Z; const bf16_t* GT;
    __device__ __forceinline__ void operator()(const f32x4 (&acc)[2][2][4][2], const Unit& u, int wr, int wc, int fr, int fq) const {
        const int row0 = u.pm * BM + wr * 64 + fr, col0 = u.pn * BM + wc * 32 + 8 * fq;
#pragma unroll
        for (int ai = 0; ai < 2; ++ai)
#pragma unroll
            for (int m = 0; m < 4; ++m) { const size_t row = (size_t)(row0 + ai * HALF + m * 16);
#pragma unroll
                for (int bj = 0; bj < 2; ++bj) { const int col = col0 + bj * HALF;
                    const u32x4 gt = *(const u32x4*)(GT + row * 2048 + (MODE == 0 ? 1024 : 0) + col);
                    f32x4 v0 = acc[ai][bj][m][0], v1 = acc[ai][bj][m][1];
                    v0[0] *= sigm(bf_lo(gt.x)); v0[1] *= sigm(bf_hi(gt.x)); v0[2] *= sigm(bf_lo(gt.y)); v0[3] *= sigm(bf_hi(gt.y));
                    v1[0] *= sigm(bf_lo(gt.z)); v1[1] *= sigm(bf_hi(gt.z)); v1[2] *= sigm(bf_lo(gt.w)); v1[3] *= sigm(bf_hi(gt.w));
                    u32x4* zp = (u32x4*)(Z + row * 1024 + col);
                    if (MODE == 1) { const u32x4 z = *zp;
                        v0[0] += bf_lo(z.x); v0[1] += bf_hi(z.x); v0[2] += bf_lo(z.y); v0[3] += bf_hi(z.y);
                        v1[0] += bf_lo(z.z); v1[1] += bf_hi(z.z); v1[2] += bf_lo(z.w); v1[3] += bf_hi(z.w); }
                    u32x4 w; w.x = cvt_pk_bf16(v0[0], v0[1]); w.y = cvt_pk_bf16(v0[2], v0[3]); w.z = cvt_pk_bf16(v1[0], v1[1]); w.w = cvt_pk_bf16(v1[2], v1[3]);
                    *zp = w; }
                asm volatile("" ::: "memory"); }
    }
};
struct EpiRes {
    static constexpr bool PERM = false, AFTER_DRAIN = false;
    const float* srcL; const float* srcC; float* dstL; float* dstC; const float* gate;
    __device__ __forceinline__ void operator()(const f32x4 (&acc)[2][2][4][2], const Unit& u, int wr, int wc, int fr, int fq) const {
        const bool lat = u.pm < 64;
        const size_t tb = (size_t)(lat ? u.pm : u.pm - 64) * 256 * 1024;
        const float* src = (lat ? srcL : srcC) + tb; float* dst = (lat ? dstL : dstC) + tb;
        const float* gv = gate + (lat ? (u.pm >> 4) : 4) * 6144;
        const int rl0 = wr * 64 + fr, col0 = u.pn * BM + wc * 32 + 4 * fq;
        f32x4 g[2][2];
#pragma unroll
        for (int bj = 0; bj < 2; ++bj)
#pragma unroll
            for (int n = 0; n < 2; ++n) g[bj][n] = *(const f32x4*)(gv + col0 + bj * HALF + n * 16);
#pragma unroll
        for (int ai = 0; ai < 2; ++ai)
#pragma unroll
            for (int m = 0; m < 4; ++m) { const size_t off = (size_t)(rl0 + ai * HALF + m * 16) * 1024 + col0;
#pragma unroll
                for (int bj = 0; bj < 2; ++bj)
#pragma unroll
                    for (int n = 0; n < 2; ++n) { const f32x4 s = *(const f32x4*)(src + off + bj * HALF + n * 16);
                        *(f32x4*)(dst + off + bj * HALF + n * 16) = s + g[bj][n] * acc[ai][bj][m][n]; }
                if (m == 3) asm volatile("" ::: "memory"); }
    }
};
struct EpiSqRelu {
    static constexpr bool PERM = true, AFTER_DRAIN = false;
    bf16_t* F; int ldc;
    __device__ __forceinline__ void operator()(const f32x4 (&acc)[2][2][4][2], const Unit& u, int wr, int wc, int fr, int fq) const {
        const int row0 = u.pm * BM + wr * 64 + fr, col0 = u.pn * BM + wc * 32 + 8 * fq;
#pragma unroll
        for (int ai = 0; ai < 2; ++ai)
#pragma unroll
            for (int m = 0; m < 4; ++m) { bf16_t* rowp = F + (size_t)(row0 + ai * HALF + m * 16) * ldc + col0;
#pragma unroll
                for (int bj = 0; bj < 2; ++bj) { f32x4 v0 = acc[ai][bj][m][0], v1 = acc[ai][bj][m][1];
#pragma unroll
                    for (int j = 0; j < 4; ++j) { const float a0 = fmaxf(v0[j], 0.f), a1 = fmaxf(v1[j], 0.f); v0[j] = a0 * a0; v1[j] = a1 * a1; }
                    u32x4 w; w.x = cvt_pk_bf16(v0[0], v0[1]); w.y = cvt_pk_bf16(v0[2], v0[3]); w.z = cvt_pk_bf16(v1[0], v1[1]); w.w = cvt_pk_bf16(v1[2], v1[3]);
                    *(u32x4*)(rowp + bj * HALF) = w; } }
    }
};

struct EpiSlab {
    static constexpr bool PERM = false, AFTER_DRAIN = false;
    float* slab;
    __device__ __forceinline__ void operator()(const f32x4 (&acc)[2][2][4][2], const Unit& u, int wr, int wc, int fr, int fq) const {
        float* p0 = slab + ((size_t)u.ks * 1024 + u.pm * BM + wr * 64 + fr) * 1024 + u.pn * BM + wc * 32 + 4 * fq;
#pragma unroll
        for (int ai = 0; ai < 2; ++ai)
#pragma unroll
            for (int m = 0; m < 4; ++m) { float* rowp = p0 + (size_t)(ai * HALF + m * 16) * 1024;
#pragma unroll
                for (int bj = 0; bj < 2; ++bj)
#pragma unroll
                    for (int n = 0; n < 2; ++n) *(f32x4*)(rowp + bj * HALF + n * 16) = acc[ai][bj][m][n]; }
    }
};

template <class Epi, class Sched, bool ALIGN_EPI = false, bool SP2 = false>
__device__ __forceinline__ void gemm_phase(PG8_LAS unsigned char* lds, const Gemm g, const Sched& S, const Epi& E) {
    const int tid = opaque_tid(), wid = __builtin_amdgcn_readfirstlane(tid >> 6), lane = tid & 63, wr = wid >> 2, wc = wid & 3, fr = lane & 15, fq = lane >> 4;
    const int K = g.ld, nt = g.K / BK;
    unsigned voffA[2], voffB[2];
#pragma unroll
    for (int i = 0; i < 2; ++i) { int R, C; stage_rc(tid * 16 + i * 8192, R, C); const int Rb = Epi::PERM ? ((R & ~31) + perm32(R & 31)) : R;
        voffA[i] = (unsigned)(R * K + C) * 2u; voffB[i] = (unsigned)(Rb * K + C) * 2u; }
    const size_t kstep = (size_t)(BK * 2);
    const size_t hstep = (size_t)HALF * K * 2;
    const size_t tstep = 2 * hstep;
    const unsigned ldsw = (unsigned)wid * 1024u;
    const int aoff = lds_byte(wr * 64 + fr, fq * 8), boff = lds_byte(wc * 32 + fr, fq * 8);
#define PG8_SA(b, h) (((b) * 2 + (h)) * HTB)
#define PG8_SB(b, h) ((4 + (b) * 2 + (h)) * HTB)
#define PG8_STAGE(bufoff, gbase, voff) do { _Pragma("unroll") for (int _i = 0; _i < 2; ++_i) \
        __builtin_amdgcn_global_load_lds((const unsigned*)((const char*)(gbase) + (voff)[_i]), (PG8_LAS unsigned*)(lds + (bufoff) + ldsw + _i * 8192), 16, 0, 0); } while (0)
#define PG8_LDA(dst, b, h) do { _Pragma("unroll") for (int m = 0; m < 4; ++m) _Pragma("unroll") for (int k = 0; k < 2; ++k) dst[m][k] = *(const PG8_LAS bf16x8*)(lds + PG8_SA(b, h) + aoff + m * 2048 + k * 1024); } while (0)
#define PG8_LDB(dst, b, h) do { _Pragma("unroll") for (int n = 0; n < 2; ++n) _Pragma("unroll") for (int k = 0; k < 2; ++k) dst[n][k] = *(const PG8_LAS bf16x8*)(lds + PG8_SB(b, h) + boff + n * 2048 + k * 1024); } while (0)
#define PG8_MMA(ai, bj, At, Bt) do { __builtin_amdgcn_s_setprio(1); _Pragma("unroll") for (int m = 0; m < 4; ++m) _Pragma("unroll") for (int n = 0; n < 2; ++n) _Pragma("unroll") for (int k = 0; k < 2; ++k) \
        acc[ai][bj][m][n] = __builtin_amdgcn_mfma_f32_16x16x32_bf16(Bt[n][k], At[m][k], acc[ai][bj][m][n], 0, 0, 0); __builtin_amdgcn_s_setprio(0); } while (0)
#define PG8_WAIT_V(n) asm volatile("s_waitcnt vmcnt(" #n ")" ::: "memory")
#define PG8_WAIT_L(n) asm volatile("s_waitcnt lgkmcnt(" #n ")" ::: "memory")
#define PG8_BAR __builtin_amdgcn_s_barrier()
#define PG8_SCHED __builtin_amdgcn_sched_barrier(0)
    Unit cur, nxt; int ui = 0;
    if (!S.next(0, cur)) return;
    f32x4 acc[2][2][4][2];
#pragma unroll
    for (int a = 0; a < 2; ++a)
#pragma unroll
        for (int b = 0; b < 2; ++b)
#pragma unroll
            for (int m = 0; m < 4; ++m)
#pragma unroll
                for (int n = 0; n < 2; ++n) acc[a][b][m][n] = (f32x4){0.f, 0.f, 0.f, 0.f};
    bf16x8 At[4][2], B0[2][2], B1[2][2];
    const char* cA = (const char*)g.A + (size_t)cur.pm * tstep + (size_t)cur.kb * 2; const char* cB = (const char*)g.Bt + (size_t)cur.pn * tstep + (size_t)cur.kb * 2;
    S.a_ready(cur);
    if constexpr (SP2) {
        PG8_STAGE(PG8_SB(0, 0), cB, voffB); PG8_STAGE(PG8_SB(0, 1), cB + hstep, voffB); PG8_STAGE(PG8_SA(0, 0), cA, voffA); PG8_STAGE(PG8_SA(0, 1), cA + hstep, voffA);
        if (wr == 1) PG8_BAR;
        PG8_WAIT_V(2); PG8_BAR;
        PG8_STAGE(PG8_SB(1, 0), cB + kstep, voffB); PG8_STAGE(PG8_SA(1, 0), cA + kstep, voffA); PG8_STAGE(PG8_SB(1, 1), cB + hstep + kstep, voffB);
        PG8_WAIT_V(6); PG8_BAR;
    } else {
        PG8_STAGE(PG8_SB(0, 0), cB, voffB); PG8_STAGE(PG8_SA(0, 0), cA, voffA); PG8_STAGE(PG8_SB(0, 1), cB + hstep, voffB); PG8_STAGE(PG8_SA(0, 1), cA + hstep, voffA);
        if (wr == 1) PG8_BAR;
        PG8_WAIT_V(4); PG8_BAR;
        PG8_STAGE(PG8_SB(1, 0), cB + kstep, voffB); PG8_STAGE(PG8_SA(1, 0), cA + kstep, voffA); PG8_STAGE(PG8_SB(1, 1), cB + hstep + kstep, voffB);
        PG8_WAIT_V(6); PG8_BAR;
    }
    for (;;) {
        const bool has_next = S.next(ui + 1, nxt);
        const char* nA = has_next ? (const char*)g.A + (size_t)nxt.pm * tstep + (size_t)nxt.kb * 2 : cA; const char* nB = has_next ? (const char*)g.Bt + (size_t)nxt.pn * tstep + (size_t)nxt.kb * 2 : cB;
        for (int t = 0; t < nt; t += 2) {
            const bool last = (t == nt - 2);
            const char* a1 = cA + (size_t)(t + 1) * kstep;
            const char* a2 = last ? nA : cA + (size_t)(t + 2) * kstep; const char* b2 = last ? nB : cB + (size_t)(t + 2) * kstep;
            const char* a3 = a2 + kstep; const char* b3 = b2 + kstep;
            if (last && has_next) S.a_ready(nxt);
            if constexpr (SP2) {
            PG8_LDB(B0, 0, 0); PG8_LDB(B1, 0, 1); PG8_SCHED; PG8_LDA(At, 0, 0); PG8_STAGE(PG8_SA(1, 1), a1 + hstep, voffA);
            PG8_WAIT_V(8); PG8_WAIT_L(0); PG8_BAR; PG8_MMA(0, 0, At, B0); PG8_MMA(0, 1, At, B1); PG8_BAR; PG8_SCHED;
            PG8_LDA(At, 0, 1); PG8_STAGE(PG8_SB(0, 0), b2, voffB); PG8_STAGE(PG8_SB(0, 1), b2 + hstep, voffB); PG8_STAGE(PG8_SA(0, 0), a2, voffA);
            PG8_WAIT_V(8); PG8_WAIT_L(0); PG8_BAR; PG8_MMA(1, 0, At, B0); PG8_MMA(1, 1, At, B1); PG8_BAR; PG8_SCHED;
            PG8_LDB(B0, 1, 0); PG8_LDB(B1, 1, 1); PG8_SCHED; PG8_LDA(At, 1, 0); PG8_STAGE(PG8_SA(0, 1), a2 + hstep, voffA);
            PG8_WAIT_V(8); PG8_WAIT_L(0); PG8_BAR; PG8_MMA(0, 0, At, B0); PG8_MMA(0, 1, At, B1); PG8_BAR; PG8_SCHED;
            PG8_LDA(At, 1, 1); PG8_STAGE(PG8_SB(1, 0), b3, voffB); PG8_STAGE(PG8_SB(1, 1), b3 + hstep, voffB); PG8_STAGE(PG8_SA(1, 0), a3, voffA);
            PG8_WAIT_V(8); PG8_WAIT_L(0); PG8_BAR; PG8_MMA(1, 0, At, B0); PG8_MMA(1, 1, At, B1); PG8_BAR; PG8_SCHED;
            } else {
            PG8_LDB(B0, 0, 0); PG8_SCHED; PG8_LDA(At, 0, 0); PG8_STAGE(PG8_SA(1, 1), a1 + hstep, voffA);
            PG8_WAIT_L(8); PG8_BAR; PG8_WAIT_L(0); PG8_MMA(0, 0, At, B0); PG8_BAR; PG8_SCHED;
            PG8_LDB(B1, 0, 1); PG8_STAGE(PG8_SB(0, 0), b2, voffB);
            PG8_BAR; PG8_WAIT_L(0); PG8_MMA(0, 1, At, B1); PG8_BAR;
            PG8_LDA(At, 0, 1); PG8_STAGE(PG8_SA(0, 0), a2, voffA);
            PG8_BAR; PG8_WAIT_L(0); PG8_MMA(1, 0, At, B0); PG8_BAR; PG8_SCHED;
            PG8_STAGE(PG8_SB(0, 1), b2 + hstep, voffB);
            PG8_WAIT_V(6); PG8_BAR; PG8_MMA(1, 1, At, B1); PG8_BAR;
            PG8_LDB(B0, 1, 0); PG8_SCHED; PG8_LDA(At, 1, 0); PG8_STAGE(PG8_SA(0, 1), a2 + hstep, voffA);
            PG8_WAIT_L(8); PG8_BAR; PG8_WAIT_L(0); PG8_MMA(0, 0, At, B0); PG8_BAR; PG8_SCHED;
            PG8_LDB(B1, 1, 1); PG8_STAGE(PG8_SB(1, 0), b3, voffB);
            PG8_BAR; PG8_WAIT_L(0); PG8_MMA(0, 1, At, B1); PG8_BAR;
            PG8_LDA(At, 1, 1); PG8_STAGE(PG8_SA(1, 0), a3, voffA);
            PG8_BAR; PG8_WAIT_L(0); PG8_MMA(1, 0, At, B0); PG8_BAR; PG8_SCHED;
            PG8_STAGE(PG8_SB(1, 1), b3 + hstep, voffB);
            PG8_WAIT_V(6); PG8_BAR; PG8_MMA(1, 1, At, B1); PG8_BAR;
            }
        }
        if constexpr (ALIGN_EPI) { if (wr == 0) PG8_BAR; }
        if constexpr (!Epi::AFTER_DRAIN) { E(acc, cur, wr, wc, fr, fq); S.done(cur); }
        if (!has_next) break;
#pragma unroll
        for (int a = 0; a < 2; ++a)
#pragma unroll
            for (int b = 0; b < 2; ++b)
#pragma unroll
                for (int m = 0; m < 4; ++m)
#pragma unroll
                    for (int n = 0; n < 2; ++n) acc[a][b][m][n] = (f32x4){0.f, 0.f, 0.f, 0.f};
        cur = nxt; cA = nA; cB = nB; ++ui;
        if constexpr (ALIGN_EPI) { if (wr == 1) PG8_BAR; }
    }
    PG8_WAIT_V(0);
    if constexpr (!ALIGN_EPI) { if (wr == 0) PG8_BAR; }
    PG8_BAR;
    if constexpr (Epi::AFTER_DRAIN) { E.fused(acc, cur, wr, wc, fr, fq, lds, wid, lane); S.done(cur); }
#undef PG8_SA
#undef PG8_SB
#undef PG8_STAGE
#undef PG8_LDA
#undef PG8_LDB
#undef PG8_MMA
#undef PG8_WAIT_V
#undef PG8_WAIT_L
#undef PG8_BAR
#undef PG8_SCHED
}
}
constexpr int D = 1024, NB = 4, SEQ = 4096, CTX = 256, DEPTH = 2;
constexpr int ML = NB * SEQ, MC = NB * CTX, MT = ML + MC;
constexpr int D_IN = 4608, D_POOL = 512, D_FF = 4096, MODW = 6 * D;
constexpr int TCH = 64;
constexpr int NSUB = TCH / 32, NCL = SEQ / TCH, NCC = CTX / TCH, NLAT = NB * NCL * 16, NCTX = NB * NCC * 16;
constexpr int NQ = NCC + NCL;
constexpr float EPS = 1e-6f;
constexpr size_t MiB = 1u << 20;
constexpr size_t WS_MOD = 0;
constexpr size_t WS_BAR = 256 * 1024;
constexpr size_t WS_SUMM = 244 * MiB;
constexpr size_t WS_CARRY = WS_SUMM + (size_t)NB * 2 * NQ * 2 * 1024 * 4;
constexpr size_t WS_XC = 4 * MiB;
constexpr size_t WS_WIN = 8 * MiB, WS_WLO = 17 * MiB, WS_WPO = 19 * MiB, WS_WO = 20 * MiB, WS_W1 = 22 * MiB, WS_W2 = 30 * MiB;
constexpr size_t WS_GW = 38 * MiB;
constexpr size_t WS_PW = 39 * MiB;
constexpr size_t WS_H = 40 * MiB;
constexpr size_t WS_U = 74 * MiB;
constexpr size_t WS_G = 108 * MiB;
constexpr size_t WS_P = 142 * MiB;
constexpr size_t WS_GT = 159 * MiB;
constexpr size_t WS_PM = 227 * MiB;
constexpr size_t WS_SLAB3 = WS_G;
constexpr size_t WS_SLAB5 = 210 * MiB;
constexpr size_t WS_F = WS_U;
constexpr size_t WS_END = 256 * MiB;
static_assert(WS_CARRY + (size_t)NB * 2 * NQ * 1024 * 4 <= 256 * MiB, "ws map (tail)");
static_assert(WS_F + (size_t)MT * D_FF * 2 <= WS_PM && WS_H + (size_t)MT * D * 2 <= WS_U && WS_GT + (size_t)MT * 2048 * 2 <= WS_PM, "ws map");
constexpr int LDS_BYTES = 8 * 19456 + 256, MISC_OFF = 8 * 19456;

#define LAS __attribute__((address_space(3)))
typedef unsigned short bf16;
typedef unsigned u32x4 __attribute__((ext_vector_type(4)));
typedef unsigned u32x2 __attribute__((ext_vector_type(2)));
typedef float f32x4 __attribute__((ext_vector_type(4)));
typedef float f32x16 __attribute__((ext_vector_type(16)));
typedef short bf16x8 __attribute__((ext_vector_type(8)));
using pg8::cvt_pk_bf16; using pg8::bf_lo; using pg8::bf_hi; using pg8::sigm;

struct Args { const float* in[24]; float* out; unsigned char* ws; int lo, hi; };
enum { I_X = 0, I_C, I_CTX, I_CCTX, I_WADA, I_BADA, I_N1G, I_N2G, I_WIN, I_CONVW, I_CONVB, I_WR, I_BR, I_WI, I_BI, I_LAM, I_WLO, I_POOLW, I_POOLS, I_WPO, I_WO, I_W1, I_W2, I_FG };

__device__ __forceinline__ float wave_sum(float v) {
#pragma unroll
    for (int o = 1; o < 64; o <<= 1) v += __shfl_xor(v, o);
    return v;
}
__device__ __forceinline__ float gelu_tanh(float x) { const float z = 0.7978845608f * (x + 0.044715f * x * x * x); const float e = __expf(2.f * z); return 0.5f * x * (2.f - 2.f * __builtin_amdgcn_rcpf(e + 1.f)); }

__device__ __forceinline__ void mod_item(const Args& a, LAS unsigned char* lds, int item) {
    const int tid = opaque_tid(), l = item / 96, cb = item % 96, cq = tid & 15, kg = tid >> 4;
    LAS float* s = (LAS float*)lds;
    LAS float* part = (LAS float*)(lds + 20480);
    const float* c = a.in[I_C]; const float* cc = a.in[I_CCTX];
    for (int i = tid; i < 5120; i += 512) { const int r = i >> 10, k = i & 1023; const float v = r < 4 ? c[r * 1024 + k] : cc[k]; s[i] = v * sigm(v); }
    __syncthreads();
    const float* W = a.in[I_WADA] + (size_t)l * D * MODW + cb * 64 + cq * 4;
    float acc[5][4];
#pragma unroll
    for (int r = 0; r < 5; ++r)
#pragma unroll
        for (int j = 0; j < 4; ++j) acc[r][j] = 0.f;
#pragma unroll 8
    for (int kk = 0; kk < 32; ++kk) { const int k = kg * 32 + kk; const f32x4 w = *(const f32x4*)(W + (size_t)k * MODW);
#pragma unroll
        for (int r = 0; r < 5; ++r) { const float sv = s[r * 1024 + k];
#pragma unroll
            for (int j = 0; j < 4; ++j) acc[r][j] += sv * w[j]; } }
#pragma unroll
    for (int r = 0; r < 5; ++r)
#pragma unroll
        for (int j = 0; j < 4; ++j) part[(kg * 5 + r) * 64 + cq * 4 + j] = acc[r][j];
    __syncthreads();
    if (tid < 320) { const int r = tid >> 6, col = tid & 63; float t = 0.f;
#pragma unroll 8
        for (int g = 0; g < 32; ++g) t += part[(g * 5 + r) * 64 + col];
        ((float*)(a.ws + WS_MOD))[(size_t)(l * 5 + r) * MODW + cb * 64 + col] = t + a.in[I_BADA][l * MODW + cb * 64 + col]; }
    __syncthreads();
}
__device__ __forceinline__ void transpose_item(const float* W, int K, int N, bf16* WT, LAS float* scr, int item, int lane) {
    const int nblk = N / 32, kb = item / nblk, nb = item % nblk, k0 = 64 * kb, n0 = 32 * nb;
    f32x4 v[8];
#pragma unroll
    for (int i = 0; i < 8; ++i) v[i] = *(const f32x4*)(W + (size_t)(k0 + 8 * i + (lane >> 3)) * N + n0 + 4 * (lane & 7));
#pragma unroll
    for (int i = 0; i < 8; ++i) { LAS float* d = scr + (8 * i + (lane >> 3)) * 33 + 4 * (lane & 7); d[0] = v[i].x; d[1] = v[i].y; d[2] = v[i].z; d[3] = v[i].w; }
    asm volatile("s_waitcnt lgkmcnt(0)" ::: "memory");
    const int c = lane & 7;
#pragma unroll
    for (int j = 0; j < 4; ++j) { const int n = (lane >> 3) + 8 * j; const LAS float* s = scr + (8 * c) * 33 + n;
        u32x4 o; o.x = cvt_pk_bf16(s[0 * 33], s[1 * 33]); o.y = cvt_pk_bf16(s[2 * 33], s[3 * 33]); o.z = cvt_pk_bf16(s[4 * 33], s[5 * 33]); o.w = cvt_pk_bf16(s[6 * 33], s[7 * 33]);
        *(u32x4*)(WT + (size_t)(n0 + n) * K + k0 + 8 * c) = o; }
    asm volatile("s_waitcnt lgkmcnt(0)" ::: "memory");
}
__device__ __forceinline__ void convert_big(const Args& a, LAS unsigned char* lds, int l, int gw, int NGW, int wave, int lane) {
    LAS float* scr = (LAS float*)(lds + wave * 16384);
    constexpr int I_IN = (D / 64) * (D_IN / 32), I_LO = (D / 64) * (D / 32), I_PO = (D_POOL / 64) * (D / 32), I_O = I_LO, I_1 = (D / 64) * (D_FF / 32), I_2 = (D_FF / 64) * (D / 32);
    constexpr int NIT = I_IN + I_LO + I_PO + I_O + I_1 + I_2;
    unsigned char* ws = a.ws;
    for (int it = gw; it < NIT; it += NGW) { int r = it;
        if (r < I_IN) { transpose_item(a.in[I_WIN] + (size_t)l * D * D_IN, D, D_IN, (bf16*)(ws + WS_WIN), scr, r, lane); continue; } r -= I_IN;
        if (r < I_LO) { transpose_item(a.in[I_WLO] + (size_t)l * D * D, D, D, (bf16*)(ws + WS_WLO), scr, r, lane); continue; } r -= I_LO;
        if (r < I_PO) { transpose_item(a.in[I_WPO] + (size_t)l * D_POOL * D, D_POOL, D, (bf16*)(ws + WS_WPO), scr, r, lane); continue; } r -= I_PO;
        if (r < I_O) { transpose_item(a.in[I_WO] + (size_t)l * D * D, D, D, (bf16*)(ws + WS_WO), scr, r, lane); continue; } r -= I_O;
        if (r < I_1) { transpose_item(a.in[I_W1] + (size_t)l * D * D_FF, D, D_FF, (bf16*)(ws + WS_W1), scr, r, lane); continue; } r -= I_1;
        transpose_item(a.in[I_W2] + (size_t)l * D_FF * D, D_FF, D, (bf16*)(ws + WS_W2), scr, r, lane); }
}
__device__ __forceinline__ void convert_small(const Args& a, LAS unsigned char* lds, int gw, int NGW, int wave, int lane) {
    LAS float* scr = (LAS float*)(lds + wave * 16384);
    for (int it = gw; it < 256 + 64; it += NGW) {
        if (it < 256) { const int mi = it >> 1, sub = it & 1, h = mi & 15, ri = (mi >> 4) & 1, ld = mi >> 5;
            const float* src = a.in[ri ? I_WI : I_WR] + ((size_t)ld * 16 + h) * 4096;
            transpose_item(src, 64, 64, (bf16*)(a.ws + WS_GW) + ((size_t)(ld * 2 + ri) * 16 + h) * 4096, scr, sub, lane); }
        else { const int r = it - 256, mi = r >> 3, sub = r & 7;
            transpose_item(a.in[I_POOLW] + (size_t)mi * 16384, 128, 128, (bf16*)(a.ws + WS_PW) + (size_t)mi * 16384, scr, sub, lane); }
    }
}
__device__ __forceinline__ void norm_rows(const float* xl, const float* xc, bf16* H, const float* gvec, const float* mod  , int shift_i, int scale_i, int nrows, int gw, int NGW, int lane,
                                          const float* slab = nullptr, const float* sgate = nullptr, float* xcw = nullptr) {
    f32x4 vn[4];
    { const int mc = min(gw, nrows - 1); const f32x4* x4 = (const f32x4*)(mc < ML ? xl + (size_t)mc * D : xc + (size_t)(mc - ML) * D) + lane;
#pragma unroll
      for (int j = 0; j < 4; ++j) vn[j] = x4[64 * j]; }
    for (int m = gw; m < nrows; m += NGW) {
        const int r = m < ML ? (m >> 12) : 4;
        f32x4 v[4]; float ss = 0.f;
#pragma unroll
        for (int j = 0; j < 4; ++j) v[j] = vn[j];
        { const int mc = min(m + NGW, nrows - 1); const f32x4* x4 = (const f32x4*)(mc < ML ? xl + (size_t)mc * D : xc + (size_t)(mc - ML) * D) + lane;
#pragma unroll
          for (int j = 0; j < 4; ++j) vn[j] = x4[64 * j]; }
        if (slab != nullptr && m >= ML) {
            const f32x4* s4 = (const f32x4*)(slab + (size_t)(m - ML) * D) + lane; const f32x4* g4s = (const f32x4*)sgate + lane;
#pragma unroll
            for (int j = 0; j < 4; ++j) { const f32x4 t = (s4[64 * j] + s4[64 * j + 262144]) + (s4[64 * j + 2 * 262144] + s4[64 * j + 3 * 262144]); v[j] = v[j] + g4s[64 * j] * t; }
            if (xcw != nullptr) { f32x4* w4 = (f32x4*)(xcw + (size_t)(m - ML) * D) + lane;
#pragma unroll
                for (int j = 0; j < 4; ++j) w4[64 * j] = v[j]; } }
#pragma unroll
        for (int j = 0; j < 4; ++j) ss += (v[j].x * v[j].x + v[j].y * v[j].y) + (v[j].z * v[j].z + v[j].w * v[j].w);
        const float rstd = 1.0f / sqrtf(wave_sum(ss) * (1.f / D) + EPS);
        const f32x4* g4 = (const f32x4*)gvec + lane; const f32x4* sc4 = (const f32x4*)(mod + (size_t)r * MODW + scale_i * D) + lane; const f32x4* sh4 = (const f32x4*)(mod + (size_t)r * MODW + shift_i * D) + lane;
        u32x2* o = (u32x2*)(H + (size_t)m * D) + lane;
#pragma unroll
        for (int j = 0; j < 4; ++j) { const f32x4 h = v[j] * rstd * g4[64 * j] * (1.0f + sc4[64 * j]) + sh4[64 * j]; u32x2 w; w.x = cvt_pk_bf16(h.x, h.y); w.y = cvt_pk_bf16(h.z, h.w); o[64 * j] = w; }
    }
}
__device__ __forceinline__ void final_rows(float* x, const float* gvec, int gw, int NGW, int lane) {
    f32x4 vn[4];
    { const f32x4* xq = (const f32x4*)(x + (size_t)min(gw, ML - 1) * D) + lane;
#pragma unroll
      for (int j = 0; j < 4; ++j) vn[j] = xq[64 * j]; }
    for (int m = gw; m < ML; m += NGW) {
        f32x4* x4 = (f32x4*)(x + (size_t)m * D) + lane; f32x4 v[4]; float ss = 0.f;
#pragma unroll
        for (int j = 0; j < 4; ++j) { v[j] = vn[j]; ss += (v[j].x * v[j].x + v[j].y * v[j].y) + (v[j].z * v[j].z + v[j].w * v[j].w); }
        { const f32x4* xq = (const f32x4*)(x + (size_t)min(m + NGW, ML - 1) * D) + lane;
#pragma unroll
          for (int j = 0; j < 4; ++j) vn[j] = xq[64 * j]; }
        const float rstd = 1.0f / sqrtf(wave_sum(ss) * (1.f / D) + EPS);
        const f32x4* g4 = (const f32x4*)gvec + lane;
#pragma unroll
        for (int j = 0; j < 4; ++j) x4[64 * j] = v[j] * rstd * g4[64 * j];
    }
}
constexpr int SCW_WAVE = 19456, SCW_TILE = 17664;
constexpr int SCW_WAVE_OLD = 18432;
#ifndef AF_STACK
#define AF_STACK 1
#endif
template <bool PASSB, int DIR>
__device__ __forceinline__ void scan_sweep(const Args& a, LAS unsigned char* wl, int l, int b, int q, int h, int seqbase, int L, int t0, int lane, unsigned (&st)[NSUB][16], unsigned (&afs)[NSUB][16]) {
    constexpr bool AFS = (AF_STACK != 0);
    const int l31 = lane & 31, lh = lane >> 5, ld = l * 2 + DIR;
    const bf16* U = (const bf16*)(a.ws + WS_U) + (size_t)seqbase * D + h * 64 + lh * 8;
    const LAS float* cwl = (const LAS float*)(wl + 16384);
    { const bf16* g0 = (const bf16*)(a.ws + WS_GW) + (size_t)((ld * 2 + 0) * 16 + h) * 4096; const bf16* g1 = (const bf16*)(a.ws + WS_GW) + (size_t)((ld * 2 + 1) * 16 + h) * 4096;
      u32x4 v0[8], v1[8];
#pragma unroll
      for (int p = 0; p < 8; ++p) { v0[p] = *(const u32x4*)(g0 + (p * 64 + lane) * 8); v1[p] = *(const u32x4*)(g1 + (p * 64 + lane) * 8); }
#pragma unroll
      for (int p = 0; p < 8; ++p) { const int piece = p * 64 + lane, row = piece >> 3, c = piece & 7, off = row * 128 + ((c ^ (row & 7)) * 16);
          *(LAS u32x4*)(wl + off) = v0[p]; *(LAS u32x4*)(wl + 8192 + off) = v1[p]; } }
    float brr[2], bii[2], sp[2], s[2], AT[2];
#pragma unroll
    for (int nb = 0; nb < 2; ++nb) { const int ch = h * 64 + nb * 32 + l31;
        brr[nb] = -1.44269504f * a.in[I_BR][ld * D + ch]; bii[nb] = -1.44269504f * a.in[I_BI][ld * D + ch];
        const float lam = a.in[I_LAM][ld * D + ch]; sp[nb] = (-8.0f * 1.44269504f) * (fmaxf(-lam, 0.f) + log1pf(__expf(-fabsf(lam))));
        AT[nb] = 1.f; s[nb] = PASSB ? ((const float*)(a.ws + WS_CARRY))[(size_t)((b * 2 + DIR) * NQ + q) * 1024 + ch] : 0.f; }
    asm volatile("s_waitcnt lgkmcnt(0)" ::: "memory"); __builtin_amdgcn_wave_barrier();
    u32x4 ur[4][4];
#define LOADU(tokv) do { _Pragma("unroll") for (int j_ = 0; j_ < 4; ++j_) { const int tc_ = min(max((tokv) - 2 + j_, 0), L - 1); \
        _Pragma("unroll") for (int ks_ = 0; ks_ < 4; ++ks_) ur[ks_][j_] = *(const u32x4*)(U + (size_t)tc_ * D + ks_ * 16); } } while (0)
#ifndef SCAN_PREFETCH
#define SCAN_PREFETCH 0
#endif
    if (SCAN_PREFETCH) LOADU(t0 + (DIR ? (NSUB - 1) * 32 : 0) + l31);
#pragma unroll 1
    for (int k = 0; k < NSUB; ++k) {
        const int tsub = t0 + (DIR ? NSUB - 1 - k : k) * 32, tok = tsub + l31;
        bf16x8 af[4];
        if (AFS && DIR == 1) {
#pragma unroll
            for (int ks = 0; ks < 4; ++ks) { u32x4 o; o.x = afs[0][4 * ks]; o.y = afs[0][4 * ks + 1]; o.z = afs[0][4 * ks + 2]; o.w = afs[0][4 * ks + 3]; af[ks] = __builtin_bit_cast(bf16x8, o); }
#pragma unroll
            for (int i = 0; i < 16; ++i)
#pragma unroll
                for (int d = 0; d + 1 < NSUB; ++d) afs[d][i] = afs[d + 1][i];
        } else {
        if (!SCAN_PREFETCH) { LOADU(tok); __builtin_amdgcn_sched_barrier(0); }
#pragma unroll
        for (int ks = 0; ks < 4; ++ks) { const int c0 = ks * 16 + lh * 8;
            f32x4 u0 = *(const LAS f32x4*)(cwl + 256 + c0), u1 = *(const LAS f32x4*)(cwl + 256 + c0 + 4);
#pragma unroll
            for (int j = 0; j < 4; ++j) { const int tt = tok - 2 + j; const bool ok = (tt >= 0 && tt < L); u32x4 uv = ur[ks][j];
                uv.x = ok ? uv.x : 0u; uv.y = ok ? uv.y : 0u; uv.z = ok ? uv.z : 0u; uv.w = ok ? uv.w : 0u;
                const f32x4 w0 = *(const LAS f32x4*)(cwl + j * 64 + c0), w1 = *(const LAS f32x4*)(cwl + j * 64 + c0 + 4);
                u0.x = fmaf(w0.x, bf_lo(uv.x), u0.x); u0.y = fmaf(w0.y, bf_hi(uv.x), u0.y); u0.z = fmaf(w0.z, bf_lo(uv.y), u0.z); u0.w = fmaf(w0.w, bf_hi(uv.y), u0.w);
                u1.x = fmaf(w1.x, bf_lo(uv.z), u1.x); u1.y = fmaf(w1.y, bf_hi(uv.z), u1.y); u1.z = fmaf(w1.z, bf_lo(uv.w), u1.z); u1.w = fmaf(w1.w, bf_hi(uv.w), u1.w); }
            u32x4 o; o.x = cvt_pk_bf16(u0.x, u0.y); o.y = cvt_pk_bf16(u0.z, u0.w); o.z = cvt_pk_bf16(u1.x, u1.y); o.w = cvt_pk_bf16(u1.z, u1.w);
            af[ks] = __builtin_bit_cast(bf16x8, o);
            if (AFS) {
#pragma unroll
                for (int d = NSUB - 1; d > 0; --d) { afs[d][4 * ks] = afs[d - 1][4 * ks]; afs[d][4 * ks + 1] = afs[d - 1][4 * ks + 1]; afs[d][4 * ks + 2] = afs[d - 1][4 * ks + 2]; afs[d][4 * ks + 3] = afs[d - 1][4 * ks + 3]; }
                afs[0][4 * ks] = o.x; afs[0][4 * ks + 1] = o.y; afs[0][4 * ks + 2] = o.z; afs[0][4 * ks + 3] = o.w; } }
        }
        __builtin_amdgcn_sched_barrier(0);
        if (SCAN_PREFETCH) { const int kn = k < NSUB - 1 ? k + 1 : k; LOADU(t0 + (DIR ? NSUB - 1 - kn : kn) * 32 + l31); }
        __builtin_amdgcn_sched_barrier(0);
        unsigned cur[16];
        if (PASSB && DIR == 1) {
#pragma unroll
            for (int i = 0; i < 16; ++i) { cur[i] = st[0][i];
#pragma unroll
                for (int d = 0; d + 1 < NSUB; ++d) st[d][i] = st[d + 1][i]; } }
        float gall[2][16]; unsigned outp[2][8];
        LAS unsigned char* tile = wl + SCW_TILE; const int r8 = lane >> 3, c8 = lane & 7;
        if (PASSB && DIR == 1) {
            const bf16* Grow = (const bf16*)(a.ws + WS_G) + (size_t)(seqbase + tsub + r8) * D + h * 64 + c8 * 8;
            u32x4 gq[4];
#pragma unroll
            for (int gi = 0; gi < 4; ++gi) gq[gi] = *(const u32x4*)(Grow + (size_t)(8 * gi) * D);
#pragma unroll
            for (int gi = 0; gi < 4; ++gi) { *(LAS u32x4*)(tile + r8 * 128 + c8 * 16) = gq[gi];
#pragma unroll
                for (int nb2 = 0; nb2 < 2; ++nb2)
#pragma unroll
                    for (int j = 0; j < 4; ++j) gall[nb2][4 * gi + j] = __uint_as_float((unsigned)(*(const LAS unsigned short*)(tile + (4 * lh + j) * 128 + (nb2 * 32 + l31) * 2)) << 16); } }
#pragma unroll
        for (int nb = 0; nb < 2; ++nb) {
            __builtin_amdgcn_sched_barrier(0);
            const size_t cbase = (size_t)(seqbase + tsub + 4 * lh) * D + h * 64 + nb * 32 + l31;
            bf16* HL = (bf16*)(a.ws + WS_H) + cbase; const bf16* Gp = (const bf16*)(a.ws + WS_G) + cbase;
            float hfv[16], gv[16];
            if (PASSB && DIR == 1) {
#pragma unroll
                for (int reg = 0; reg < 16; ++reg) { gv[reg] = gall[nb][reg];
                    hfv[reg] = (reg & 1) ? bf_hi(cur[nb * 8 + (reg >> 1)]) : bf_lo(cur[nb * 8 + (reg >> 1)]); } }
            f32x16 ar, ai, au;
#pragma unroll
            for (int i = 0; i < 16; ++i) { ar[i] = 0.f; ai[i] = 0.f; au[i] = 0.f; }
            const int row = nb * 32 + l31;
#pragma unroll
            for (int ks = 0; ks < 4; ++ks) {
                const int idx = row - (ks * 16 + lh * 8);
                const unsigned one = (idx >= 0 && idx < 8) ? (0x3F80u << ((idx & 1) * 16)) : 0u; const int dw = idx >> 1;
                u32x4 idv; idv.x = dw == 0 ? one : 0u; idv.y = dw == 1 ? one : 0u; idv.z = dw == 2 ? one : 0u; idv.w = dw == 3 ? one : 0u;
                const int woff = row * 128 + (((ks * 2 + lh) ^ (row & 7)) * 16);
                const bf16x8 wr = *(const LAS bf16x8*)(wl + woff), wi = *(const LAS bf16x8*)(wl + 8192 + woff);
                ar = __builtin_amdgcn_mfma_f32_32x32x16_bf16(af[ks], wr, ar, 0, 0, 0);
                ai = __builtin_amdgcn_mfma_f32_32x32x16_bf16(af[ks], wi, ai, 0, 0, 0);
                if ((ks >> 1) == nb) au = __builtin_amdgcn_mfma_f32_32x32x16_bf16(af[ks], __builtin_bit_cast(bf16x8, idv), au, 0, 0, 0); }
#pragma unroll
            for (int reg = 0; reg < 16; ++reg) {
                const float r = __builtin_amdgcn_rcpf(1.0f + __builtin_amdgcn_exp2f(fmaf(ar[reg], -1.44269504f, brr[nb])));
                const float ig = __builtin_amdgcn_rcpf(1.0f + __builtin_amdgcn_exp2f(fmaf(ai[reg], -1.44269504f, bii[nb])));
                float rs = r * sp[nb]; asm volatile("" : "+v"(rs));
                const float av = __builtin_amdgcn_exp2f(rs); float om = fmaf(-av, av, 1.0f); asm volatile("" : "+v"(om));
                float bq = (__builtin_amdgcn_sqrtf(om) * ig) * au[reg]; asm volatile("" : "+v"(bq));
                ar[reg] = av; ai[reg] = bq; }
            float gA[4], gB[4], pA[4], pB[4], sIn[4];
#pragma unroll
            for (int gi = 0; gi < 4; ++gi) { const int j0 = DIR ? 3 : 0; float A = ar[4 * gi + j0], B = ai[4 * gi + j0];
#pragma unroll
                for (int jj = 1; jj < 4; ++jj) { const int j = DIR ? 3 - jj : jj; B = ar[4 * gi + j] * B + ai[4 * gi + j]; A *= ar[4 * gi + j]; }
                gA[gi] = A; gB[gi] = B; }
#pragma unroll
            for (int gi = 0; gi < 4; ++gi) { pA[gi] = __shfl_xor(gA[gi], 32); pB[gi] = __shfl_xor(gB[gi], 32); sIn[gi] = 0.f; }
            float st = s[nb];
#pragma unroll
            for (int g = 0; g < 8; ++g) { const int gg = DIR ? 7 - g : g, gi = gg >> 1; const bool own = (lh == (gg & 1));
                const float Ag = own ? gA[gi] : pA[gi], Bg = own ? gB[gi] : pB[gi];
                sIn[gi] = own ? st : sIn[gi]; st = Ag * st + Bg; if (!PASSB) AT[nb] *= Ag; }
            s[nb] = st;
            if (PASSB) {
#pragma unroll
                for (int gi = 0; gi < 4; ++gi) { float hc = sIn[gi];
#pragma unroll
                    for (int jj = 0; jj < 4; ++jj) { const int j = DIR ? 3 - jj : jj, reg = 4 * gi + j; hc = ar[reg] * hc + ai[reg];
                        const size_t o = (size_t)(8 * gi + j) * D;
                        if (DIR == 0) ar[reg] = hc;
                        else ar[reg] = (hfv[reg] + hc) * gelu_tanh(gv[reg]); } }
#pragma unroll
                for (int p = 0; p < 8; ++p) { const unsigned pk = cvt_pk_bf16(ar[2 * p], ar[2 * p + 1]); if (DIR == 0) cur[nb * 8 + p] = pk; else outp[nb][p] = pk; }
            }
        }
        if (PASSB && DIR == 0) {
#pragma unroll
            for (int i = 0; i < 16; ++i) {
#pragma unroll
                for (int d = NSUB - 1; d > 0; --d) st[d][i] = st[d - 1][i];
                st[0][i] = cur[i]; } }
        if (PASSB && DIR == 1) {
            bf16* HLrow = (bf16*)(a.ws + WS_H) + (size_t)(seqbase + tsub + r8) * D + h * 64 + c8 * 8;
#pragma unroll
            for (int gi = 0; gi < 4; ++gi) {
#pragma unroll
                for (int nb2 = 0; nb2 < 2; ++nb2)
#pragma unroll
                    for (int j = 0; j < 4; ++j) { const unsigned pk = outp[nb2][2 * gi + (j >> 1)];
                        *(LAS unsigned short*)(tile + (4 * lh + j) * 128 + (nb2 * 32 + l31) * 2) = (unsigned short)((j & 1) ? (pk >> 16) : (pk & 0xffffu)); }
                const u32x4 row = *(const LAS u32x4*)(tile + r8 * 128 + c8 * 16);
                *(u32x4*)(HLrow + (size_t)(8 * gi) * D) = row; } }
    }
#undef LOADU
    if (!PASSB) {
#pragma unroll
        for (int nb = 0; nb < 2; ++nb) { float* sm = (float*)(a.ws + WS_SUMM) + ((size_t)((b * 2 + DIR) * NQ + q) * 2) * 1024 + h * 64 + nb * 32 + l31;
            if (lh == 0) { sm[0] = AT[nb]; sm[1024] = s[nb]; } }
    }
    asm volatile("s_waitcnt lgkmcnt(0)" ::: "memory"); __builtin_amdgcn_wave_barrier();
}
template <bool PASSB>
__device__ __forceinline__ void scan_task(const Args& a, LAS unsigned char* lds, int l, int item, int wave, int lane) {
    int b, chunk, h, seqbase, L, q;
    if (item < NLAT) { b = item / (NCL * 16); const int rem = item % (NCL * 16); chunk = rem >> 4; h = rem & 15; seqbase = b * SEQ; L = SEQ; q = NCC + chunk; }
    else { const int it = item - NLAT; b = it / (NCC * 16); const int rem = it % (NCC * 16); chunk = rem >> 4; h = rem & 15; seqbase = ML + b * CTX; L = CTX; q = chunk; }
    LAS unsigned char* wl = lds + wave * SCW_WAVE; LAS float* cwl = (LAS float*)(wl + 16384);
    { const float* cw = a.in[I_CONVW] + (size_t)l * 4 * D + h * 64;
#pragma unroll
      for (int j = 0; j < 4; ++j) cwl[j * 64 + lane] = cw[j * D + lane];
      cwl[256 + lane] = a.in[I_CONVB][l * D + h * 64 + lane]; }
    unsigned st[NSUB][16];
#pragma unroll
    for (int d = 0; d < NSUB; ++d)
#pragma unroll
        for (int i = 0; i < 16; ++i) st[d][i] = 0u;
    unsigned afs[NSUB][16];
#pragma unroll
    for (int d = 0; d < NSUB; ++d)
#pragma unroll
        for (int i = 0; i < 16; ++i) afs[d][i] = 0u;
    scan_sweep<PASSB, 0>(a, wl, l, b, q, h, seqbase, L, chunk * TCH, lane, st, afs);
    scan_sweep<PASSB, 1>(a, wl, l, b, q, h, seqbase, L, chunk * TCH, lane, st, afs);
}
__device__ __forceinline__ void carry_phase(const Args& a) {
    const float* sm = (const float*)(a.ws + WS_SUMM); float* cr = (float*)(a.ws + WS_CARRY);
    const int tid = opaque_tid();
    static_assert(NQ % 17 == 0, "carry batches");
    for (int idx = blockIdx.x * 64 + tid; tid < 64 && idx < NB * 2 * 1024; idx += gridDim.x * 64) {
        const int chn = idx & 1023, bd = idx >> 10, dir = bd & 1;
        const float* s0 = sm + (size_t)bd * NQ * 2048 + chn; float* c0 = cr + (size_t)bd * NQ * 1024 + chn;
        float hs = 0.f;
#pragma unroll 1
        for (int k0 = 0; k0 < NQ; k0 += 17) { float va[17], vb[17];
#pragma unroll
            for (int i = 0; i < 17; ++i) { const int k = k0 + i; const int q = (dir == 0) ? k : ((k < NCC) ? NCC - 1 - k : (NQ - 1 - (k - NCC)));
                va[i] = s0[(size_t)q * 2048]; vb[i] = s0[(size_t)q * 2048 + 1024]; }
#pragma unroll
            for (int i = 0; i < 17; ++i) { const int k = k0 + i; const int q = (dir == 0) ? k : ((k < NCC) ? NCC - 1 - k : (NQ - 1 - (k - NCC)));
                c0[(size_t)q * 1024] = hs; hs = va[i] * hs + vb[i]; } }
    }
}
constexpr int PL_PF = 0  , PL_MB = 40960  , PL_MROW = 272;
__device__ __forceinline__ void pool_item(const Args& a, LAS unsigned char* lds, int l, int item) {
    const int tid = opaque_tid(), lane = tid & 63, wave = __builtin_amdgcn_readfirstlane(tid >> 6);
    int g, R0, L, t0;
    if (item < 1024) { g = item & 3; R0 = (item >> 2) * 64; L = 64; t0 = 0; }
    else { const int it = item - 1024; g = it & 3; const int blk = (it >> 2) & 3, b = it >> 4; R0 = ML + b * CTX; L = CTX; t0 = blk * 64; }
    const bf16* P = (const bf16*)(a.ws + WS_P); LAS float* pf = (LAS float*)(lds + PL_PF);
    { u32x4 v[3];
#pragma unroll
      for (int i = 0; i < 3; ++i) { const int idx = min(tid + 512 * i, 1279), row = idx >> 4, c8 = (idx & 15) * 8, tt = t0 - 8 + row, tc = min(max(tt, 0), L - 1);
          v[i] = *(const u32x4*)(P + (size_t)(R0 + tc) * D_POOL + g * 128 + c8);
          const bool ok = (tt == tc); v[i].x = ok ? v[i].x : 0u; v[i].y = ok ? v[i].y : 0u; v[i].z = ok ? v[i].z : 0u; v[i].w = ok ? v[i].w : 0u; }
#pragma unroll
      for (int i = 0; i < 3; ++i) { const int idx = tid + 512 * i, row = idx >> 4, c8 = (idx & 15) * 8;
          if (idx < 1280) { *(LAS f32x4*)(pf + row * 128 + c8) = (f32x4){bf_lo(v[i].x), bf_hi(v[i].x), bf_lo(v[i].y), bf_hi(v[i].y)}; *(LAS f32x4*)(pf + row * 128 + c8 + 4) = (f32x4){bf_lo(v[i].z), bf_hi(v[i].z), bf_lo(v[i].w), bf_hi(v[i].w)}; } } }
    __syncthreads();
    { const int c = tid & 127, tq = tid >> 7, hw = 1 << g;
      const LAS float* pc = pf + c; const int tb = tq * 16; float s = 0.f;
#pragma unroll
      for (int u = 0; u < 16; ++u) { const int r = min(tb + 8 - hw + u, tb + 8 + hw - 1); const float v = pc[r * 128]; s += (u < 2 * hw) ? v : 0.f; }
#pragma unroll
      for (int k = 0; k < 16; ++k) { const int t = tb + k, tt = t0 + t; const int cnt = min(tt + hw, L) - max(tt - hw, 0);
          const float mval = s * __builtin_amdgcn_rcpf((float)cnt) - pc[(t + 8) * 128];
          *(LAS unsigned short*)(lds + PL_MB + t * PL_MROW + c * 2) = (unsigned short)cvt_pk_bf16(mval, 0.f);
          if (k < 15) s += pc[(t + 8 + hw) * 128] - pc[(t + 8 - hw) * 128]; } }
    __syncthreads();
    { const int mblk = wave & 1, nblk = wave >> 1, l31 = lane & 31, lh = lane >> 5, e = nblk * 32 + l31;
      const bf16* pw = (const bf16*)(a.ws + WS_PW) + ((size_t)(l * 4 + g) * 128 + e) * 128 + lh * 8;
      f32x16 acc;
#pragma unroll
      for (int i = 0; i < 16; ++i) acc[i] = 0.f;
#pragma unroll
      for (int ks = 0; ks < 8; ++ks) { const bf16x8 af = *(const LAS bf16x8*)(lds + PL_MB + (mblk * 32 + l31) * PL_MROW + (ks * 16 + lh * 8) * 2); const bf16x8 bw = *(const bf16x8*)(pw + ks * 16);
          acc = __builtin_amdgcn_mfma_f32_32x32x16_bf16(af, bw, acc, 0, 0, 0); }
      const float scl = a.in[I_POOLS][l * D_POOL + g * 128 + e];
      LAS unsigned short* ot = (LAS unsigned short*)(lds + PL_PF);
#pragma unroll
      for (int reg = 0; reg < 16; ++reg) { const int t = mblk * 32 + (reg & 3) + 8 * (reg >> 2) + 4 * lh; ot[t * 128 + e] = (unsigned short)cvt_pk_bf16(acc[reg] * scl, 0.f); } }
    __syncthreads();
    { bf16* PM = (bf16*)(a.ws + WS_PM) + (size_t)(R0 + t0) * D_POOL + g * 128;
#pragma unroll
      for (int i = 0; i < 2; ++i) { const int idx = tid + 512 * i, row = idx >> 4, c16 = idx & 15;
          *(u32x4*)(PM + (size_t)row * D_POOL + c16 * 8) = *(const LAS u32x4*)(lds + PL_PF + row * 256 + c16 * 16); } }
    __syncthreads();
}
#define XB_TMO      128
#define XB_XCNT(j)  (256  + 64 * (j))
#define XB_XSUB(j)  (1280 + 64 * (j))
#define XB_XGEN(j)  (2304 + 64 * (j))
#define XB_TOP      3328
#define XB_TOPGEN   3392
#define XCD_BAR_WORDS 3456
#define XB_SPIN_CAP (1u << 18)

__device__ __forceinline__ unsigned xb_ld(unsigned* p)              { return __hip_atomic_load(p, __ATOMIC_RELAXED, __HIP_MEMORY_SCOPE_AGENT); }
__device__ __forceinline__ unsigned xb_add(unsigned* p, unsigned v) { return __hip_atomic_fetch_add(p, v, __ATOMIC_RELAXED, __HIP_MEMORY_SCOPE_AGENT); }
__device__ __forceinline__ unsigned xb_xcc_id() { return (unsigned)__builtin_amdgcn_s_getreg((3 << 11) | 20) & 0xFu; }
#define XB_SPIN(cond, bar) do { unsigned _sp = 0; while (cond) { __builtin_amdgcn_s_sleep(1); \
    if ((++_sp & 255u) == 0u) { if (xb_ld(&(bar)[XB_TMO])) break; if (_sp > XB_SPIN_CAP) { atomicAdd(&(bar)[XB_TMO], 1u); break; } } } } while (0)

struct XcdBarrier {
    unsigned* bar; unsigned x;
    volatile LAS unsigned* st;
};

__device__ __forceinline__ XcdBarrier xcd_barrier_post(unsigned* bar, volatile LAS unsigned* st) {
    XcdBarrier b; b.bar = bar; b.x = xb_xcc_id(); b.st = st;
    if (threadIdx.x == 0) (void)xb_add(&bar[XB_XCNT(b.x)], 1u);
    return b;
}
__device__ __forceinline__ void xcd_barrier_complete(unsigned* bar, unsigned x, unsigned& nloc, unsigned& nx) {
    const unsigned G = gridDim.x * gridDim.y * gridDim.z;
    unsigned sum, cnt, mine, sp = 0u;
    for (;;) {
        sum = 0u; cnt = 0u; mine = 0u;
#pragma unroll
        for (unsigned j = 0; j < 16; ++j) { const unsigned c = xb_ld(&bar[XB_XCNT(j)]); sum += c; cnt += (c > 0u) ? 1u : 0u; mine = (j == x) ? c : mine; }
        if (sum == G) break;
        __builtin_amdgcn_s_sleep(1);
        if ((++sp & 255u) == 0u) { if (xb_ld(&bar[XB_TMO])) break; if (sp > XB_SPIN_CAP) { atomicAdd(&bar[XB_TMO], 1u); break; } }
    }
    nloc = mine > 0u ? mine : 1u; nx = cnt > 0u ? cnt : 1u;
}

__device__ __forceinline__ void xcd_barrier(const XcdBarrier& b) {
    asm volatile("s_waitcnt vmcnt(0)" ::: "memory");
    __syncthreads();
    if (threadIdx.x == 0) {
        unsigned* bar = b.bar;
        __builtin_amdgcn_s_waitcnt(0);
        unsigned nloc = b.st[0], nx = b.st[1];
        if (nloc == 0u) { xcd_barrier_complete(bar, b.x, nloc, nx); b.st[0] = nloc; b.st[1] = nx; }
        const unsigned old = xb_add(&bar[XB_XSUB(b.x)], 1u);
        const unsigned gen = old / nloc;
        if (old + 1u == (gen + 1u) * nloc) {
            __builtin_amdgcn_fence(__ATOMIC_RELEASE, "agent");
            asm volatile("s_waitcnt vmcnt(0)" ::: "memory");
            const unsigned og = xb_add(&bar[XB_TOP], 1u);
            const unsigned tg = og / nx;
            if (og + 1u == (tg + 1u) * nx) xb_add(&bar[XB_TOPGEN], 1u);
            else XB_SPIN(xb_ld(&bar[XB_TOPGEN]) == tg, bar);
            __builtin_amdgcn_fence(__ATOMIC_ACQUIRE, "agent");
            xb_add(&bar[XB_XGEN(b.x)], 1u);
            asm volatile("s_waitcnt vmcnt(0)" ::: "memory");
        } else {
            XB_SPIN(xb_ld(&bar[XB_XGEN(b.x)]) == gen, bar);
            __builtin_amdgcn_fence(__ATOMIC_ACQUIRE, "agent");
            asm volatile("s_waitcnt vmcnt(0)" ::: "memory");
        }
    }
    __syncthreads();
}

constexpr int NPHASE = 22;
__global__ void __launch_bounds__(512, 2) mk_fwd(Args a) {
    extern __shared__ __attribute__((aligned(16))) unsigned char lds_raw[];
    LAS unsigned char* lds = (LAS unsigned char*)lds_raw;
    cg::grid_group grid = cg::this_grid();
    volatile LAS unsigned* MISC = (volatile LAS unsigned*)(lds + MISC_OFF);
    if (threadIdx.x < 64) MISC[threadIdx.x] = 0u;
    __syncthreads();
    XcdBarrier xbar; xbar.bar = (unsigned*)(a.ws + WS_BAR); xbar.x = 0; xbar.st = MISC + 8;
    if (a.hi - a.lo > 1) xbar = xcd_barrier_post((unsigned*)(a.ws + WS_BAR), MISC + 8);
    const int G = gridDim.x, bx = blockIdx.x, NGW = G * 8;
#define WL() const int tid_ = opaque_tid(), lane = tid_ & 63, wave = __builtin_amdgcn_readfirstlane(tid_ >> 6), gw = bx * 8 + wave
    const int lo = a.lo, hi = a.hi;
    unsigned char* ws = a.ws;
    float* MOD = (float*)(ws + WS_MOD); float* XC = (float*)(ws + WS_XC);
    bf16* Hb = (bf16*)(ws + WS_H); bf16* Ub = (bf16*)(ws + WS_U); bf16* Gb = (bf16*)(ws + WS_G); bf16* Pb = (bf16*)(ws + WS_P); bf16* GTb = (bf16*)(ws + WS_GT); bf16* PMb = (bf16*)(ws + WS_PM); bf16* Fb = (bf16*)(ws + WS_F);
#ifndef PH_MASK
#define PH_MASK 0xfff
#endif
#define IN(k) (lo <= (k) && (k) < hi)
#define ON(b) ((PH_MASK >> (b)) & 1)
#ifndef REP_MASK
#define REP_MASK 0
#endif
#define REPS(b) for (int rep_ = 0; rep_ < 1 + ((REP_MASK >> (b)) & 1); ++rep_)
#ifndef SYNC_REP
#define SYNC_REP 1
#endif
#define SEAM(k) do { if (IN(k) && IN((k) + 1)) for (int sr_ = 0; sr_ < SYNC_REP; ++sr_) { if (a.hi < 0) grid.sync(); xcd_barrier(xbar); } } while (0)
    if (ON(0) && IN(0)) REPS(0) {
        for (int it = bx; it < 192; it += G) mod_item(a, lds, it);
        WL();
        convert_small(a, lds, gw, NGW, wave, lane);
        convert_big(a, lds, 0, gw, NGW, wave, lane);
    }
    SEAM(0);
#pragma unroll 1
    for (int l = 0; l < DEPTH; ++l) {
        const int pb = 1 + 10 * l; const bool last = (l == DEPTH - 1);
        const float* modl = MOD + (size_t)l * 5 * MODW;
        const float* xsrcL = l == 0 ? a.in[I_X] : a.out; const float* xsrcC = l == 0 ? a.in[I_CTX] : XC;
        const int Mrest = last ? ML : MT;
        if (ON(1) && IN(pb + 0)) REPS(1) {
            WL();
            if (l > 0) convert_big(a, lds, l, gw, NGW, wave, lane);
            norm_rows(xsrcL, xsrcC, Hb, a.in[I_N1G] + l * D, modl, 0, 1, MT, gw, NGW, lane, l > 0 ? (const float*)(ws + WS_SLAB5) : nullptr, MOD + 4 * MODW + 5 * D  , nullptr);
        }
        SEAM(pb + 0);
        if (ON(2) && IN(pb + 1)) REPS(2) {
            pg8::Gemm g{Hb, (const bf16*)(ws + WS_WIN), MT, D_IN, D, D}; pg8::StaticOrder S; S.init(MT, D_IN, G, bx);
            pg8::EpiSplit E{Ub, Gb, Pb, GTb};
            pg8::gemm_phase<pg8::EpiSplit, pg8::StaticOrder, true, true>(lds, g, S, E);
        }
        SEAM(pb + 1);
        if (ON(3) && IN(pb + 2)) REPS(3) {
            const int npool = last ? 1024 : 1088;
            { WL(); const int nit = NLAT + NCTX, nfull = (nit / NGW) * NGW;
              for (int r = 0;; ++r) { const int it = (r * NGW < nfull) ? r * NGW + gw : nfull + wave * G + bx; if (r * NGW > nfull || it >= nit) break;
                  scan_task<false>(a, lds, l, it, wave, lane); } }
            __syncthreads();
            for (int it = bx; it < npool; it += G) pool_item(a, lds, l, it);
        }
        SEAM(pb + 2);
        if (ON(4) && IN(pb + 3)) REPS(4) carry_phase(a);
        SEAM(pb + 3);
        if (ON(5) && IN(pb + 4)) REPS(5) { WL(); const int nit = last ? NLAT : NLAT + NCTX, nfull = (nit / NGW) * NGW;
            for (int r = 0;; ++r) { const int it = (r * NGW < nfull) ? r * NGW + gw : nfull + wave * G + bx; if (r * NGW > nfull || it >= nit) break;
                scan_task<true>(a, lds, l, it, wave, lane); } }
        SEAM(pb + 4);
        if (ON(6) && IN(pb + 5)) REPS(6) {
            { pg8::Gemm g{PMb, (const bf16*)(ws + WS_WPO), Mrest, D, D_POOL, D_POOL}; pg8::StaticOrder S; S.init(Mrest, D, G, bx);
              pg8::EpiGate<0> E{Ub, GTb}; pg8::gemm_phase<pg8::EpiGate<0>, pg8::StaticOrder, true, true>(lds, g, S, E); }
            { pg8::Gemm g{Hb, (const bf16*)(ws + WS_WLO), Mrest, D, D, D}; pg8::StaticOrder S; S.init(Mrest, D, G, bx);
              pg8::EpiGate<1> E{Ub, GTb}; pg8::gemm_phase<pg8::EpiGate<1>, pg8::StaticOrder, true, true>(lds, g, S, E); }
        }
        SEAM(pb + 5);
        if (ON(7) && IN(pb + 6)) {
            { pg8::Gemm g{Ub, (const bf16*)(ws + WS_WO), ML, D, D, D}; pg8::StaticOrder S; S.init(ML, D, G, bx);
              pg8::EpiRes E{xsrcL, xsrcC, a.out, XC, modl + 2 * D};
              pg8::gemm_phase<pg8::EpiRes, pg8::StaticOrder, true, true>(lds, g, S, E); }
            if (!last) {
              int ksl = 256; asm volatile("" : "+s"(ksl));
              pg8::Gemm g{Ub + (size_t)ML * D, (const bf16*)(ws + WS_WO), MC, D, ksl, D}; pg8::SplitOrder S; S.init(MC, D, D, ksl, G, bx);
              pg8::EpiSlab E{(float*)(ws + WS_SLAB3)};
              pg8::gemm_phase<pg8::EpiSlab, pg8::SplitOrder, true, true>(lds, g, S, E); }
        }
        SEAM(pb + 6);
        if (ON(8) && IN(pb + 7)) REPS(8) { WL(); norm_rows(a.out, l == 0 ? a.in[I_CTX] : XC, Hb, a.in[I_N2G] + l * D, modl, 3, 4, Mrest, gw, NGW, lane, l == 0 ? (const float*)(ws + WS_SLAB3) : nullptr, modl + 4 * MODW + 2 * D  , XC); }
        SEAM(pb + 7);
        if (ON(9) && IN(pb + 8)) REPS(9) {
            pg8::Gemm g{Hb, (const bf16*)(ws + WS_W1), Mrest, D_FF, D, D}; pg8::StaticOrder S; S.init(Mrest, D_FF, G, bx);
            pg8::EpiSqRelu E{Fb, D_FF};
            pg8::gemm_phase<pg8::EpiSqRelu, pg8::StaticOrder, true, true>(lds, g, S, E);
        }
        SEAM(pb + 8);
        if (ON(10) && IN(pb + 9)) {
            { pg8::Gemm g{Fb, (const bf16*)(ws + WS_W2), ML, D, D_FF, D_FF}; pg8::StaticOrder S; S.init(ML, D, G, bx);
              pg8::EpiRes E{a.out, XC, a.out, XC, modl + 5 * D};
              pg8::gemm_phase<pg8::EpiRes, pg8::StaticOrder, true, true>(lds, g, S, E); }
            if (!last) {
              int ksl = 1024; asm volatile("" : "+s"(ksl));
              pg8::Gemm g{Fb + (size_t)ML * D_FF, (const bf16*)(ws + WS_W2), MC, D, ksl, D_FF}; pg8::SplitOrder S; S.init(MC, D, D_FF, ksl, G, bx);
              pg8::EpiSlab E{(float*)(ws + WS_SLAB5)};
              pg8::gemm_phase<pg8::EpiSlab, pg8::SplitOrder, true, true>(lds, g, S, E); }
        }
        SEAM(pb + 9);
    }
    if (ON(11) && IN(21)) { WL(); final_rows(a.out, a.in[I_FG], gw, NGW, lane); }
#undef IN
#undef SEAM
}

extern "C" void kernel_launch(void* const* d_in, const int* in_sizes, int n_in, void* d_out, int out_size, void* d_ws, size_t ws_size, hipStream_t stream) {
    static int grid = 0;
    if (grid == 0) {
        if (n_in != 24 || out_size != ML * D || ws_size < WS_END) { fprintf(stderr, "kernel_launch: unexpected shapes (n_in %d, out %d, ws %zu)\n", n_in, out_size, ws_size); grid = -1; return; }
        int dev = 0, cus = 0, per_cu = 0;
        if (hipGetDevice(&dev) != hipSuccess || hipDeviceGetAttribute(&cus, hipDeviceAttributeMultiprocessorCount, dev) != hipSuccess) { grid = -1; return; }
        if (hipFuncSetAttribute((const void*)mk_fwd, hipFuncAttributeMaxDynamicSharedMemorySize, LDS_BYTES) != hipSuccess) { fprintf(stderr, "kernel_launch: hipFuncSetAttribute failed\n"); grid = -1; return; }
        if (hipOccupancyMaxActiveBlocksPerMultiprocessor(&per_cu, (const void*)mk_fwd, 512, LDS_BYTES) != hipSuccess || per_cu < 1) { fprintf(stderr, "kernel_launch: occupancy query says %d\n", per_cu); per_cu = 1; }
        (void)hipGetLastError();
        grid = cus;
    }
    if (grid < 0) return;
    Args a{};
    for (int i = 0; i < 24; ++i) a.in[i] = (const float*)d_in[i];
    a.out = (float*)d_out; a.ws = (unsigned char*)d_ws;
#if MK_PER_PHASE
    for (int p = 0; p < NPHASE; ++p) { a.lo = p; a.hi = p + 1; hipLaunchKernelGGL(mk_fwd, dim3(grid), dim3(512), LDS_BYTES, stream, a); }
#else
    a.lo = 0; a.hi = NPHASE;
    if (hipMemsetAsync((char*)d_ws + WS_BAR, 0, 16384, stream) != hipSuccess) { fprintf(stderr, "kernel_launch: memset of the barrier words failed\n"); return; }
    void* args[] = {&a};
    hipError_t e = hipLaunchCooperativeKernel((const void*)mk_fwd, dim3(grid), dim3(512), args, LDS_BYTES, stream);
    if (e != hipSuccess) fprintf(stderr, "kernel_launch: cooperative launch failed: %s (grid %d)\n", hipGetErrorString(e), grid);
#endif
}
```

```cpp
#include <hip/hip_runtime.h>
#include <hip/hip_cooperative_groups.h>
#include <cstdio>
#include <cstdint>
namespace cg = cooperative_groups;
#ifndef MK_PER_PHASE
#define MK_PER_PHASE 0
#endif
__device__ __forceinline__ int opaque_tid() { int t = threadIdx.x; asm volatile("" : "+v"(t) : : "memory"); return t; }
namespace pg8 {
#define PG8_LAS __attribute__((address_space(3)))
typedef unsigned short bf16_t;
typedef short bf16x8 __attribute__((ext_vector_type(8)));
typedef float f32x4 __attribute__((ext_vector_type(4)));
typedef unsigned u32x4 __attribute__((ext_vector_type(4)));
constexpr int BM = 256, BK = 64, HALF = 128, HTB = HALF * BK * 2  , STAGE_BYTES = 8 * HTB, NXCD = 8, WGM = 8;

__host__ __device__ __forceinline__ int lds_byte(int r, int c) { const int st = (r >> 4) * 2 + (c >> 5), rr = r & 15, cc = c & 31, ob = rr * 64 + cc * 2; return st * 1024 + (ob ^ (((ob >> 9) & 1) << 5)); }
__host__ __device__ __forceinline__ void stage_rc(int b, int& R, int& C) { const int st = b / 1024, sb = b % 1024, swz = sb ^ (((sb >> 9) & 1) << 5); R = (st >> 1) * 16 + swz / 64; C = (st & 1) * 32 + (swz % 64) / 2; }
__host__ __device__ __forceinline__ int perm32(int rho) { const int n = rho >> 4, i = rho & 15; return 8 * (i >> 2) + 4 * n + (i & 3); }

struct Unit { int pm, pn, kb, ks; };
struct Gemm { const bf16_t* A; const bf16_t* Bt; int M, N, K, ld; };

struct StaticOrder {
    int nM, nN, nwg, G, c;
    __host__ __device__ void init(int M, int N, int G_, int c_) { nM = M / BM; nN = N / BM; nwg = nM * nN; G = G_; c = c_; }
    __host__ __device__ bool next(int i, Unit& u) const {
        const long L = (long)i * G + c; if (L >= nwg) return false;
        int wgid = (int)L; { const int q = nwg / NXCD, r = nwg % NXCD, xcd = wgid % NXCD, off = wgid / NXCD; wgid = (xcd < r ? xcd * (q + 1) : r * (q + 1) + (xcd - r) * q) + off; }
        const int nig = WGM * nN, gid = wgid / nig, fm = gid * WGM, gsz = (nM - fm) < WGM ? (nM - fm) : WGM;
        u.pm = fm + ((wgid % nig) % gsz); u.pn = (wgid % nig) / gsz; u.kb = 0; u.ks = 0; return true;
    }
    __device__ __forceinline__ void a_ready(const Unit&) const {}
    __device__ __forceinline__ void done(const Unit&) const {}
};
struct SplitOrder {
    int nN, nS, ksl, ntot, G, c;
    __host__ __device__ void init(int M, int N, int Kfull, int ksl_, int G_, int c_) { nN = N / BM; nS = Kfull / ksl_; ksl = ksl_; ntot = (M / BM) * nN * nS; G = G_; c = c_; }
    __host__ __device__ bool next(int i, Unit& u) const { const int j = i * G + c; if (j >= ntot) return false; const int ks = j % nS, t = j / nS; u.pn = t % nN; u.pm = t / nN; u.kb = ks * ksl; u.ks = ks; return true; }
    __device__ __forceinline__ void a_ready(const Unit&) const {}
    __device__ __forceinline__ void done(const Unit&) const {}
};
__device__ __forceinline__ unsigned cvt_pk_bf16(float lo, float hi) { unsigned r; asm volatile("v_cvt_pk_bf16_f32 %0, %1, %2" : "=v"(r) : "v"(lo), "v"(hi)); return r; }
__device__ __forceinline__ float bf_lo(unsigned w) { return __uint_as_float(w << 16); }
__device__ __forceinline__ float bf_hi(unsigned w) { return __uint_as_float(w & 0xffff0000u); }
__device__ __forceinline__ float sigm(float x) { return __builtin_amdgcn_rcpf(1.0f + __expf(-x)); }

struct EpiSplit {
    static constexpr bool PERM = true, AFTER_DRAIN = false;
    bf16_t *U, *G, *P, *GT;
    __device__ __forceinline__ void operator()(const f32x4 (&acc)[2][2][4][2], const Unit& u, int wr, int wc, int fr, int fq) const {
        bf16_t* base; int ldc, colt;
        if (u.pn < 4) { base = U; ldc = 1024; colt = u.pn * 256; }
        else if (u.pn < 8) { base = G; ldc = 1024; colt = (u.pn - 4) * 256; }
        else if (u.pn < 10) { base = P; ldc = 512; colt = (u.pn - 8) * 256; }
        else { base = GT; ldc = 2048; colt = (u.pn - 10) * 256; }
        const int row0 = u.pm * BM + wr * 64 + fr, col0 = colt + wc * 32 + 8 * fq;
#pragma unroll
        for (int ai = 0; ai < 2; ++ai)
#pragma unroll
            for (int m = 0; m < 4; ++m) { bf16_t* rowp = base + (size_t)(row0 + ai * HALF + m * 16) * ldc + col0;
#pragma unroll
                for (int bj = 0; bj < 2; ++bj) { const f32x4 v0 = acc[ai][bj][m][0], v1 = acc[ai][bj][m][1];
                    u32x4 w; w.x = cvt_pk_bf16(v0[0], v0[1]); w.y = cvt_pk_bf16(v0[2], v0[3]); w.z = cvt_pk_bf16(v1[0], v1[1]); w.w = cvt_pk_bf16(v1[2], v1[3]);
                    *(u32x4*)(rowp + bj * HALF) = w; } }
    }
};
template <int MODE> struct EpiGate {
    static constexpr bool PERM = true, AFTER_DRAIN = false;
    bf16_t* Z; const bf16_t* GT;
    __device__ __forceinline__ void operator()(const f32x4 (&acc)[2][2][4][2], const Unit& u, int wr, int wc, int fr, int fq) const {
        const int row0 = u.pm * BM + wr * 64 + fr, col0 = u.pn * BM + wc * 32 + 8 * fq;
#pragma unroll
        for (int ai = 0; ai < 2; ++ai)
#pragma unroll
            for (int m = 0; m < 4; ++m) { const size_t row = (size_t)(row0 + ai * HALF + m * 16);
#pragma unroll
                for (int bj = 0; bj < 2; ++bj) { const int col = col0 + bj * HALF;
                    const u32x4 gt = *(const u32x4*)(GT + row * 2048 + (MODE == 0 ? 1024 : 0) + col);
                    f32x4 v0 = acc[ai][bj][m][0], v1 = acc[ai][bj][m][1];
                    v0[0] *= sigm(bf_lo(gt.x)); v0[1] *= sigm(bf_hi(gt.x)); v0[2] *= sigm(bf_lo(gt.y)); v0[3] *= sigm(bf_hi(gt.y));
                    v1[0] *= sigm(bf_lo(gt.z)); v1[1] *= sigm(bf_hi(gt.z)); v1[2] *= sigm(bf_lo(gt.w)); v1[3] *= sigm(bf_hi(gt.w));
                    u32x4* zp = (u32x4*)(Z + row * 1024 + col);
                    if (MODE == 1) { const u32x4 z = *zp;
                        v0[0] += bf_lo(z.x); v0[1] += bf_hi(z.x); v0[2] += bf_lo(z.y); v0[3] += bf_hi(z.y);
                        v1[0] += bf_lo(z.z); v1[1] += bf_hi(z.z); v1[2] += bf_lo(z.w); v1[3] += bf_hi(z.w); }
                    u32x4 w; w.x = cvt_pk_bf16(v0[0], v0[1]); w.y = cvt_pk_bf16(v0[2], v0[3]); w.z = cvt_pk_bf16(v1[0], v1[1]); w.w = cvt_pk_bf16(v1[2], v1[3]);
                    *zp = w; }
                asm volatile("" ::: "memory"); }
    }
};
struct EpiRes {
    static constexpr bool PERM = false, AFTER_DRAIN = false;
    const float* srcL; const float* srcC; float* dstL; float* dstC; const float* gate;
    __device__ __forceinline__ void operator()(const f32x4 (&acc)[2][2][4][2], const Unit& u, int wr, int wc, int fr, int fq) const {
        const bool lat = u.pm < 64;
        const size_t tb = (size_t)(lat ? u.pm : u.pm - 64) * 256 * 1024;
        const float* src = (lat ? srcL : srcC) + tb; float* dst = (lat ? dstL : dstC) + tb;
        const float* gv = gate + (lat ? (u.pm >> 4) : 4) * 6144;
        const int rl0 = wr * 64 + fr, col0 = u.pn * BM + wc * 32 + 4 * fq;
        f32x4 g[2][2];
#pragma unroll
        for (int bj = 0; bj < 2; ++bj)
#pragma unroll
            for (int n = 0; n < 2; ++n) g[bj][n] = *(const f32x4*)(gv + col0 + bj * HALF + n * 16);
#pragma unroll
        for (int ai = 0; ai < 2; ++ai)
#pragma unroll
            for (int m = 0; m < 4; ++m) { const size_t off = (size_t)(rl0 + ai * HALF + m * 16) * 1024 + col0;
#pragma unroll
                for (int bj = 0; bj < 2; ++bj)
#pragma unroll
                    for (int n = 0; n < 2; ++n) { const f32x4 s = *(const f32x4*)(src + off + bj * HALF + n * 16);
                        *(f32x4*)(dst + off + bj * HALF + n * 16) = s + g[bj][n] * acc[ai][bj][m][n]; }
                if (m == 3) asm volatile("" ::: "memory"); }
    }
};
struct EpiSqRelu {
    static constexpr bool PERM = true, AFTER_DRAIN = false;
    bf16_t* F; int ldc;
    __device__ __forceinline__ void operator()(const f32x4 (&acc)[2][2][4][2], const Unit& u, int wr, int wc, int fr, int fq) const {
        const int row0 = u.pm * BM + wr * 64 + fr, col0 = u.pn * BM + wc * 32 + 8 * fq;
#pragma unroll
        for (int ai = 0; ai < 2; ++ai)
#pragma unroll
            for (int m = 0; m < 4; ++m) { bf16_t* rowp = F + (size_t)(row0 + ai * HALF + m * 16) * ldc + col0;
#pragma unroll
                for (int bj = 0; bj < 2; ++bj) { f32x4 v0 = acc[ai][bj][m][0], v1 = acc[ai][bj][m][1];
#pragma unroll
                    for (int j = 0; j < 4; ++j) { const float a0 = fmaxf(v0[j], 0.f), a1 = fmaxf(v1[j], 0.f); v0[j] = a0 * a0; v1[j] = a1 * a1; }
                    u32x4 w; w.x = cvt_pk_bf16(v0[0], v0[1]); w.y = cvt_pk_bf16(v0[2], v0[3]); w.z = cvt_pk_bf16(v1[0], v1[1]); w.w = cvt_pk_bf16(v1[2], v1[3]);
                    *(u32x4*)(rowp + bj * HALF) = w; } }
    }
};

struct EpiSlab {
    static constexpr bool PERM = false, AFTER_DRAIN = false;
    float* slab;
    __device__ __forceinline__ void operator()(const f32x4 (&acc)[2][2][4][2], const Unit& u, int wr, int wc, int fr, int fq) const {
        float* p0 = slab + ((size_t)u.ks * 1024 + u.pm * BM + wr * 64 + fr) * 1024 + u.pn * BM + wc * 32 + 4 * fq;
#pragma unroll
        for (int ai = 0; ai < 2; ++ai)
#pragma unroll
            for (int m = 0; m < 4; ++m) { float* rowp = p0 + (size_t)(ai * HALF + m * 16) * 1024;
#pragma unroll
                for (int bj = 0; bj < 2; ++bj)
#pragma unroll
                    for (int n = 0; n < 2; ++n) *(f32x4*)(rowp + bj * HALF + n * 16) = acc[ai][bj][m][n]; }
    }
};

template <class Epi, class Sched, bool ALIGN_EPI = false, bool SP2 = false>
__device__ __forceinline__ void gemm_phase(PG8_LAS unsigned char* lds, const Gemm g, const Sched& S, const Epi& E) {
    const int tid = opaque_tid(), wid = __builtin_amdgcn_readfirstlane(tid >> 6), lane = tid & 63, wr = wid >> 2, wc = wid & 3, fr = lane & 15, fq = lane >> 4;
    const int K = g.ld, nt = g.K / BK;
    unsigned voffA[2], voffB[2];
#pragma unroll
    for (int i = 0; i < 2; ++i) { int R, C; stage_rc(tid * 16 + i * 8192, R, C); const int Rb = Epi::PERM ? ((R & ~31) + perm32(R & 31)) : R;
        voffA[i] = (unsigned)(R * K + C) * 2u; voffB[i] = (unsigned)(Rb * K + C) * 2u; }
    const size_t kstep = (size_t)(BK * 2);
    const size_t hstep = (size_t)HALF * K * 2;
    const size_t tstep = 2 * hstep;
    const unsigned ldsw = (unsigned)wid * 1024u;
    const int aoff = lds_byte(wr * 64 + fr, fq * 8), boff = lds_byte(wc * 32 + fr, fq * 8);
#define PG8_SA(b, h) (((b) * 2 + (h)) * HTB)
#define PG8_SB(b, h) ((4 + (b) * 2 + (h)) * HTB)
#define PG8_STAGE(bufoff, gbase, voff) do { _Pragma("unroll") for (int _i = 0; _i < 2; ++_i) \
        __builtin_amdgcn_global_load_lds((const unsigned*)((const char*)(gbase) + (voff)[_i]), (PG8_LAS unsigned*)(lds + (bufoff) + ldsw + _i * 8192), 16, 0, 0); } while (0)
#define PG8_LDA(dst, b, h) do { _Pragma("unroll") for (int m = 0; m < 4; ++m) _Pragma("unroll") for (int k = 0; k < 2; ++k) dst[m][k] = *(const PG8_LAS bf16x8*)(lds + PG8_SA(b, h) + aoff + m * 2048 + k * 1024); } while (0)
#define PG8_LDB(dst, b, h) do { _Pragma("unroll") for (int n = 0; n < 2; ++n) _Pragma("unroll") for (int k = 0; k < 2; ++k) dst[n][k] = *(const PG8_LAS bf16x8*)(lds + PG8_SB(b, h) + boff + n * 2048 + k * 1024); } while (0)
#define PG8_MMA(ai, bj, At, Bt) do { __builtin_amdgcn_s_setprio(1); _Pragma("unroll") for (int m = 0; m < 4; ++m) _Pragma("unroll") for (int n = 0; n < 2; ++n) _Pragma("unroll") for (int k = 0; k < 2; ++k) \
        acc[ai][bj][m][n] = __builtin_amdgcn_mfma_f32_16x16x32_bf16(Bt[n][k], At[m][k], acc[ai][bj][m][n], 0, 0, 0); __builtin_amdgcn_s_setprio(0); } while (0)
#define PG8_WAIT_V(n) asm volatile("s_waitcnt vmcnt(" #n ")" ::: "memory")
#define PG8_WAIT_L(n) asm volatile("s_waitcnt lgkmcnt(" #n ")" ::: "memory")
#define PG8_BAR __builtin_amdgcn_s_barrier()
#define PG8_SCHED __builtin_amdgcn_sched_barrier(0)
    Unit cur, nxt; int ui = 0;
    if (!S.next(0, cur)) return;
    f32x4 acc[2][2][4][2];
#pragma unroll
    for (int a = 0; a < 2; ++a)
#pragma unroll
        for (int b = 0; b < 2; ++b)
#pragma unroll
            for (int m = 0; m < 4; ++m)
#pragma unroll
                for (int n = 0; n < 2; ++n) acc[a][b][m][n] = (f32x4){0.f, 0.f, 0.f, 0.f};
    bf16x8 At[4][2], B0[2][2], B1[2][2];
    const char* cA = (const char*)g.A + (size_t)cur.pm * tstep + (size_t)cur.kb * 2; const char* cB = (const char*)g.Bt + (size_t)cur.pn * tstep + (size_t)cur.kb * 2;
    S.a_ready(cur);
    if constexpr (SP2) {
        PG8_STAGE(PG8_SB(0, 0), cB, voffB); PG8_STAGE(PG8_SB(0, 1), cB + hstep, voffB); PG8_STAGE(PG8_SA(0, 0), cA, voffA); PG8_STAGE(PG8_SA(0, 1), cA + hstep, voffA);
        if (wr == 1) PG8_BAR;
        PG8_WAIT_V(2); PG8_BAR;
        PG8_STAGE(PG8_SB(1, 0), cB + kstep, voffB); PG8_STAGE(PG8_SA(1, 0), cA + kstep, voffA); PG8_STAGE(PG8_SB(1, 1), cB + hstep + kstep, voffB);
        PG8_WAIT_V(6); PG8_BAR;
    } else {
        PG8_STAGE(PG8_SB(0, 0), cB, voffB); PG8_STAGE(PG8_SA(0, 0), cA, voffA); PG8_STAGE(PG8_SB(0, 1), cB + hstep, voffB); PG8_STAGE(PG8_SA(0, 1), cA + hstep, voffA);
        if (wr == 1) PG8_BAR;
        PG8_WAIT_V(4); PG8_BAR;
        PG8_STAGE(PG8_SB(1, 0), cB + kstep, voffB); PG8_STAGE(PG8_SA(1, 0), cA + kstep, voffA); PG8_STAGE(PG8_SB(1, 1), cB + hstep + kstep, voffB);
        PG8_WAIT_V(6); PG8_BAR;
    }
    for (;;) {
        const bool has_next = S.next(ui + 1, nxt);
        const char* nA = has_next ? (const char*)g.A + (size_t)nxt.pm * tstep + (size_t)nxt.kb * 2 : cA; const char* nB = has_next ? (const char*)g.Bt + (size_t)nxt.pn * tstep + (size_t)nxt.kb * 2 : cB;
        for (int t = 0; t < nt; t += 2) {
            const bool last = (t == nt - 2);
            const char* a1 = cA + (size_t)(t + 1) * kstep;
            const char* a2 = last ? nA : cA + (size_t)(t + 2) * kstep; const char* b2 = last ? nB : cB + (size_t)(t + 2) * kstep;
            const char* a3 = a2 + kstep; const char* b3 = b2 + kstep;
            if (last && has_next) S.a_ready(nxt);
            if constexpr (SP2) {
            PG8_LDB(B0, 0, 0); PG8_LDB(B1, 0, 1); PG8_SCHED; PG8_LDA(At, 0, 0); PG8_STAGE(PG8_SA(1, 1), a1 + hstep, voffA);
            PG8_WAIT_V(8); PG8_WAIT_L(0); PG8_BAR; PG8_MMA(0, 0, At, B0); PG8_MMA(0, 1, At, B1); PG8_BAR; PG8_SCHED;
            PG8_LDA(At, 0, 1); PG8_STAGE(PG8_SB(0, 0), b2, voffB); PG8_STAGE(PG8_SB(0, 1), b2 + hstep, voffB); PG8_STAGE(PG8_SA(0, 0), a2, voffA);
            PG8_WAIT_V(8); PG8_WAIT_L(0); PG8_BAR; PG8_MMA(1, 0, At, B0); PG8_MMA(1, 1, At, B1); PG8_BAR; PG8_SCHED;
            PG8_LDB(B0, 1, 0); PG8_LDB(B1, 1, 1); PG8_SCHED; PG8_LDA(At, 1, 0); PG8_STAGE(PG8_SA(0, 1), a2 + hstep, voffA);
            PG8_WAIT_V(8); PG8_WAIT_L(0); PG8_BAR; PG8_MMA(0, 0, At, B0); PG8_MMA(0, 1, At, B1); PG8_BAR; PG8_SCHED;
            PG8_LDA(At, 1, 1); PG8_STAGE(PG8_SB(1, 0), b3, voffB); PG8_STAGE(PG8_SB(1, 1), b3 + hstep, voffB); PG8_STAGE(PG8_SA(1, 0), a3, voffA);
            PG8_WAIT_V(8); PG8_WAIT_L(0); PG8_BAR; PG8_MMA(1, 0, At, B0); PG8_MMA(1, 1, At, B1); PG8_BAR; PG8_SCHED;
            } else {
            PG8_LDB(B0, 0, 0); PG8_SCHED; PG8_LDA(At, 0, 0); PG8_STAGE(PG8_SA(1, 1), a1 + hstep, voffA);
            PG8_WAIT_L(8); PG8_BAR; PG8_WAIT_L(0); PG8_MMA(0, 0, At, B0); PG8_BAR; PG8_SCHED;
            PG8_LDB(B1, 0, 1); PG8_STAGE(PG8_SB(0, 0), b2, voffB);
            PG8_BAR; PG8_WAIT_L(0); PG8_MMA(0, 1, At, B1); PG8_BAR;
            PG8_LDA(At, 0, 1); PG8_STAGE(PG8_SA(0, 0), a2, voffA);
            PG8_BAR; PG8_WAIT_L(0); PG8_MMA(1, 0, At, B0); PG8_BAR; PG8_SCHED;
            PG8_STAGE(PG8_SB(0, 1), b2 + hstep, voffB);
            PG8_WAIT_V(6); PG8_BAR; PG8_MMA(1, 1, At, B1); PG8_BAR;
            PG8_LDB(B0, 1, 0); PG8_SCHED; PG8_LDA(At, 1, 0); PG8_STAGE(PG8_SA(0, 1), a2 + hstep, voffA);
            PG8_WAIT_L(8); PG8_BAR; PG8_WAIT_L(0); PG8_MMA(0, 0, At, B0); PG8_BAR; PG8_SCHED;
            PG8_LDB(B1, 1, 1); PG8_STAGE(PG8_SB(1, 0), b3, voffB);
            PG8_BAR; PG8_WAIT_L(0); PG8_MMA(0, 1, At, B1); PG8_BAR;
            PG8_LDA(At, 1, 1); PG8_STAGE(PG8_SA(1, 0), a3, voffA);
            PG8_BAR; PG8_WAIT_L(0); PG8_MMA(1, 0, At, B0); PG8_BAR; PG8_SCHED;
            PG8_STAGE(PG8_SB(1, 1), b3 + hstep, voffB);
            PG8_WAIT_V(6); PG8_BAR; PG8_MMA(1, 1, At, B1); PG8_BAR;
            }
        }
        if constexpr (ALIGN_EPI) { if (wr == 0) PG8_BAR; }
        if constexpr (!Epi::AFTER_DRAIN) { E(acc, cur, wr, wc, fr, fq); S.done(cur); }
        if (!has_next) break;
#pragma unroll
        for (int a = 0; a < 2; ++a)
#pragma unroll
            for (int b = 0; b < 2; ++b)
#pragma unroll
                for (int m = 0; m < 4; ++m)
#pragma unroll
                    for (int n = 0; n < 2; ++n) acc[a][b][m][n] = (f32x4){0.f, 0.f, 0.f, 0.f};
        cur = nxt; cA = nA; cB = nB; ++ui;
        if constexpr (ALIGN_EPI) { if (wr == 1) PG8_BAR; }
    }
    PG8_WAIT_V(0);
    if constexpr (!ALIGN_EPI) { if (wr == 0) PG8_BAR; }
    PG8_BAR;
    if constexpr (Epi::AFTER_DRAIN) { E.fused(acc, cur, wr, wc, fr, fq, lds, wid, lane); S.done(cur); }
#undef PG8_SA
#undef PG8_SB
#undef PG8_STAGE
#undef PG8_LDA
#undef PG8_LDB
#undef PG8_MMA
#undef PG8_WAIT_V
#undef PG8_WAIT_L
#undef PG8_BAR
#undef PG8_SCHED
}
}
constexpr int D = 1024, NB = 4, SEQ = 4096, CTX = 256, DEPTH = 2;
constexpr int ML = NB * SEQ, MC = NB * CTX, MT = ML + MC;
constexpr int D_IN = 4608, D_POOL = 512, D_FF = 4096, MODW = 6 * D;
constexpr int TCH = 64;
constexpr int NSUB = TCH / 32, NCL = SEQ / TCH, NCC = CTX / TCH, NLAT = NB * NCL * 16, NCTX = NB * NCC * 16;
constexpr int NQ = NCC + NCL;
constexpr float EPS = 1e-6f;
constexpr size_t MiB = 1u << 20;
constexpr size_t WS_MOD = 0;
constexpr size_t WS_BAR = 256 * 1024;
constexpr size_t WS_SUMM = 244 * MiB;
constexpr size_t WS_CARRY = WS_SUMM + (size_t)NB * 2 * NQ * 2 * 1024 * 4;
constexpr size_t WS_XC = 4 * MiB;
constexpr size_t WS_WIN = 8 * MiB, WS_WLO = 17 * MiB, WS_WPO = 19 * MiB, WS_WO = 20 * MiB, WS_W1 = 22 * MiB, WS_W2 = 30 * MiB;
constexpr size_t WS_GW = 38 * MiB;
constexpr size_t WS_PW = 39 * MiB;
constexpr size_t WS_H = 40 * MiB;
constexpr size_t WS_U = 74 * MiB;
constexpr size_t WS_G = 108 * MiB;
constexpr size_t WS_P = 142 * MiB;
constexpr size_t WS_GT = 159 * MiB;
constexpr size_t WS_PM = 227 * MiB;
constexpr size_t WS_SLAB3 = WS_G;
constexpr size_t WS_SLAB5 = 210 * MiB;
constexpr size_t WS_F = WS_U;
constexpr size_t WS_END = 256 * MiB;
static_assert(WS_CARRY + (size_t)NB * 2 * NQ * 1024 * 4 <= 256 * MiB, "ws map (tail)");
static_assert(WS_F + (size_t)MT * D_FF * 2 <= WS_PM && WS_H + (size_t)MT * D * 2 <= WS_U && WS_GT + (size_t)MT * 2048 * 2 <= WS_PM, "ws map");
constexpr int LDS_BYTES = 8 * 19456 + 256, MISC_OFF = 8 * 19456;

#define LAS __attribute__((address_space(3)))
typedef unsigned short bf16;
typedef unsigned u32x4 __attribute__((ext_vector_type(4)));
typedef unsigned u32x2 __attribute__((ext_vector_type(2)));
typedef float f32x4 __attribute__((ext_vector_type(4)));
typedef float f32x16 __attribute__((ext_vector_type(16)));
typedef short bf16x8 __attribute__((ext_vector_type(8)));
using pg8::cvt_pk_bf16; using pg8::bf_lo; using pg8::bf_hi; using pg8::sigm;

struct Args { const float* in[24]; float* out; unsigned char* ws; int lo, hi; };
enum { I_X = 0, I_C, I_CTX, I_CCTX, I_WADA, I_BADA, I_N1G, I_N2G, I_WIN, I_CONVW, I_CONVB, I_WR, I_BR, I_WI, I_BI, I_LAM, I_WLO, I_POOLW, I_POOLS, I_WPO, I_WO, I_W1, I_W2, I_FG };

__device__ __forceinline__ float wave_sum(float v) {
#pragma unroll
    for (int o = 1; o < 64; o <<= 1) v += __shfl_xor(v, o);
    return v;
}
__device__ __forceinline__ float gelu_tanh(float x) { const float z = 0.7978845608f * (x + 0.044715f * x * x * x); const float e = __expf(2.f * z); return 0.5f * x * (2.f - 2.f * __builtin_amdgcn_rcpf(e + 1.f)); }

__device__ __forceinline__ void mod_item(const Args& a, LAS unsigned char* lds, int item) {
    const int tid = opaque_tid(), l = item / 96, cb = item % 96, cq = tid & 15, kg = tid >> 4;
    LAS float* s = (LAS float*)lds;
    LAS float* part = (LAS float*)(lds + 20480);
    const float* c = a.in[I_C]; const float* cc = a.in[I_CCTX];
    for (int i = tid; i < 5120; i += 512) { const int r = i >> 10, k = i & 1023; const float v = r < 4 ? c[r * 1024 + k] : cc[k]; s[i] = v * sigm(v); }
    __syncthreads();
    const float* W = a.in[I_WADA] + (size_t)l * D * MODW + cb * 64 + cq * 4;
    float acc[5][4];
#pragma unroll
    for (int r = 0; r < 5; ++r)
#pragma unroll
        for (int j = 0; j < 4; ++j) acc[r][j] = 0.f;
#pragma unroll 8
    for (int kk = 0; kk < 32; ++kk) { const int k = kg * 32 + kk; const f32x4 w = *(const f32x4*)(W + (size_t)k * MODW);
#pragma unroll
        for (int r = 0; r < 5; ++r) { const float sv = s[r * 1024 + k];
#pragma unroll
            for (int j = 0; j < 4; ++j) acc[r][j] += sv * w[j]; } }
#pragma unroll
    for (int r = 0; r < 5; ++r)
#pragma unroll
        for (int j = 0; j < 4; ++j) part[(kg * 5 + r) * 64 + cq * 4 + j] = acc[r][j];
    __syncthreads();
    if (tid < 320) { const int r = tid >> 6, col = tid & 63; float t = 0.f;
#pragma unroll 8
        for (int g = 0; g < 32; ++g) t += part[(g * 5 + r) * 64 + col];
        ((float*)(a.ws + WS_MOD))[(size_t)(l * 5 + r) * MODW + cb * 64 + col] = t + a.in[I_BADA][l * MODW + cb * 64 + col]; }
    __syncthreads();
}
__device__ __forceinline__ void transpose_item(const float* W, int K, int N, bf16* WT, LAS float* scr, int item, int lane) {
    const int nblk = N / 32, kb = item / nblk, nb = item % nblk, k0 = 64 * kb, n0 = 32 * nb;
    f32x4 v[8];
#pragma unroll
    for (int i = 0; i < 8; ++i) v[i] = *(const f32x4*)(W + (size_t)(k0 + 8 * i + (lane >> 3)) * N + n0 + 4 * (lane & 7));
#pragma unroll
    for (int i = 0; i < 8; ++i) { LAS float* d = scr + (8 * i + (lane >> 3)) * 33 + 4 * (lane & 7); d[0] = v[i].x; d[1] = v[i].y; d[2] = v[i].z; d[3] = v[i].w; }
    asm volatile("s_waitcnt lgkmcnt(0)" ::: "memory");
    const int c = lane & 7;
#pragma unroll
    for (int j = 0; j < 4; ++j) { const int n = (lane >> 3) + 8 * j; const LAS float* s = scr + (8 * c) * 33 + n;
        u32x4 o; o.x = cvt_pk_bf16(s[0 * 33], s[1 * 33]); o.y = cvt_pk_bf16(s[2 * 33], s[3 * 33]); o.z = cvt_pk_bf16(s[4 * 33], s[5 * 33]); o.w = cvt_pk_bf16(s[6 * 33], s[7 * 33]);
        *(u32x4*)(WT + (size_t)(n0 + n) * K + k0 + 8 * c) = o; }
    asm volatile("s_waitcnt lgkmcnt(0)" ::: "memory");
}
__device__ __forceinline__ void convert_big(const Args& a, LAS unsigned char* lds, int l, int gw, int NGW, int wave, int lane) {
    LAS float* scr = (LAS float*)(lds + wave * 16384);
    constexpr int I_IN = (D / 64) * (D_IN / 32), I_LO = (D / 64) * (D / 32), I_PO = (D_POOL / 64) * (D / 32), I_O = I_LO, I_1 = (D / 64) * (D_FF / 32), I_2 = (D_FF / 64) * (D / 32);
    constexpr int NIT = I_IN + I_LO + I_PO + I_O + I_1 + I_2;
    unsigned char* ws = a.ws;
    for (int it = gw; it < NIT; it += NGW) { int r = it;
        if (r < I_IN) { transpose_item(a.in[I_WIN] + (size_t)l * D * D_IN, D, D_IN, (bf16*)(ws + WS_WIN), scr, r, lane); continue; } r -= I_IN;
        if (r < I_LO) { transpose_item(a.in[I_WLO] + (size_t)l * D * D, D, D, (bf16*)(ws + WS_WLO), scr, r, lane); continue; } r -= I_LO;
        if (r < I_PO) { transpose_item(a.in[I_WPO] + (size_t)l * D_POOL * D, D_POOL, D, (bf16*)(ws + WS_WPO), scr, r, lane); continue; } r -= I_PO;
        if (r < I_O) { transpose_item(a.in[I_WO] + (size_t)l * D * D, D, D, (bf16*)(ws + WS_WO), scr, r, lane); continue; } r -= I_O;
        if (r < I_1) { transpose_item(a.in[I_W1] + (size_t)l * D * D_FF, D, D_FF, (bf16*)(ws + WS_W1), scr, r, lane); continue; } r -= I_1;
        transpose_item(a.in[I_W2] + (size_t)l * D_FF * D, D_FF, D, (bf16*)(ws + WS_W2), scr, r, lane); }
}
__device__ __forceinline__ void convert_small(const Args& a, LAS unsigned char* lds, int gw, int NGW, int wave, int lane) {
    LAS float* scr = (LAS float*)(lds + wave * 16384);
    for (int it = gw; it < 256 + 64; it += NGW) {
        if (it < 256) { const int mi = it >> 1, sub = it & 1, h = mi & 15, ri = (mi >> 4) & 1, ld = mi >> 5;
            const float* src = a.in[ri ? I_WI : I_WR] + ((size_t)ld * 16 + h) * 4096;
            transpose_item(src, 64, 64, (bf16*)(a.ws + WS_GW) + ((size_t)(ld * 2 + ri) * 16 + h) * 4096, scr, sub, lane); }
        else { const int r = it - 256, mi = r >> 3, sub = r & 7;
            transpose_item(a.in[I_POOLW] + (size_t)mi * 16384, 128, 128, (bf16*)(a.ws + WS_PW) + (size_t)mi * 16384, scr, sub, lane); }
    }
}
__device__ __forceinline__ void norm_rows(const float* xl, const float* xc, bf16* H, const float* gvec, const float* mod  , int shift_i, int scale_i, int nrows, int gw, int NGW, int lane,
                                          const float* slab = nullptr, const float* sgate = nullptr, float* xcw = nullptr) {
    f32x4 vn[4];
    { const int mc = min(gw, nrows - 1); const f32x4* x4 = (const f32x4*)(mc < ML ? xl + (size_t)mc * D : xc + (size_t)(mc - ML) * D) + lane;
#pragma unroll
      for (int j = 0; j < 4; ++j) vn[j] = x4[64 * j]; }
    for (int m = gw; m < nrows; m += NGW) {
        const int r = m < ML ? (m >> 12) : 4;
        f32x4 v[4]; float ss = 0.f;
#pragma unroll
        for (int j = 0; j < 4; ++j) v[j] = vn[j];
        { const int mc = min(m + NGW, nrows - 1); const f32x4* x4 = (const f32x4*)(mc < ML ? xl + (size_t)mc * D : xc + (size_t)(mc - ML) * D) + lane;
#pragma unroll
          for (int j = 0; j < 4; ++j) vn[j] = x4[64 * j]; }
        if (slab != nullptr && m >= ML) {
            const f32x4* s4 = (const f32x4*)(slab + (size_t)(m - ML) * D) + lane; const f32x4* g4s = (const f32x4*)sgate + lane;
#pragma unroll
            for (int j = 0; j < 4; ++j) { const f32x4 t = (s4[64 * j] + s4[64 * j + 262144]) + (s4[64 * j + 2 * 262144] + s4[64 * j + 3 * 262144]); v[j] = v[j] + g4s[64 * j] * t; }
            if (xcw != nullptr) { f32x4* w4 = (f32x4*)(xcw + (size_t)(m - ML) * D) + lane;
#pragma unroll
                for (int j = 0; j < 4; ++j) w4[64 * j] = v[j]; } }
#pragma unroll
        for (int j = 0; j < 4; ++j) ss += (v[j].x * v[j].x + v[j].y * v[j].y) + (v[j].z * v[j].z + v[j].w * v[j].w);
        const float rstd = 1.0f / sqrtf(wave_sum(ss) * (1.f / D) + EPS);
        const f32x4* g4 = (const f32x4*)gvec + lane; const f32x4* sc4 = (const f32x4*)(mod + (size_t)r * MODW + scale_i * D) + lane; const f32x4* sh4 = (const f32x4*)(mod + (size_t)r * MODW + shift_i * D) + lane;
        u32x2* o = (u32x2*)(H + (size_t)m * D) + lane;
#pragma unroll
        for (int j = 0; j < 4; ++j) { const f32x4 h = v[j] * rstd * g4[64 * j] * (1.0f + sc4[64 * j]) + sh4[64 * j]; u32x2 w; w.x = cvt_pk_bf16(h.x, h.y); w.y = cvt_pk_bf16(h.z, h.w); o[64 * j] = w; }
    }
}
__device__ __forceinline__ void final_rows(float* x, const float* gvec, int gw, int NGW, int lane) {
    f32x4 vn[4];
    { const f32x4* xq = (const f32x4*)(x + (size_t)min(gw, ML - 1) * D) + lane;
#pragma unroll
      for (int j = 0; j < 4; ++j) vn[j] = xq[64 * j]; }
    for (int m = gw; m < ML; m += NGW) {
        f32x4* x4 = (f32x4*)(x + (size_t)m * D) + lane; f32x4 v[4]; float ss = 0.f;
#pragma unroll
        for (int j = 0; j < 4; ++j) { v[j] = vn[j]; ss += (v[j].x * v[j].x + v[j].y * v[j].y) + (v[j].z * v[j].z + v[j].w * v[j].w); }
        { const f32x4* xq = (const f32x4*)(x + (size_t)min(m + NGW, ML - 1) * D) + lane;
#pragma unroll
          for (int j = 0; j < 4; ++j) vn[j] = xq[64 * j]; }
        const float rstd = 1.0f / sqrtf(wave_sum(ss) * (1.f / D) + EPS);
        const f32x4* g4 = (const f32x4*)gvec + lane;
#pragma unroll
        for (int j = 0; j < 4; ++j) x4[64 * j] = v[j] * rstd * g4[64 * j];
    }
}
constexpr int SCW_WAVE = 19456, SCW_TILE = 17664;
constexpr int SCW_WAVE_OLD = 18432;
#ifndef AF_STACK
#define AF_STACK 1
#endif
template <bool PASSB, int DIR>
__device__ __forceinline__ void scan_sweep(const Args& a, LAS unsigned char* wl, int l, int b, int q, int h, int seqbase, int L, int t0, int lane, unsigned (&st)[NSUB][16], unsigned (&afs)[NSUB][16]) {
    constexpr bool AFS = (AF_STACK != 0);
    const int l31 = lane & 31, lh = lane >> 5, ld = l * 2 + DIR;
    const bf16* U = (const bf16*)(a.ws + WS_U) + (size_t)seqbase * D + h * 64 + lh * 8;
    const LAS float* cwl = (const LAS float*)(wl + 16384);
    { const bf16* g0 = (const bf16*)(a.ws + WS_GW) + (size_t)((ld * 2 + 0) * 16 + h) * 4096; const bf16* g1 = (const bf16*)(a.ws + WS_GW) + (size_t)((ld * 2 + 1) * 16 + h) * 4096;
      u32x4 v0[8], v1[8];
#pragma unroll
      for (int p = 0; p < 8; ++p) { v0[p] = *(const u32x4*)(g0 + (p * 64 + lane) * 8); v1[p] = *(const u32x4*)(g1 + (p * 64 + lane) * 8); }
#pragma unroll
      for (int p = 0; p < 8; ++p) { const int piece = p * 64 + lane, row = piece >> 3, c = piece & 7, off = row * 128 + ((c ^ (row & 7)) * 16);
          *(LAS u32x4*)(wl + off) = v0[p]; *(LAS u32x4*)(wl + 8192 + off) = v1[p]; } }
    float brr[2], bii[2], sp[2], s[2], AT[2];
#pragma unroll
    for (int nb = 0; nb < 2; ++nb) { const int ch = h * 64 + nb * 32 + l31;
        brr[nb] = -1.44269504f * a.in[I_BR][ld * D + ch]; bii[nb] = -1.44269504f * a.in[I_BI][ld * D + ch];
        const float lam = a.in[I_LAM][ld * D + ch]; sp[nb] = (-8.0f * 1.44269504f) * (fmaxf(-lam, 0.f) + log1pf(__expf(-fabsf(lam))));
        AT[nb] = 1.f; s[nb] = PASSB ? ((const float*)(a.ws + WS_CARRY))[(size_t)((b * 2 + DIR) * NQ + q) * 1024 + ch] : 0.f; }
    asm volatile("s_waitcnt lgkmcnt(0)" ::: "memory"); __builtin_amdgcn_wave_barrier();
    u32x4 ur[4][4];
#define LOADU(tokv) do { _Pragma("unroll") for (int j_ = 0; j_ < 4; ++j_) { const int tc_ = min(max((tokv) - 2 + j_, 0), L - 1); \
        _Pragma("unroll") for (int ks_ = 0; ks_ < 4; ++ks_) ur[ks_][j_] = *(const u32x4*)(U + (size_t)tc_ * D + ks_ * 16); } } while (0)
#ifndef SCAN_PREFETCH
#define SCAN_PREFETCH 0
#endif
    if (SCAN_PREFETCH) LOADU(t0 + (DIR ? (NSUB - 1) * 32 : 0) + l31);
#pragma unroll 1
    for (int k = 0; k < NSUB; ++k) {
        const int tsub = t0 + (DIR ? NSUB - 1 - k : k) * 32, tok = tsub + l31;
        bf16x8 af[4];
        if (AFS && DIR == 1) {
#pragma unroll
            for (int ks = 0; ks < 4; ++ks) { u32x4 o; o.x = afs[0][4 * ks]; o.y = afs[0][4 * ks + 1]; o.z = afs[0][4 * ks + 2]; o.w = afs[0][4 * ks + 3]; af[ks] = __builtin_bit_cast(bf16x8, o); }
#pragma unroll
            for (int i = 0; i < 16; ++i)
#pragma unroll
                for (int d = 0; d + 1 < NSUB; ++d) afs[d][i] = afs[d + 1][i];
        } else {
        if (!SCAN_PREFETCH) { LOADU(tok); __builtin_amdgcn_sched_barrier(0); }
#pragma unroll
        for (int ks = 0; ks < 4; ++ks) { const int c0 = ks * 16 + lh * 8;
            f32x4 u0 = *(const LAS f32x4*)(cwl + 256 + c0), u1 = *(const LAS f32x4*)(cwl + 256 + c0 + 4);
#pragma unroll
            for (int j = 0; j < 4; ++j) { const int tt = tok - 2 + j; const bool ok = (tt >= 0 && tt < L); u32x4 uv = ur[ks][j];
                uv.x = ok ? uv.x : 0u; uv.y = ok ? uv.y : 0u; uv.z = ok ? uv.z : 0u; uv.w = ok ? uv.w : 0u;
                const f32x4 w0 = *(const LAS f32x4*)(cwl + j * 64 + c0), w1 = *(const LAS f32x4*)(cwl + j * 64 + c0 + 4);
                u0.x = fmaf(w0.x, bf_lo(uv.x), u0.x); u0.y = fmaf(w0.y, bf_hi(uv.x), u0.y); u0.z = fmaf(w0.z, bf_lo(uv.y), u0.z); u0.w = fmaf(w0.w, bf_hi(uv.y), u0.w);
                u1.x = fmaf(w1.x, bf_lo(uv.z), u1.x); u1.y = fmaf(w1.y, bf_hi(uv.z), u1.y); u1.z = fmaf(w1.z, bf_lo(uv.w), u1.z); u1.w = fmaf(w1.w, bf_hi(uv.w), u1.w); }
            u32x4 o; o.x = cvt_pk_bf16(u0.x, u0.y); o.y = cvt_pk_bf16(u0.z, u0.w); o.z = cvt_pk_bf16(u1.x, u1.y); o.w = cvt_pk_bf16(u1.z, u1.w);
            af[ks] = __builtin_bit_cast(bf16x8, o);
            if (AFS) {
#pragma unroll
                for (int d = NSUB - 1; d > 0; --d) { afs[d][4 * ks] = afs[d - 1][4 * ks]; afs[d][4 * ks + 1] = afs[d - 1][4 * ks + 1]; afs[d][4 * ks + 2] = afs[d - 1][4 * ks + 2]; afs[d][4 * ks + 3] = afs[d - 1][4 * ks + 3]; }
                afs[0][4 * ks] = o.x; afs[0][4 * ks + 1] = o.y; afs[0][4 * ks + 2] = o.z; afs[0][4 * ks + 3] = o.w; } }
        }
        __builtin_amdgcn_sched_barrier(0);
        if (SCAN_PREFETCH) { const int kn = k < NSUB - 1 ? k + 1 : k; LOADU(t0 + (DIR ? NSUB - 1 - kn : kn) * 32 + l31); }
        __builtin_amdgcn_sched_barrier(0);
        unsigned cur[16];
        if (PASSB && DIR == 1) {
#pragma unroll
            for (int i = 0; i < 16; ++i) { cur[i] = st[0][i];
#pragma unroll
                for (int d = 0; d + 1 < NSUB; ++d) st[d][i] = st[d + 1][i]; } }
        float gall[2][16]; unsigned outp[2][8];
        LAS unsigned char* tile = wl + SCW_TILE; const int r8 = lane >> 3, c8 = lane & 7;
        if (PASSB && DIR == 1) {
            const bf16* Grow = (const bf16*)(a.ws + WS_G) + (size_t)(seqbase + tsub + r8) * D + h * 64 + c8 * 8;
            u32x4 gq[4];
#pragma unroll
            for (int gi = 0; gi < 4; ++gi) gq[gi] = *(const u32x4*)(Grow + (size_t)(8 * gi) * D);
#pragma unroll
            for (int gi = 0; gi < 4; ++gi) { *(LAS u32x4*)(tile + r8 * 128 + c8 * 16) = gq[gi];
#pragma unroll
                for (int nb2 = 0; nb2 < 2; ++nb2)
#pragma unroll
                    for (int j = 0; j < 4; ++j) gall[nb2][4 * gi + j] = __uint_as_float((unsigned)(*(const LAS unsigned short*)(tile + (4 * lh + j) * 128 + (nb2 * 32 + l31) * 2)) << 16); } }
#pragma unroll
        for (int nb = 0; nb < 2; ++nb) {
            __builtin_amdgcn_sched_barrier(0);
            const size_t cbase = (size_t)(seqbase + tsub + 4 * lh) * D + h * 64 + nb * 32 + l31;
            bf16* HL = (bf16*)(a.ws + WS_H) + cbase; const bf16* Gp = (const bf16*)(a.ws + WS_G) + cbase;
            float hfv[16], gv[16];
            if (PASSB && DIR == 1) {
#pragma unroll
                for (int reg = 0; reg < 16; ++reg) { gv[reg] = gall[nb][reg];
                    hfv[reg] = (reg & 1) ? bf_hi(cur[nb * 8 + (reg >> 1)]) : bf_lo(cur[nb * 8 + (reg >> 1)]); } }
            f32x16 ar, ai, au;
#pragma unroll
            for (int i = 0; i < 16; ++i) { ar[i] = 0.f; ai[i] = 0.f; au[i] = 0.f; }
            const int row = nb * 32 + l31;
#pragma unroll
            for (int ks = 0; ks < 4; ++ks) {
                const int idx = row - (ks * 16 + lh * 8);
                const unsigned one = (idx >= 0 && idx < 8) ? (0x3F80u << ((idx & 1) * 16)) : 0u; const int dw = idx >> 1;
                u32x4 idv; idv.x = dw == 0 ? one : 0u; idv.y = dw == 1 ? one : 0u; idv.z = dw == 2 ? one : 0u; idv.w = dw == 3 ? one : 0u;
                const int woff = row * 128 + (((ks * 2 + lh) ^ (row & 7)) * 16);
                const bf16x8 wr = *(const LAS bf16x8*)(wl + woff), wi = *(const LAS bf16x8*)(wl + 8192 + woff);
                ar = __builtin_amdgcn_mfma_f32_32x32x16_bf16(af[ks], wr, ar, 0, 0, 0);
                ai = __builtin_amdgcn_mfma_f32_32x32x16_bf16(af[ks], wi, ai, 0, 0, 0);
                if ((ks >> 1) == nb) au = __builtin_amdgcn_mfma_f32_32x32x16_bf16(af[ks], __builtin_bit_cast(bf16x8, idv), au, 0, 0, 0); }
#pragma unroll
            for (int reg = 0; reg < 16; ++reg) {
                const float r = __builtin_amdgcn_rcpf(1.0f + __builtin_amdgcn_exp2f(fmaf(ar[reg], -1.44269504f, brr[nb])));
                const float ig = __builtin_amdgcn_rcpf(1.0f + __builtin_amdgcn_exp2f(fmaf(ai[reg], -1.44269504f, bii[nb])));
                float rs = r * sp[nb]; asm volatile("" : "+v"(rs));
                const float av = __builtin_amdgcn_exp2f(rs); float om = fmaf(-av, av, 1.0f); asm volatile("" : "+v"(om));
                float bq = (__builtin_amdgcn_sqrtf(om) * ig) * au[reg]; asm volatile("" : "+v"(bq));
                ar[reg] = av; ai[reg] = bq; }
            float gA[4], gB[4], pA[4], pB[4], sIn[4];
#pragma unroll
            for (int gi = 0; gi < 4; ++gi) { const int j0 = DIR ? 3 : 0; float A = ar[4 * gi + j0], B = ai[4 * gi + j0];
#pragma unroll
                for (int jj = 1; jj < 4; ++jj) { const int j = DIR ? 3 - jj : jj; B = ar[4 * gi + j] * B + ai[4 * gi + j]; A *= ar[4 * gi + j]; }
                gA[gi] = A; gB[gi] = B; }
#pragma unroll
            for (int gi = 0; gi < 4; ++gi) { pA[gi] = __shfl_xor(gA[gi], 32); pB[gi] = __shfl_xor(gB[gi], 32); sIn[gi] = 0.f; }
            float st = s[nb];
#pragma unroll
            for (int g = 0; g < 8; ++g) { const int gg = DIR ? 7 - g : g, gi = gg >> 1; const bool own = (lh == (gg & 1));
                const float Ag = own ? gA[gi] : pA[gi], Bg = own ? gB[gi] : pB[gi];
                sIn[gi] = own ? st : sIn[gi]; st = Ag * st + Bg; if (!PASSB) AT[nb] *= Ag; }
            s[nb] = st;
            if (PASSB) {
#pragma unroll
                for (int gi = 0; gi < 4; ++gi) { float hc = sIn[gi];
#pragma unroll
                    for (int jj = 0; jj < 4; ++jj) { const int j = DIR ? 3 - jj : jj, reg = 4 * gi + j; hc = ar[reg] * hc + ai[reg];
                        const size_t o = (size_t)(8 * gi + j) * D;
                        if (DIR == 0) ar[reg] = hc;
                        else ar[reg] = (hfv[reg] + hc) * gelu_tanh(gv[reg]); } }
#pragma unroll
                for (int p = 0; p < 8; ++p) { const unsigned pk = cvt_pk_bf16(ar[2 * p], ar[2 * p + 1]); if (DIR == 0) cur[nb * 8 + p] = pk; else outp[nb][p] = pk; }
            }
        }
        if (PASSB && DIR == 0) {
#pragma unroll
            for (int i = 0; i < 16; ++i) {
#pragma unroll
                for (int d = NSUB - 1; d > 0; --d) st[d][i] = st[d - 1][i];
                st[0][i] = cur[i]; } }
        if (PASSB && DIR == 1) {
            bf16* HLrow = (bf16*)(a.ws + WS_H) + (size_t)(seqbase + tsub + r8) * D + h * 64 + c8 * 8;
#pragma unroll
            for (int gi = 0; gi < 4; ++gi) {
#pragma unroll
                for (int nb2 = 0; nb2 < 2; ++nb2)
#pragma unroll
                    for (int j = 0; j < 4; ++j) { const unsigned pk = outp[nb2][2 * gi + (j >> 1)];
                        *(LAS unsigned short*)(tile + (4 * lh + j) * 128 + (nb2 * 32 + l31) * 2) = (unsigned short)((j & 1) ? (pk >> 16) : (pk & 0xffffu)); }
                const u32x4 row = *(const LAS u32x4*)(tile + r8 * 128 + c8 * 16);
                *(u32x4*)(HLrow + (size_t)(8 * gi) * D) = row; } }
    }
#undef LOADU
    if (!PASSB) {
#pragma unroll
        for (int nb = 0; nb < 2; ++nb) { float* sm = (float*)(a.ws + WS_SUMM) + ((size_t)((b * 2 + DIR) * NQ + q) * 2) * 1024 + h * 64 + nb * 32 + l31;
            if (lh == 0) { sm[0] = AT[nb]; sm[1024] = s[nb]; } }
    }
    asm volatile("s_waitcnt lgkmcnt(0)" ::: "memory"); __builtin_amdgcn_wave_barrier();
}
template <bool PASSB>
__device__ __forceinline__ void scan_task(const Args& a, LAS unsigned char* lds, int l, int item, int wave, int lane) {
    int b, chunk, h, seqbase, L, q;
    if (item < NLAT) { b = item / (NCL * 16); const int rem = item % (NCL * 16); chunk = rem >> 4; h = rem & 15; seqbase = b * SEQ; L = SEQ; q = NCC + chunk; }
    else { const int it = item - NLAT; b = it / (NCC * 16); const int rem = it % (NCC * 16); chunk = rem >> 4; h = rem & 15; seqbase = ML + b * CTX; L = CTX; q = chunk; }
    LAS unsigned char* wl = lds + wave * SCW_WAVE; LAS float* cwl = (LAS float*)(wl + 16384);
    { const float* cw = a.in[I_CONVW] + (size_t)l * 4 * D + h * 64;
#pragma unroll
      for (int j = 0; j < 4; ++j) cwl[j * 64 + lane] = cw[j * D + lane];
      cwl[256 + lane] = a.in[I_CONVB][l * D + h * 64 + lane]; }
    unsigned st[NSUB][16];
#pragma unroll
    for (int d = 0; d < NSUB; ++d)
#pragma unroll
        for (int i = 0; i < 16; ++i) st[d][i] = 0u;
    unsigned afs[NSUB][16];
#pragma unroll
    for (int d = 0; d < NSUB; ++d)
#pragma unroll
        for (int i = 0; i < 16; ++i) afs[d][i] = 0u;
    scan_sweep<PASSB, 0>(a, wl, l, b, q, h, seqbase, L, chunk * TCH, lane, st, afs);
    scan_sweep<PASSB, 1>(a, wl, l, b, q, h, seqbase, L, chunk * TCH, lane, st, afs);
}
__device__ __forceinline__ void carry_phase(const Args& a) {
    const float* sm = (const float*)(a.ws + WS_SUMM); float* cr = (float*)(a.ws + WS_CARRY);
    const int tid = opaque_tid();
    static_assert(NQ % 17 == 0, "carry batches");
    for (int idx = blockIdx.x * 64 + tid; tid < 64 && idx < NB * 2 * 1024; idx += gridDim.x * 64) {
        const int chn = idx & 1023, bd = idx >> 10, dir = bd & 1;
        const float* s0 = sm + (size_t)bd * NQ * 2048 + chn; float* c0 = cr + (size_t)bd * NQ * 1024 + chn;
        float hs = 0.f;
#pragma unroll 1
        for (int k0 = 0; k0 < NQ; k0 += 17) { float va[17], vb[17];
#pragma unroll
            for (int i = 0; i < 17; ++i) { const int k = k0 + i; const int q = (dir == 0) ? k : ((k < NCC) ? NCC - 1 - k : (NQ - 1 - (k - NCC)));
                va[i] = s0[(size_t)q * 2048]; vb[i] = s0[(size_t)q * 2048 + 1024]; }
#pragma unroll
            for (int i = 0; i < 17; ++i) { const int k = k0 + i; const int q = (dir == 0) ? k : ((k < NCC) ? NCC - 1 - k : (NQ - 1 - (k - NCC)));
                c0[(size_t)q * 1024] = hs; hs = va[i] * hs + vb[i]; } }
    }
}
constexpr int PL_PF = 0  , PL_MB = 40960  , PL_MROW = 272;
__device__ __forceinline__ void pool_decode(int item, int& g, int& R0, int& L, int& t0) {
    if (item < 1024) { g = item & 3; R0 = (item >> 2) * 64; L = 64; t0 = 0; }
    else { const int it = item - 1024; g = it & 3; const int blk = (it >> 2) & 3, b = it >> 4; R0 = ML + b * CTX; L = CTX; t0 = blk * 64; }
}
__device__ __forceinline__ void pool_load(const Args& a, int item, int tid, u32x4 (&v)[3]) {
    int g, R0, L, t0; pool_decode(item, g, R0, L, t0);
    const bf16* P = (const bf16*)(a.ws + WS_P);
#pragma unroll
    for (int i = 0; i < 3; ++i) { const int idx = min(tid + 512 * i, 1279), row = idx >> 4, c8 = (idx & 15) * 8, tt = t0 - 8 + row, tc = min(max(tt, 0), L - 1);
        v[i] = *(const u32x4*)(P + (size_t)(R0 + tc) * D_POOL + g * 128 + c8);
        const bool ok = (tt == tc); v[i].x = ok ? v[i].x : 0u; v[i].y = ok ? v[i].y : 0u; v[i].z = ok ? v[i].z : 0u; v[i].w = ok ? v[i].w : 0u; }
}
__device__ __forceinline__ void pool_phase(const Args& a, LAS unsigned char* lds, int l, int npool) {
    const int tid = opaque_tid(), lane = tid & 63, wave = __builtin_amdgcn_readfirstlane(tid >> 6), G = gridDim.x, bx = blockIdx.x;
    if (bx >= npool) return;
    LAS float* pf = (LAS float*)(lds + PL_PF);
    const int mblk = wave & 1, nblk = wave >> 1, l31 = lane & 31, lh = lane >> 5, e = nblk * 32 + l31, g = bx & 3;
    bf16x8 bw[8];
    { const bf16* pw = (const bf16*)(a.ws + WS_PW) + ((size_t)(l * 4 + g) * 128 + e) * 128 + lh * 8;
#pragma unroll
      for (int ks = 0; ks < 8; ++ks) bw[ks] = *(const bf16x8*)(pw + ks * 16); }
    const float scl = a.in[I_POOLS][l * D_POOL + g * 128 + e];
    u32x4 v[3]; pool_load(a, bx, tid, v);
    for (int item = bx; item < npool; item += G) {
        int gg, R0, L, t0; pool_decode(item, gg, R0, L, t0);
        if (gg != g) return;
#pragma unroll
        for (int i = 0; i < 3; ++i) { const int idx = tid + 512 * i, row = idx >> 4, c8 = (idx & 15) * 8;
            if (idx < 1280) { *(LAS f32x4*)(pf + row * 128 + c8) = (f32x4){bf_lo(v[i].x), bf_hi(v[i].x), bf_lo(v[i].y), bf_hi(v[i].y)}; *(LAS f32x4*)(pf + row * 128 + c8 + 4) = (f32x4){bf_lo(v[i].z), bf_hi(v[i].z), bf_lo(v[i].w), bf_hi(v[i].w)}; } }
        pool_load(a, min(item + G, npool - 1), tid, v);
        __syncthreads();
        { const int c = tid & 127, tq = tid >> 7, hw = 1 << g;
          const LAS float* pc = pf + c; const int tb = tq * 16; float s = 0.f;
#pragma unroll
          for (int u = 0; u < 16; ++u) { const int r = min(tb + 8 - hw + u, tb + 8 + hw - 1); const float x = pc[r * 128]; s += (u < 2 * hw) ? x : 0.f; }
#pragma unroll
          for (int k = 0; k < 16; ++k) { const int t = tb + k, tt = t0 + t; const int cnt = min(tt + hw, L) - max(tt - hw, 0);
              const float mval = s * __builtin_amdgcn_rcpf((float)cnt) - pc[(t + 8) * 128];
              *(LAS unsigned short*)(lds + PL_MB + t * PL_MROW + c * 2) = (unsigned short)cvt_pk_bf16(mval, 0.f);
              if (k < 15) s += pc[(t + 8 + hw) * 128] - pc[(t + 8 - hw) * 128]; } }
        __syncthreads();
        { f32x16 acc;
#pragma unroll
          for (int i = 0; i < 16; ++i) acc[i] = 0.f;
#pragma unroll
          for (int ks = 0; ks < 8; ++ks) { const bf16x8 af = *(const LAS bf16x8*)(lds + PL_MB + (mblk * 32 + l31) * PL_MROW + (ks * 16 + lh * 8) * 2);
              acc = __builtin_amdgcn_mfma_f32_32x32x16_bf16(af, bw[ks], acc, 0, 0, 0); }
          LAS unsigned short* ot = (LAS unsigned short*)(lds + PL_PF);
#pragma unroll
          for (int reg = 0; reg < 16; ++reg) { const int t = mblk * 32 + (reg & 3) + 8 * (reg >> 2) + 4 * lh; ot[t * 128 + e] = (unsigned short)cvt_pk_bf16(acc[reg] * scl, 0.f); } }
        __syncthreads();
        { bf16* PM = (bf16*)(a.ws + WS_PM) + (size_t)(R0 + t0) * D_POOL + g * 128;
#pragma unroll
          for (int i = 0; i < 2; ++i) { const int idx = tid + 512 * i, row = idx >> 4, c16 = idx & 15;
              *(u32x4*)(PM + (size_t)row * D_POOL + c16 * 8) = *(const LAS u32x4*)(lds + PL_PF + row * 256 + c16 * 16); } }
        __syncthreads();
    }
}
#define XB_TMO      128
#define XB_XCNT(j)  (256  + 64 * (j))
#define XB_XSUB(j)  (1280 + 64 * (j))
#define XB_XGEN(j)  (2304 + 64 * (j))
#define XB_TOP      3328
#define XB_TOPGEN   3392
#define XCD_BAR_WORDS 3456
#define XB_SPIN_CAP (1u << 18)

__device__ __forceinline__ unsigned xb_ld(unsigned* p)              { return __hip_atomic_load(p, __ATOMIC_RELAXED, __HIP_MEMORY_SCOPE_AGENT); }
__device__ __forceinline__ unsigned xb_add(unsigned* p, unsigned v) { return __hip_atomic_fetch_add(p, v, __ATOMIC_RELAXED, __HIP_MEMORY_SCOPE_AGENT); }
__device__ __forceinline__ unsigned xb_xcc_id() { return (unsigned)__builtin_amdgcn_s_getreg((3 << 11) | 20) & 0xFu; }
#define XB_SPIN(cond, bar) do { unsigned _sp = 0; while (cond) { __builtin_amdgcn_s_sleep(1); \
    if ((++_sp & 255u) == 0u) { if (xb_ld(&(bar)[XB_TMO])) break; if (_sp > XB_SPIN_CAP) { atomicAdd(&(bar)[XB_TMO], 1u); break; } } } } while (0)

struct XcdBarrier {
    unsigned* bar; unsigned x;
    volatile LAS unsigned* st;
};

__device__ __forceinline__ XcdBarrier xcd_barrier_post(unsigned* bar, volatile LAS unsigned* st) {
    XcdBarrier b; b.bar = bar; b.x = xb_xcc_id(); b.st = st;
    if (threadIdx.x == 0) (void)xb_add(&bar[XB_XCNT(b.x)], 1u);
    return b;
}
__device__ __forceinline__ void xcd_barrier_complete(unsigned* bar, unsigned x, unsigned& nloc, unsigned& nx) {
    const unsigned G = gridDim.x * gridDim.y * gridDim.z;
    unsigned sum, cnt, mine, sp = 0u;
    for (;;) {
        sum = 0u; cnt = 0u; mine = 0u;
#pragma unroll
        for (unsigned j = 0; j < 16; ++j) { const unsigned c = xb_ld(&bar[XB_XCNT(j)]); sum += c; cnt += (c > 0u) ? 1u : 0u; mine = (j == x) ? c : mine; }
        if (sum == G) break;
        __builtin_amdgcn_s_sleep(1);
        if ((++sp & 255u) == 0u) { if (xb_ld(&bar[XB_TMO])) break; if (sp > XB_SPIN_CAP) { atomicAdd(&bar[XB_TMO], 1u); break; } }
    }
    nloc = mine > 0u ? mine : 1u; nx = cnt > 0u ? cnt : 1u;
}

__device__ __forceinline__ void xcd_barrier(const XcdBarrier& b) {
    asm volatile("s_waitcnt vmcnt(0)" ::: "memory");
    __syncthreads();
    if (threadIdx.x == 0) {
        unsigned* bar = b.bar;
        __builtin_amdgcn_s_waitcnt(0);
        unsigned nloc = b.st[0], nx = b.st[1];
        if (nloc == 0u) { xcd_barrier_complete(bar, b.x, nloc, nx); b.st[0] = nloc; b.st[1] = nx; }
        const unsigned old = xb_add(&bar[XB_XSUB(b.x)], 1u);
        const unsigned gen = old / nloc;
        if (old + 1u == (gen + 1u) * nloc) {
            __builtin_amdgcn_fence(__ATOMIC_RELEASE, "agent");
            asm volatile("s_waitcnt vmcnt(0)" ::: "memory");
            const unsigned og = xb_add(&bar[XB_TOP], 1u);
            const unsigned tg = og / nx;
            if (og + 1u == (tg + 1u) * nx) xb_add(&bar[XB_TOPGEN], 1u);
            else XB_SPIN(xb_ld(&bar[XB_TOPGEN]) == tg, bar);
            __builtin_amdgcn_fence(__ATOMIC_ACQUIRE, "agent");
            xb_add(&bar[XB_XGEN(b.x)], 1u);
            asm volatile("s_waitcnt vmcnt(0)" ::: "memory");
        } else {
            XB_SPIN(xb_ld(&bar[XB_XGEN(b.x)]) == gen, bar);
            __builtin_amdgcn_fence(__ATOMIC_ACQUIRE, "agent");
            asm volatile("s_waitcnt vmcnt(0)" ::: "memory");
        }
    }
    __syncthreads();
}

constexpr int NPHASE = 22;
__global__ void __launch_bounds__(512, 2) mk_fwd(Args a) {
    extern __shared__ __attribute__((aligned(16))) unsigned char lds_raw[];
    LAS unsigned char* lds = (LAS unsigned char*)lds_raw;
    cg::grid_group grid = cg::this_grid();
    volatile LAS unsigned* MISC = (volatile LAS unsigned*)(lds + MISC_OFF);
    if (threadIdx.x < 64) MISC[threadIdx.x] = 0u;
    __syncthreads();
    XcdBarrier xbar; xbar.bar = (unsigned*)(a.ws + WS_BAR); xbar.x = 0; xbar.st = MISC + 8;
    if (a.hi - a.lo > 1) xbar = xcd_barrier_post((unsigned*)(a.ws + WS_BAR), MISC + 8);
    const int G = gridDim.x, bx = blockIdx.x, NGW = G * 8;
#define WL() const int tid_ = opaque_tid(), lane = tid_ & 63, wave = __builtin_amdgcn_readfirstlane(tid_ >> 6), gw = bx * 8 + wave
    const int lo = a.lo, hi = a.hi;
    unsigned char* ws = a.ws;
    float* MOD = (float*)(ws + WS_MOD); float* XC = (float*)(ws + WS_XC);
    bf16* Hb = (bf16*)(ws + WS_H); bf16* Ub = (bf16*)(ws + WS_U); bf16* Gb = (bf16*)(ws + WS_G); bf16* Pb = (bf16*)(ws + WS_P); bf16* GTb = (bf16*)(ws + WS_GT); bf16* PMb = (bf16*)(ws + WS_PM); bf16* Fb = (bf16*)(ws + WS_F);
#ifndef PH_MASK
#define PH_MASK 0xfff
#endif
#define IN(k) (lo <= (k) && (k) < hi)
#define ON(b) ((PH_MASK >> (b)) & 1)
#ifndef REP_MASK
#define REP_MASK 0
#endif
#define REPS(b) for (int rep_ = 0; rep_ < 1 + ((REP_MASK >> (b)) & 1); ++rep_)
#ifndef SYNC_REP
#define SYNC_REP 1
#endif
#define SEAM(k) do { if (IN(k) && IN((k) + 1)) for (int sr_ = 0; sr_ < SYNC_REP; ++sr_) { if (a.hi < 0) grid.sync(); xcd_barrier(xbar); } } while (0)
    if (ON(0) && IN(0)) REPS(0) {
        for (int it = bx; it < 192; it += G) mod_item(a, lds, it);
        WL();
        convert_small(a, lds, gw, NGW, wave, lane);
        convert_big(a, lds, 0, gw, NGW, wave, lane);
    }
    SEAM(0);
#pragma unroll 1
    for (int l = 0; l < DEPTH; ++l) {
        const int pb = 1 + 10 * l; const bool last = (l == DEPTH - 1);
        const float* modl = MOD + (size_t)l * 5 * MODW;
        const float* xsrcL = l == 0 ? a.in[I_X] : a.out; const float* xsrcC = l == 0 ? a.in[I_CTX] : XC;
        const int Mrest = last ? ML : MT;
        if (ON(1) && IN(pb + 0)) REPS(1) {
            WL();
            if (l > 0) convert_big(a, lds, l, gw, NGW, wave, lane);
            norm_rows(xsrcL, xsrcC, Hb, a.in[I_N1G] + l * D, modl, 0, 1, MT, gw, NGW, lane, l > 0 ? (const float*)(ws + WS_SLAB5) : nullptr, MOD + 4 * MODW + 5 * D  , nullptr);
        }
        SEAM(pb + 0);
        if (ON(2) && IN(pb + 1)) REPS(2) {
            pg8::Gemm g{Hb, (const bf16*)(ws + WS_WIN), MT, D_IN, D, D}; pg8::StaticOrder S; S.init(MT, D_IN, G, bx);
            pg8::EpiSplit E{Ub, Gb, Pb, GTb};
            pg8::gemm_phase<pg8::EpiSplit, pg8::StaticOrder, true, true>(lds, g, S, E);
        }
        SEAM(pb + 1);
        if (ON(3) && IN(pb + 2)) REPS(3) {
            const int npool = last ? 1024 : 1088;
            { WL(); const int nit = NLAT + NCTX, nfull = (nit / NGW) * NGW;
              for (int r = 0;; ++r) { const int it = (r * NGW < nfull) ? r * NGW + gw : nfull + wave * G + bx; if (r * NGW > nfull || it >= nit) break;
                  scan_task<false>(a, lds, l, it, wave, lane); } }
            __syncthreads();
            pool_phase(a, lds, l, npool);
        }
        SEAM(pb + 2);
        if (ON(4) && IN(pb + 3)) REPS(4) carry_phase(a);
        SEAM(pb + 3);
        if (ON(5) && IN(pb + 4)) REPS(5) { WL(); const int nit = last ? NLAT : NLAT + NCTX, nfull = (nit / NGW) * NGW;
            for (int r = 0;; ++r) { const int it = (r * NGW < nfull) ? r * NGW + gw : nfull + wave * G + bx; if (r * NGW > nfull || it >= nit) break;
                scan_task<true>(a, lds, l, it, wave, lane); } }
        SEAM(pb + 4);
        if (ON(6) && IN(pb + 5)) REPS(6) {
            { pg8::Gemm g{PMb, (const bf16*)(ws + WS_WPO), Mrest, D, D_POOL, D_POOL}; pg8::StaticOrder S; S.init(Mrest, D, G, bx);
              pg8::EpiGate<0> E{Ub, GTb}; pg8::gemm_phase<pg8::EpiGate<0>, pg8::StaticOrder, true, true>(lds, g, S, E); }
            { pg8::Gemm g{Hb, (const bf16*)(ws + WS_WLO), Mrest, D, D, D}; pg8::StaticOrder S; S.init(Mrest, D, G, bx);
              pg8::EpiGate<1> E{Ub, GTb}; pg8::gemm_phase<pg8::EpiGate<1>, pg8::StaticOrder, true, true>(lds, g, S, E); }
        }
        SEAM(pb + 5);
        if (ON(7) && IN(pb + 6)) {
            { pg8::Gemm g{Ub, (const bf16*)(ws + WS_WO), ML, D, D, D}; pg8::StaticOrder S; S.init(ML, D, G, bx);
              pg8::EpiRes E{xsrcL, xsrcC, a.out, XC, modl + 2 * D};
              pg8::gemm_phase<pg8::EpiRes, pg8::StaticOrder, true, true>(lds, g, S, E); }
            if (!last) {
              int ksl = 256; asm volatile("" : "+s"(ksl));
              pg8::Gemm g{Ub + (size_t)ML * D, (const bf16*)(ws + WS_WO), MC, D, ksl, D}; pg8::SplitOrder S; S.init(MC, D, D, ksl, G, bx);
              pg8::EpiSlab E{(float*)(ws + WS_SLAB3)};
              pg8::gemm_phase<pg8::EpiSlab, pg8::SplitOrder, true, true>(lds, g, S, E); }
        }
        SEAM(pb + 6);
        if (ON(8) && IN(pb + 7)) REPS(8) { WL(); norm_rows(a.out, l == 0 ? a.in[I_CTX] : XC, Hb, a.in[I_N2G] + l * D, modl, 3, 4, Mrest, gw, NGW, lane, l == 0 ? (const float*)(ws + WS_SLAB3) : nullptr, modl + 4 * MODW + 2 * D  , XC); }
        SEAM(pb + 7);
        if (ON(9) && IN(pb + 8)) REPS(9) {
            pg8::Gemm g{Hb, (const bf16*)(ws + WS_W1), Mrest, D_FF, D, D}; pg8::StaticOrder S; S.init(Mrest, D_FF, G, bx);
            pg8::EpiSqRelu E{Fb, D_FF};
            pg8::gemm_phase<pg8::EpiSqRelu, pg8::StaticOrder, true, true>(lds, g, S, E);
        }
        SEAM(pb + 8);
        if (ON(10) && IN(pb + 9)) {
            { pg8::Gemm g{Fb, (const bf16*)(ws + WS_W2), ML, D, D_FF, D_FF}; pg8::StaticOrder S; S.init(ML, D, G, bx);
              pg8::EpiRes E{a.out, XC, a.out, XC, modl + 5 * D};
              pg8::gemm_phase<pg8::EpiRes, pg8::StaticOrder, true, true>(lds, g, S, E); }
            if (!last) {
              int ksl = 1024; asm volatile("" : "+s"(ksl));
              pg8::Gemm g{Fb + (size_t)ML * D_FF, (const bf16*)(ws + WS_W2), MC, D, ksl, D_FF}; pg8::SplitOrder S; S.init(MC, D, D_FF, ksl, G, bx);
              pg8::EpiSlab E{(float*)(ws + WS_SLAB5)};
              pg8::gemm_phase<pg8::EpiSlab, pg8::SplitOrder, true, true>(lds, g, S, E); }
        }
        SEAM(pb + 9);
    }
    if (ON(11) && IN(21)) { WL(); final_rows(a.out, a.in[I_FG], gw, NGW, lane); }
#undef IN
#undef SEAM
}

extern "C" void kernel_launch(void* const* d_in, const int* in_sizes, int n_in, void* d_out, int out_size, void* d_ws, size_t ws_size, hipStream_t stream) {
    static int grid = 0;
    if (grid == 0) {
        if (n_in != 24 || out_size != ML * D || ws_size < WS_END) { fprintf(stderr, "kernel_launch: unexpected shapes (n_in %d, out %d, ws %zu)\n", n_in, out_size, ws_size); grid = -1; return; }
        int dev = 0, cus = 0, per_cu = 0;
        if (hipGetDevice(&dev) != hipSuccess || hipDeviceGetAttribute(&cus, hipDeviceAttributeMultiprocessorCount, dev) != hipSuccess) { grid = -1; return; }
        if (hipFuncSetAttribute((const void*)mk_fwd, hipFuncAttributeMaxDynamicSharedMemorySize, LDS_BYTES) != hipSuccess) { fprintf(stderr, "kernel_launch: hipFuncSetAttribute failed\n"); grid = -1; return; }
        if (hipOccupancyMaxActiveBlocksPerMultiprocessor(&per_cu, (const void*)mk_fwd, 512, LDS_BYTES) != hipSuccess || per_cu < 1) { fprintf(stderr, "kernel_launch: occupancy query says %d\n", per_cu); per_cu = 1; }
        (void)hipGetLastError();
        grid = cus;
    }
    if (grid < 0) return;
    Args a{};
    for (int i = 0; i < 24; ++i) a.in[i] = (const float*)d_in[i];
    a.out = (float*)d_out; a.ws = (unsigned char*)d_ws;
#if MK_PER_PHASE
    for (int p = 0; p < NPHASE; ++p) { a.lo = p; a.hi = p + 1; hipLaunchKernelGGL(mk_fwd, dim3(grid), dim3(512), LDS_BYTES, stream, a); }
#else
    a.lo = 0; a.hi = NPHASE;
    if (hipMemsetAsync((char*)d_ws + WS_BAR, 0, 16384, stream) != hipSuccess) { fprintf(stderr, "kernel_launch: memset of the barrier words failed\n"); return; }
    void* args[] = {&a};
    hipError_t e = hipLaunchCooperativeKernel((const void*)mk_fwd, dim3(grid), dim3(512), args, LDS_BYTES, stream);
    if (e != hipSuccess) fprintf(stderr, "kernel_launch: cooperative launch failed: %s (grid %d)\n", hipGetErrorString(e), grid);
#endif
}
```
